# Optimizing an MI355X kernel written in HIP

```python
import math
import jax
import jax.numpy as jnp
from jax import lax
import numpy as np

D_MODEL = 2048
BATCH = 2
SEQ = 8192
DEPTH = 2

CTX_LEN = 256
GRID_W = 64
D_FF = 5632
N_MOD = 9
EPS = 1e-6
MIX_W = D_MODEL // 2
HG_DK = 128
HG_DV = 128
HG_HEADS = MIX_W // HG_DV
HG_KEY_W = HG_HEADS * HG_DK
HG_CHUNK = 64
CONV_W = MIX_W
CONV_K = 3
DA_HEAD_DIM = 64
DA_V_DIM = 2 * DA_HEAD_DIM
DA_HEADS = MIX_W // DA_V_DIM
DA_QK_W = DA_HEADS * 2 * DA_HEAD_DIM
Q_BLOCK = 128
ROPE_THETA = 10000.0
N_BRANCH = 3
IN_SPLIT_SIZES = (HG_KEY_W, HG_KEY_W, HG_KEY_W, MIX_W, MIX_W,
                  CONV_W, CONV_W, CONV_W,
                  DA_QK_W, DA_QK_W, MIX_W,
                  D_MODEL, D_MODEL, D_MODEL)
W_IN_COLS = sum(IN_SPLIT_SIZES)

kernel_name = 'hybrid_hgrn2_conv_diffattn_dit_block'


def rmsnorm(x, w):
    xf = x.astype(jnp.float32)
    y = xf * lax.rsqrt(jnp.mean(xf * xf, axis=-1, keepdims=True) + EPS)
    return (y * w.astype(jnp.float32)).astype(x.dtype)


def modulate(x, shift, scale):
    return x * (1 + scale) + shift


def half_ffn(h, nw, shift, scale, gate, w13, w2):
    xn = modulate(rmsnorm(h, nw), shift, scale)
    g, u = jnp.split(xn @ w13, 2, axis=-1)
    return h + 0.5 * gate * ((jax.nn.silu(g) * u) @ w2)


def split_cols(p):
    out, start = [], 0
    for size in IN_SPLIT_SIZES:
        out.append(p[..., start:start + size])
        start += size
    return out


def axial_rope_tables(n_tokens):
    rows = n_tokens // GRID_W
    row = jnp.repeat(jnp.arange(rows, dtype=jnp.int32), GRID_W)
    col = jnp.tile(jnp.arange(GRID_W, dtype=jnp.int32), rows)
    half = DA_HEAD_DIM // 2
    inv_freq = ROPE_THETA ** (-jnp.arange(0, half, 2, dtype=jnp.float32) / half)
    ang_r = row.astype(jnp.float32)[:, None] * inv_freq
    ang_c = col.astype(jnp.float32)[:, None] * inv_freq
    ang = jnp.concatenate([ang_r, ang_r, ang_c, ang_c], axis=-1)
    return jnp.cos(ang), jnp.sin(ang)


def rotate_half(x):
    x1, x2 = jnp.split(x, 2, axis=-1)
    return jnp.concatenate([-x2, x1], axis=-1)


def apply_axial_rope(x, cos, sin):
    half = DA_HEAD_DIM // 2
    rot = jnp.concatenate([rotate_half(x[..., :half]), rotate_half(x[..., half:])], axis=-1)
    cos = cos[None, :, None, None, :].astype(x.dtype)
    sin = sin[None, :, None, None, :].astype(x.dtype)
    return x * cos + rot * sin


def hgrn_lower_bounds(raw):
    cum = jnp.cumsum(jax.nn.softmax(raw.astype(jnp.float32), axis=1), axis=1)
    return cum - cum[:, :1]


def hgrn_log_forget(z, lb):
    lb = lb.reshape(HG_HEADS, HG_DK)
    return jnp.logaddexp(jnp.log(lb), jnp.log1p(-lb) + jax.nn.log_sigmoid(z.astype(jnp.float32)))


def hgrn_chunk_scan(q, k, v, logf, s0):
    b, t, h, _ = q.shape
    nc = t // HG_CHUNK

    def to_chunks(a):
        return a.reshape(b, nc, HG_CHUNK, h, a.shape[-1]).transpose(1, 0, 3, 2, 4)

    lower = jnp.tril(jnp.ones((HG_CHUNK, HG_CHUNK), dtype=bool))

    def step(state, inp):
        qc, kc, vc, gc = inp
        cum = jnp.cumsum(gc, axis=-2)
        rel = jnp.where(lower[:, :, None], cum[..., :, None, :] - cum[..., None, :, :], -jnp.inf)
        scores = jnp.einsum('bhtk,bhsk,bhtsk->bhts', qc, kc, jnp.exp(rel))
        o = (jnp.einsum('bhts,bhsv->bhtv', scores, vc)
             + jnp.einsum('bhtk,bhkv->bhtv', qc * jnp.exp(cum), state))
        last = cum[..., -1:, :]
        state = (jnp.exp(last[..., 0, :])[..., None] * state
                 + jnp.einsum('bhsk,bhsv->bhkv', kc * jnp.exp(last - cum), vc))
        return state, o

    s_final, o = lax.scan(step, s0, (to_chunks(q), to_chunks(k), to_chunks(v), to_chunks(logf)))
    o = o.transpose(1, 0, 3, 2, 4).reshape(b, t, h, v.shape[-1])
    return o, s_final


def hgrn_direction(q, z, v, lb, s0, reverse):
    logf = hgrn_log_forget(z, lb)
    k = -jnp.expm1(logf)
    q = q.astype(jnp.float32)
    v = v.astype(jnp.float32)
    if reverse:
        q, k, v, logf = (jnp.flip(a, axis=1) for a in (q, k, v, logf))
    o, s_final = hgrn_chunk_scan(q, k, v, logf, s0)
    if reverse:
        o = jnp.flip(o, axis=1)
    return o, s_final


def hgrn_readout(o, g, w):
    y = rmsnorm(o, w).reshape(o.shape[0], o.shape[1], MIX_W).astype(g.dtype)
    return y * jax.nn.silu(g)


def short_conv_branch(bg, cg, u, w):
    y = lax.conv_general_dilated(cg * u, w[:, None, :], window_strides=(1,), padding='SAME',
                                 dimension_numbers=('NWC', 'WIO', 'NWC'),
                                 feature_group_count=CONV_W)
    return bg * y


def diff_lambda(lam_p, lam_init):
    lp = lam_p.astype(jnp.float32)
    return jnp.exp(jnp.sum(lp[0] * lp[1])) - jnp.exp(jnp.sum(lp[2] * lp[3])) + lam_init


def diff_attention(q, k, v, lam):
    s = jnp.einsum('bqhpd,bshpd->bhpqs', q, k).astype(jnp.float32) * (DA_HEAD_DIM ** -0.5)
    p = jax.nn.softmax(s, axis=-1)
    w = (p[:, :, 0] - lam * p[:, :, 1]).astype(v.dtype)
    return jnp.einsum('bhqs,bshe->bqhe', w, v)


def da_readout(o, w, lam_init):
    return rmsnorm(o, w).reshape(o.shape[0], o.shape[1], MIX_W) * (1 - lam_init)


def merge_branches(branches, gates, w_branch, w_out):
    y = sum(jax.nn.sigmoid(g) * (br @ w_branch[i]) for i, (br, g) in enumerate(zip(branches, gates)))
    return y @ w_out


def token_mixer(xc, xl, w_in, lb_f, lb_b, hg_norm_w, conv_w, lam_p, lam_init, da_norm_w,
                w_branch, w_out, rope_cos, rope_sin, need_ctx):
    b, n, _ = xl.shape
    (hq_l, hf_l, hb_l, hi_l, hg_l, cb_l, cc_l, cu_l, aq_l, ak_l, av_l, ga_l, gb_l, gc_l) = split_cols(xl @ w_in)
    (hq_c, hf_c, hb_c, hi_c, hg_c, cb_c, cc_c, cu_c, aq_c, ak_c, av_c, ga_c, gb_c, gc_c) = split_cols(xc @ w_in)

    def hd(a):
        return a.reshape(a.shape[0], a.shape[1], HG_HEADS, -1)

    def qh(a):
        return a.reshape(a.shape[0], a.shape[1], DA_HEADS, 2, DA_HEAD_DIM)

    def vh(a):
        return a.reshape(a.shape[0], a.shape[1], DA_HEADS, DA_V_DIM)

    s0 = jnp.zeros((b, HG_HEADS, HG_DK, HG_DV), jnp.float32)
    o_cf, s_f = hgrn_direction(hd(hq_c), hd(hf_c), hd(hi_c), lb_f, s0, False)
    o_cb, s_b = hgrn_direction(hd(hq_c), hd(hb_c), hd(hi_c), lb_b, s0, True)
    o_lf, _ = hgrn_direction(hd(hq_l), hd(hf_l), hd(hi_l), lb_f, s_f, False)
    o_lb, _ = hgrn_direction(hd(hq_l), hd(hb_l), hd(hi_l), lb_b, s_b, True)
    a_lat = hgrn_readout(o_lf + o_lb, hg_l, hg_norm_w)

    b_lat = short_conv_branch(cb_l, cc_l, cu_l, conv_w)

    lam = diff_lambda(lam_p, lam_init)
    k_c, v_c = qh(ak_c), vh(av_c)
    q_l = apply_axial_rope(qh(aq_l), rope_cos, rope_sin)
    k_l = apply_axial_rope(qh(ak_l), rope_cos, rope_sin)
    k_all = jnp.concatenate([k_c, k_l], axis=1)
    v_all = jnp.concatenate([v_c, vh(av_l)], axis=1)
    nb = n // Q_BLOCK
    q_blocks = q_l.reshape(b, nb, Q_BLOCK, DA_HEADS, 2, DA_HEAD_DIM).swapaxes(0, 1)
    o_blocks = lax.map(lambda qb: diff_attention(qb, k_all, v_all, lam), q_blocks)
    o_l = o_blocks.swapaxes(0, 1).reshape(b, n, DA_HEADS, DA_V_DIM)
    c_lat = da_readout(o_l, da_norm_w, lam_init)

    y_lat = merge_branches((a_lat, b_lat, c_lat), (ga_l, gb_l, gc_l), w_branch, w_out)
    if not need_ctx:
        return y_lat, None
    a_ctx = hgrn_readout(o_cf + o_cb, hg_c, hg_norm_w)
    b_ctx = short_conv_branch(cb_c, cc_c, cu_c, conv_w)
    c_ctx_out = da_readout(diff_attention(qh(aq_c), k_c, v_c, lam), da_norm_w, lam_init)
    y_ctx = merge_branches((a_ctx, b_ctx, c_ctx_out), (ga_c, gb_c, gc_c), w_branch, w_out)
    return y_lat, y_ctx


def setup_inputs(seed: int = 0) -> dict:
    key = jax.random.key(seed)
    ks = jax.random.split(key, 18)

    def nrm(k, shape, std):
        return jax.random.normal(k, shape, jnp.float32) * std

    return {
        'x': nrm(ks[0], (BATCH, SEQ, D_MODEL), 1.0),
        'c': nrm(ks[1], (BATCH, D_MODEL), 1.0),
        'ctx': nrm(ks[2], (BATCH, CTX_LEN, D_MODEL), 1.0),
        'c_ctx': nrm(ks[3], (D_MODEL,), 1.0),
        'w_ada': nrm(ks[4], (DEPTH, D_MODEL, N_MOD * D_MODEL), 0.5 * D_MODEL ** -0.5),
        'b_ada': nrm(ks[5], (DEPTH, N_MOD * D_MODEL), 0.02),
        'norm_w': 1.0 + nrm(ks[6], (DEPTH, 3, D_MODEL), 0.02),
        'ffn_w13': nrm(ks[7], (DEPTH, 2, D_MODEL, 2 * D_FF), D_MODEL ** -0.5),
        'ffn_w2': nrm(ks[8], (DEPTH, 2, D_FF, D_MODEL), D_FF ** -0.5),
        'w_in': nrm(ks[9], (DEPTH, D_MODEL, W_IN_COLS), D_MODEL ** -0.5),
        'hgrn_lb': nrm(ks[10], (2, DEPTH, HG_KEY_W), 0.5),
        'hgrn_norm_w': 1.0 + nrm(ks[11], (DEPTH, HG_DV), 0.02),
        'conv_w': nrm(ks[12], (DEPTH, CONV_K, CONV_W), CONV_K ** -0.5),
        'da_lambda': nrm(ks[13], (DEPTH, 4, DA_HEAD_DIM), 0.1),
        'da_norm_w': 1.0 + nrm(ks[14], (DEPTH, DA_V_DIM), 0.02),
        'w_branch': nrm(ks[15], (DEPTH, N_BRANCH, MIX_W, D_MODEL), MIX_W ** -0.5),
        'w_out': nrm(ks[16], (DEPTH, D_MODEL, D_MODEL), D_MODEL ** -0.5),
        'final_norm_w': 1.0 + nrm(ks[17], (D_MODEL,), 0.02),
    }


def reference(x, c, ctx, c_ctx, w_ada, b_ada, norm_w, ffn_w13, ffn_w2, w_in, hgrn_lb,
              hgrn_norm_w, conv_w, da_lambda, da_norm_w, w_branch, w_out, final_norm_w):
    n_tokens = x.shape[1]
    rope_cos, rope_sin = axial_rope_tables(n_tokens)
    lower_bounds = hgrn_lower_bounds(hgrn_lb)
    silu_c = jax.nn.silu(c)
    silu_cc = jax.nn.silu(c_ctx)
    h_lat, h_ctx = x, ctx
    for layer in range(DEPTH):
        last = layer == DEPTH - 1
        lam_init = 0.8 - 0.6 * math.exp(-0.3 * layer)
        m_lat = jnp.split((silu_c @ w_ada[layer] + b_ada[layer])[:, None, :], N_MOD, axis=-1)
        m_ctx = jnp.split((silu_cc @ w_ada[layer] + b_ada[layer])[None, None, :], N_MOD, axis=-1)
        h_lat = half_ffn(h_lat, norm_w[layer, 0], m_lat[0], m_lat[1], m_lat[2],
                         ffn_w13[layer, 0], ffn_w2[layer, 0])
        h_ctx = half_ffn(h_ctx, norm_w[layer, 0], m_ctx[0], m_ctx[1], m_ctx[2],
                         ffn_w13[layer, 0], ffn_w2[layer, 0])
        xl = modulate(rmsnorm(h_lat, norm_w[layer, 1]), m_lat[3], m_lat[4])
        xc = modulate(rmsnorm(h_ctx, norm_w[layer, 1]), m_ctx[3], m_ctx[4])
        y_lat, y_ctx = token_mixer(xc, xl, w_in[layer], lower_bounds[0, layer], lower_bounds[1, layer],
                                   hgrn_norm_w[layer], conv_w[layer], da_lambda[layer], lam_init,
                                   da_norm_w[layer], w_branch[layer], w_out[layer],
                                   rope_cos, rope_sin, not last)
        h_lat = h_lat + m_lat[5] * y_lat
        h_lat = half_ffn(h_lat, norm_w[layer, 2], m_lat[6], m_lat[7], m_lat[8],
                         ffn_w13[layer, 1], ffn_w2[layer, 1])
        if not last:
            h_ctx = h_ctx + m_ctx[5] * y_ctx
            h_ctx = half_ffn(h_ctx, norm_w[layer, 2], m_ctx[6], m_ctx[7], m_ctx[8],
                             ffn_w13[layer, 1], ffn_w2[layer, 1])
    return rmsnorm(h_lat, final_norm_w)
```

```cpp
#include <hip/hip_runtime.h>
#include <cstdio>
#include <cstdint>
namespace pg8 {
#define PG8_LAS __attribute__((address_space(3)))
typedef unsigned short bf16_t;
typedef short bf16x8 __attribute__((ext_vector_type(8)));
typedef float f32x4 __attribute__((ext_vector_type(4)));
typedef unsigned u32x4 __attribute__((ext_vector_type(4)));
constexpr int BM = 256, BK = 64, HALF = 128, HTB = HALF * BK * 2  , STAGE_BYTES = 8 * HTB, NXCD = 8, WGM = 8;

__host__ __device__ __forceinline__ int lds_byte(int r, int c) { const int st = (r >> 4) * 2 + (c >> 5), rr = r & 15, cc = c & 31, ob = rr * 64 + cc * 2; return st * 1024 + (ob ^ (((ob >> 9) & 1) << 5)); }
__host__ __device__ __forceinline__ void stage_rc(int b, int& R, int& C) { const int st = b / 1024, sb = b % 1024, swz = sb ^ (((sb >> 9) & 1) << 5); R = (st >> 1) * 16 + swz / 64; C = (st & 1) * 32 + (swz % 64) / 2; }
__host__ __device__ __forceinline__ int perm32(int rho) { const int n = rho >> 4, i = rho & 15; return 8 * (i >> 2) + 4 * n + (i & 3); }

struct Unit { int pm, pn; };
struct Gemm { const bf16_t* A; const bf16_t* Bt; int M, N, K; };

struct StaticOrder {
    int nM, nN, nwg, G, c;
    __host__ __device__ void init(int M, int N, int G_, int c_) { nM = M / BM; nN = N / BM; nwg = nM * nN; G = G_; c = c_; }
    __host__ __device__ bool next(int i, Unit& u) const {
        const long L = (long)i * G + c; if (L >= nwg) return false;
        int wgid = (int)L; { const int q = nwg / NXCD, r = nwg % NXCD, xcd = wgid % NXCD, off = wgid / NXCD; wgid = (xcd < r ? xcd * (q + 1) : r * (q + 1) + (xcd - r) * q) + off; }
        const int nig = WGM * nN, gid = wgid / nig, fm = gid * WGM, gsz = (nM - fm) < WGM ? (nM - fm) : WGM;
        u.pm = fm + ((wgid % nig) % gsz); u.pn = (wgid % nig) / gsz; return true;
    }
    __device__ __forceinline__ void a_ready(const Unit&) const {}
    __device__ __forceinline__ void done(const Unit&) const {}
};

__device__ __forceinline__ unsigned cvt_pk_bf16(float lo, float hi) { unsigned r; asm volatile("v_cvt_pk_bf16_f32 %0, %1, %2" : "=v"(r) : "v"(lo), "v"(hi)); return r; }
__device__ __forceinline__ float silu_f(float x) { return x * __builtin_amdgcn_rcpf(1.0f + __expf(-x)); }
__device__ __forceinline__ float sigm_f(float x) { return __builtin_amdgcn_rcpf(1.0f + __expf(-x)); }
__device__ __forceinline__ float bfbits2f(unsigned short b) { return __uint_as_float(((unsigned)b) << 16); }
typedef unsigned u32x2 __attribute__((ext_vector_type(2)));
constexpr int MODW = 18432;
constexpr int NLAT = 16384;
constexpr int DM = 2048;

struct EpiStoreBf16 {
    static constexpr bool PERM = true, AFTER_DRAIN = false;
    bf16_t* O; int ldc;
    __device__ __forceinline__ void operator()(const f32x4 (&acc)[2][2][4][2], const Unit& u, int wr, int wc, int fr, int fq) const {
        const int row0 = u.pm * BM + wr * 64 + fr; const int col0 = u.pn * BM + wc * 32 + 8 * fq;
#pragma unroll
        for (int ai = 0; ai < 2; ++ai)
#pragma unroll
            for (int m = 0; m < 4; ++m) { bf16_t* rowp = O + (size_t)(row0 + ai * HALF + m * 16) * ldc + col0;
#pragma unroll
                for (int bj = 0; bj < 2; ++bj) { const f32x4 v0 = acc[ai][bj][m][0], v1 = acc[ai][bj][m][1];
                    u32x4 w; w.x = cvt_pk_bf16(v0[0], v0[1]); w.y = cvt_pk_bf16(v0[2], v0[3]); w.z = cvt_pk_bf16(v1[0], v1[1]); w.w = cvt_pk_bf16(v1[2], v1[3]);
                    *(u32x4*)(rowp + bj * HALF) = w; } }
    }
};
struct EpiSwiglu {
    static constexpr bool PERM = true, AFTER_DRAIN = false;
    bf16_t* O; int ldc;
    __device__ __forceinline__ void operator()(const f32x4 (&acc)[2][2][4][2], const Unit& u, int wr, int wc, int fr, int fq) const {
        const int row0 = u.pm * BM + wr * 64 + fr; const int col0 = u.pn * HALF + wc * 32 + 8 * fq;
#pragma unroll
        for (int ai = 0; ai < 2; ++ai)
#pragma unroll
            for (int m = 0; m < 4; ++m) { bf16_t* rowp = O + (size_t)(row0 + ai * HALF + m * 16) * ldc + col0;
                const f32x4 g0 = acc[ai][0][m][0], g1 = acc[ai][0][m][1], u0 = acc[ai][1][m][0], u1 = acc[ai][1][m][1];
                float r[8];
#pragma unroll
                for (int i = 0; i < 4; ++i) { r[i] = silu_f(g0[i]) * u0[i]; r[4 + i] = silu_f(g1[i]) * u1[i]; }
                u32x4 w; w.x = cvt_pk_bf16(r[0], r[1]); w.y = cvt_pk_bf16(r[2], r[3]); w.z = cvt_pk_bf16(r[4], r[5]); w.w = cvt_pk_bf16(r[6], r[7]);
                *(u32x4*)rowp = w; }
    }
};
struct EpiResid {
    static constexpr bool PERM = false, AFTER_DRAIN = false;
    const float* baseL; const float* baseC; float* outL; float* outC; const float* coef; float mul;
    __device__ __forceinline__ void operator()(const f32x4 (&acc)[2][2][4][2], const Unit& u, int wr, int wc, int fr, int fq) const {
        const int g = u.pm < 32 ? 0 : (u.pm < 64 ? 1 : 2);
        const bool lat = u.pm < 64;
        const float* bp = lat ? baseL : baseC; float* op = lat ? outL : outC;
        const int rsub = lat ? 0 : NLAT;
        const int col0 = u.pn * BM + wc * 32 + 4 * fq;
        f32x4 cf[2][2];
#pragma unroll
        for (int bj = 0; bj < 2; ++bj)
#pragma unroll
            for (int n = 0; n < 2; ++n) cf[bj][n] = *(const f32x4*)(coef + (size_t)g * MODW + col0 + bj * HALF + n * 16) * mul;
#pragma unroll
        for (int ai = 0; ai < 2; ++ai)
#pragma unroll
            for (int m = 0; m < 4; ++m) { const int r = u.pm * BM + ai * HALF + wr * 64 + m * 16 + fr - rsub; const size_t off = (size_t)r * DM + col0;
#pragma unroll
                for (int bj = 0; bj < 2; ++bj)
#pragma unroll
                    for (int n = 0; n < 2; ++n) { const f32x4 bs = *(const f32x4*)(bp + off + bj * HALF + n * 16);
                        *(f32x4*)(op + off + bj * HALF + n * 16) = bs + cf[bj][n] * acc[ai][bj][m][n]; }
                if (m & 1) asm volatile("" ::: "memory"); }
    }
};
template <int MODE> struct EpiMerge {
    static constexpr bool PERM = false, AFTER_DRAIN = false;
    const bf16_t* gate; int ldg; float* y32; bf16_t* ybf;
    __device__ __forceinline__ void operator()(const f32x4 (&acc)[2][2][4][2], const Unit& u, int wr, int wc, int fr, int fq) const {
        const int col0 = u.pn * BM + wc * 32 + 4 * fq;
#pragma unroll
        for (int ai = 0; ai < 2; ++ai)
#pragma unroll
            for (int m = 0; m < 4; ++m) { const int r = u.pm * BM + ai * HALF + wr * 64 + m * 16 + fr; const size_t off = (size_t)r * DM + col0; const bf16_t* gp = gate + (size_t)r * ldg + col0;
#pragma unroll
                for (int bj = 0; bj < 2; ++bj)
#pragma unroll
                    for (int n = 0; n < 2; ++n) { const int co = bj * HALF + n * 16;
                        const u32x2 gv = *(const u32x2*)(gp + co);
                        f32x4 s; s[0] = sigm_f(__uint_as_float(gv.x << 16)); s[1] = sigm_f(__uint_as_float(gv.x & 0xffff0000u)); s[2] = sigm_f(__uint_as_float(gv.y << 16)); s[3] = sigm_f(__uint_as_float(gv.y & 0xffff0000u));
                        f32x4 val = s * acc[ai][bj][m][n];
                        if (MODE == 0) { *(f32x4*)(y32 + off + co) = val; }
                        else if (MODE == 1) { *(f32x4*)(y32 + off + co) = *(const f32x4*)(y32 + off + co) + val; }
                        else { val = val + *(const f32x4*)(y32 + off + co); u32x2 w; w.x = cvt_pk_bf16(val[0], val[1]); w.y = cvt_pk_bf16(val[2], val[3]); *(u32x2*)(ybf + off + co) = w; } }
                if (m & 1) asm volatile("" ::: "memory"); }
    }
};

template <class Epi, class Sched, bool ALIGN_EPI = false, bool SP2 = false>
__device__ __forceinline__ void gemm_phase(PG8_LAS unsigned char* lds, const Gemm g, const Sched& S, const Epi& E) {
    int tid_ = threadIdx.x; asm volatile("" : "+v"(tid_)); const int tid = tid_, wid = __builtin_amdgcn_readfirstlane(tid >> 6), lane = tid & 63, wr = wid >> 2, wc = wid & 3, fr = lane & 15, fq = lane >> 4;
    const int K = g.K, nt = K / BK;
    unsigned voffA[2], voffB[2];
#pragma unroll
    for (int i = 0; i < 2; ++i) { int R, C; stage_rc(tid * 16 + i * 8192, R, C); const int Rb = Epi::PERM ? ((R & ~31) + perm32(R & 31)) : R;
        voffA[i] = (unsigned)(R * K + C) * 2u; voffB[i] = (unsigned)(Rb * K + C) * 2u; }
    const size_t kstep = (size_t)(BK * 2);
    const size_t hstep = (size_t)HALF * K * 2;
    const size_t tstep = 2 * hstep;
    const unsigned ldsw = (unsigned)wid * 1024u;
    const int aoff = lds_byte(wr * 64 + fr, fq * 8), boff = lds_byte(wc * 32 + fr, fq * 8);
#define PG8_SA(b, h) (((b) * 2 + (h)) * HTB)
#define PG8_SB(b, h) ((4 + (b) * 2 + (h)) * HTB)
#define PG8_STAGE(bufoff, gbase, voff) do { _Pragma("unroll") for (int _i = 0; _i < 2; ++_i) \
        __builtin_amdgcn_global_load_lds((const unsigned*)((const char*)(gbase) + (voff)[_i]), (PG8_LAS unsigned*)(lds + (bufoff) + ldsw + _i * 8192), 16, 0, 0); } while (0)
#define PG8_LDA(dst, b, h) do { _Pragma("unroll") for (int m = 0; m < 4; ++m) _Pragma("unroll") for (int k = 0; k < 2; ++k) dst[m][k] = *(const PG8_LAS bf16x8*)(lds + PG8_SA(b, h) + aoff + m * 2048 + k * 1024); } while (0)
#define PG8_LDB(dst, b, h) do { _Pragma("unroll") for (int n = 0; n < 2; ++n) _Pragma("unroll") for (int k = 0; k < 2; ++k) dst[n][k] = *(const PG8_LAS bf16x8*)(lds + PG8_SB(b, h) + boff + n * 2048 + k * 1024); } while (0)
#define PG8_MMA(ai, bj, At, Bt) do { __builtin_amdgcn_s_setprio(1); _Pragma("unroll") for (int m = 0; m < 4; ++m) _Pragma("unroll") for (int n = 0; n < 2; ++n) _Pragma("unroll") for (int k = 0; k < 2; ++k) \
        acc[ai][bj][m][n] = __builtin_amdgcn_mfma_f32_16x16x32_bf16(Bt[n][k], At[m][k], acc[ai][bj][m][n], 0, 0, 0); __builtin_amdgcn_s_setprio(0); } while (0)
#define PG8_WAIT_V(n) asm volatile("s_waitcnt vmcnt(" #n ")" ::: "memory")
#define PG8_WAIT_L(n) asm volatile("s_waitcnt lgkmcnt(" #n ")" ::: "memory")
#define PG8_BAR __builtin_amdgcn_s_barrier()
#define PG8_SCHED __builtin_amdgcn_sched_barrier(0)
    Unit cur, nxt; int ui = 0;
    if (!S.next(0, cur)) return;
    f32x4 acc[2][2][4][2];
#pragma unroll
    for (int a = 0; a < 2; ++a)
#pragma unroll
        for (int b = 0; b < 2; ++b)
#pragma unroll
            for (int m = 0; m < 4; ++m)
#pragma unroll
                for (int n = 0; n < 2; ++n) acc[a][b][m][n] = (f32x4){0.f, 0.f, 0.f, 0.f};
    bf16x8 At[4][2], B0[2][2], B1[2][2];
    const char* cA = (const char*)g.A + (size_t)cur.pm * tstep; const char* cB = (const char*)g.Bt + (size_t)cur.pn * tstep;
    S.a_ready(cur);
    if constexpr (SP2) {
        PG8_STAGE(PG8_SB(0, 0), cB, voffB); PG8_STAGE(PG8_SB(0, 1), cB + hstep, voffB); PG8_STAGE(PG8_SA(0, 0), cA, voffA); PG8_STAGE(PG8_SA(0, 1), cA + hstep, voffA);
        if (wr == 1) PG8_BAR;
        PG8_WAIT_V(2); PG8_BAR;
        PG8_STAGE(PG8_SB(1, 0), cB + kstep, voffB); PG8_STAGE(PG8_SA(1, 0), cA + kstep, voffA); PG8_STAGE(PG8_SB(1, 1), cB + hstep + kstep, voffB);
        PG8_WAIT_V(6); PG8_BAR;
    } else {
        PG8_STAGE(PG8_SB(0, 0), cB, voffB); PG8_STAGE(PG8_SA(0, 0), cA, voffA); PG8_STAGE(PG8_SB(0, 1), cB + hstep, voffB); PG8_STAGE(PG8_SA(0, 1), cA + hstep, voffA);
        if (wr == 1) PG8_BAR;
        PG8_WAIT_V(4); PG8_BAR;
        PG8_STAGE(PG8_SB(1, 0), cB + kstep, voffB); PG8_STAGE(PG8_SA(1, 0), cA + kstep, voffA); PG8_STAGE(PG8_SB(1, 1), cB + hstep + kstep, voffB);
        PG8_WAIT_V(6); PG8_BAR;
    }
    for (;;) {
        const bool has_next = S.next(ui + 1, nxt);
        const char* nA = has_next ? (const char*)g.A + (size_t)nxt.pm * tstep : cA; const char* nB = has_next ? (const char*)g.Bt + (size_t)nxt.pn * tstep : cB;
        for (int t = 0; t < nt; t += 2) {
            const bool last = (t == nt - 2);
            const char* a1 = cA + (size_t)(t + 1) * kstep;
            const char* a2 = last ? nA : cA + (size_t)(t + 2) * kstep; const char* b2 = last ? nB : cB + (size_t)(t + 2) * kstep;
            const char* a3 = a2 + kstep; const char* b3 = b2 + kstep;
            if (last && has_next) S.a_ready(nxt);
            if constexpr (SP2) {
            PG8_LDB(B0, 0, 0); PG8_LDB(B1, 0, 1); PG8_SCHED; PG8_LDA(At, 0, 0); PG8_STAGE(PG8_SA(1, 1), a1 + hstep, voffA);
            PG8_WAIT_V(8); PG8_WAIT_L(0); PG8_BAR; PG8_MMA(0, 0, At, B0); PG8_MMA(0, 1, At, B1); PG8_BAR; PG8_SCHED;
            PG8_LDA(At, 0, 1); PG8_STAGE(PG8_SB(0, 0), b2, voffB); PG8_STAGE(PG8_SB(0, 1), b2 + hstep, voffB); PG8_STAGE(PG8_SA(0, 0), a2, voffA);
            PG8_WAIT_V(8); PG8_WAIT_L(0); PG8_BAR; PG8_MMA(1, 0, At, B0); PG8_MMA(1, 1, At, B1); PG8_BAR; PG8_SCHED;
            PG8_LDB(B0, 1, 0); PG8_LDB(B1, 1, 1); PG8_SCHED; PG8_LDA(At, 1, 0); PG8_STAGE(PG8_SA(0, 1), a2 + hstep, voffA);
            PG8_WAIT_V(8); PG8_WAIT_L(0); PG8_BAR; PG8_MMA(0, 0, At, B0); PG8_MMA(0, 1, At, B1); PG8_BAR; PG8_SCHED;
            PG8_LDA(At, 1, 1); PG8_STAGE(PG8_SB(1, 0), b3, voffB); PG8_STAGE(PG8_SB(1, 1), b3 + hstep, voffB); PG8_STAGE(PG8_SA(1, 0), a3, voffA);
            PG8_WAIT_V(8); PG8_WAIT_L(0); PG8_BAR; PG8_MMA(1, 0, At, B0); PG8_MMA(1, 1, At, B1); PG8_BAR; PG8_SCHED;
            } else {
            PG8_LDB(B0, 0, 0); PG8_SCHED; PG8_LDA(At, 0, 0); PG8_STAGE(PG8_SA(1, 1), a1 + hstep, voffA);
            PG8_WAIT_L(8); PG8_BAR; PG8_WAIT_L(0); PG8_MMA(0, 0, At, B0); PG8_BAR; PG8_SCHED;
            PG8_LDB(B1, 0, 1); PG8_STAGE(PG8_SB(0, 0), b2, voffB);
            PG8_BAR; PG8_WAIT_L(0); PG8_MMA(0, 1, At, B1); PG8_BAR;
            PG8_LDA(At, 0, 1); PG8_STAGE(PG8_SA(0, 0), a2, voffA);
            PG8_BAR; PG8_WAIT_L(0); PG8_MMA(1, 0, At, B0); PG8_BAR; PG8_SCHED;
            PG8_STAGE(PG8_SB(0, 1), b2 + hstep, voffB);
            PG8_WAIT_V(6); PG8_BAR; PG8_MMA(1, 1, At, B1); PG8_BAR;
            PG8_LDB(B0, 1, 0); PG8_SCHED; PG8_LDA(At, 1, 0); PG8_STAGE(PG8_SA(0, 1), a2 + hstep, voffA);
            PG8_WAIT_L(8); PG8_BAR; PG8_WAIT_L(0); PG8_MMA(0, 0, At, B0); PG8_BAR; PG8_SCHED;
            PG8_LDB(B1, 1, 1); PG8_STAGE(PG8_SB(1, 0), b3, voffB);
            PG8_BAR; PG8_WAIT_L(0); PG8_MMA(0, 1, At, B1); PG8_BAR;
            PG8_LDA(At, 1, 1); PG8_STAGE(PG8_SA(1, 0), a3, voffA);
            PG8_BAR; PG8_WAIT_L(0); PG8_MMA(1, 0, At, B0); PG8_BAR; PG8_SCHED;
            PG8_STAGE(PG8_SB(1, 1), b3 + hstep, voffB);
            PG8_WAIT_V(6); PG8_BAR; PG8_MMA(1, 1, At, B1); PG8_BAR;
            }
        }
        if constexpr (ALIGN_EPI) { if (wr == 0) PG8_BAR; }
        if constexpr (!Epi::AFTER_DRAIN) { E(acc, cur, wr, wc, fr, fq); S.done(cur); }
        if (!has_next) break;
#pragma unroll
        for (int a = 0; a < 2; ++a)
#pragma unroll
            for (int b = 0; b < 2; ++b)
#pragma unroll
                for (int m = 0; m < 4; ++m)
#pragma unroll
                    for (int n = 0; n < 2; ++n) acc[a][b][m][n] = (f32x4){0.f, 0.f, 0.f, 0.f};
        cur = nxt; cA = nA; cB = nB; ++ui;
        if constexpr (ALIGN_EPI) { if (wr == 1) PG8_BAR; }
    }
    PG8_WAIT_V(0);
    if constexpr (!ALIGN_EPI) { if (wr == 0) PG8_BAR; }
    PG8_BAR;
    if constexpr (Epi::AFTER_DRAIN) { E.fused(acc, cur, wr, wc, fr, fq, lds, wid, lane); S.done(cur); }
#undef PG8_SA
#undef PG8_SB
#undef PG8_STAGE
#undef PG8_LDA
#undef PG8_LDB
#undef PG8_MMA
#undef PG8_WAIT_V
#undef PG8_WAIT_L
#undef PG8_BAR
#undef PG8_SCHED
}
}
namespace att {
typedef unsigned short bf16;
using bf16x8 = __attribute__((ext_vector_type(8))) short;
using s16x4  = __attribute__((ext_vector_type(4))) short;
using f32x16 = __attribute__((ext_vector_type(16))) float;
using u32x4  = __attribute__((ext_vector_type(4))) unsigned;
constexpr int NW = 8, QBLK = 32, KVBLK = 64;
constexpr float SCALE = 0.125f;
constexpr float THR = 8.f;
constexpr int LDP = 17408;
constexpr int LDO = 1024;
constexpr size_t SHM_V = KVBLK * 128 * 2, SHM_K = KVBLK * 64 * 2, SHM_ATTN = 2 * SHM_V + 2 * SHM_K + NW * 64 * 4;
#define KSWZ64(row, colB) ((row) * 128 + ((colB) ^ ((((row) >> 1) & 7) << 4)))
#define SBAR() __builtin_amdgcn_sched_barrier(0)
__device__ __forceinline__ int crow(int r, int hi) { return (r & 3) + 8 * (r >> 2) + 4 * hi; }
__device__ __forceinline__ unsigned cvtpk(float lo, float hi) { unsigned r; asm volatile("v_cvt_pk_bf16_f32 %0, %1, %2" : "=v"(r) : "v"(lo), "v"(hi)); return r; }
__device__ __forceinline__ bf16x8 ld8(const bf16* p) { return *reinterpret_cast<const bf16x8*>(p); }

__device__ __forceinline__ void partialSM(f32x16& p0, f32x16& p1, float& m_reg, float& mn, float& alpha) {
  constexpr float C = SCALE * 1.4426950408889634f;
  float pmax = p0[0];
#pragma unroll
  for (int r = 1; r < 16; ++r) pmax = fmaxf(pmax, p0[r]);
#pragma unroll
  for (int r = 0; r < 16; ++r) pmax = fmaxf(pmax, p1[r]);
  { auto rr = __builtin_amdgcn_permlane32_swap(__float_as_uint(pmax), __float_as_uint(pmax), false, false);
    pmax = fmaxf(__uint_as_float(rr[0]), __uint_as_float(rr[1])); }
  if (__builtin_expect(__all(pmax - m_reg <= THR / SCALE), 1)) { mn = m_reg; alpha = 1.f; }
  else { mn = fmaxf(m_reg, pmax); alpha = __builtin_amdgcn_exp2f((m_reg - mn) * C); m_reg = mn; }
  float mnC = -mn * C;
#pragma unroll
  for (int r = 0; r < 16; ++r) p0[r] = fmaf(p0[r], C, mnC);
#pragma unroll
  for (int r = 0; r < 16; ++r) p1[r] = fmaf(p1[r], C, mnC);
#pragma unroll
  for (int r = 0; r < 16; ++r) p0[r] = __builtin_amdgcn_exp2f(p0[r]);
}
__device__ __forceinline__ void finishSM(f32x16& p0, f32x16& p1, float alpha, float& l_reg, bf16x8& pa0, bf16x8& pa1, bf16x8& pa2, bf16x8& pa3) {
#pragma unroll
  for (int r = 0; r < 16; ++r) p1[r] = __builtin_amdgcn_exp2f(p1[r]);
  float ps = 0;
#pragma unroll
  for (int r = 0; r < 16; ++r) ps += p0[r];
#pragma unroll
  for (int r = 0; r < 16; ++r) ps += p1[r];
  { auto rr = __builtin_amdgcn_permlane32_swap(__float_as_uint(ps), __float_as_uint(ps), false, false);
    ps = __uint_as_float(rr[0]) + __uint_as_float(rr[1]); }
  l_reg = l_reg * alpha + ps;
#define PK4(P, BASE, OUT) do { unsigned a0 = cvtpk(P[BASE + 0], P[BASE + 1]), a1 = cvtpk(P[BASE + 2], P[BASE + 3]);   \
    unsigned b0 = cvtpk(P[BASE + 4], P[BASE + 5]), b1 = cvtpk(P[BASE + 6], P[BASE + 7]);                              \
    auto r0 = __builtin_amdgcn_permlane32_swap(a0, b0, false, false); auto r1 = __builtin_amdgcn_permlane32_swap(a1, b1, false, false); \
    u32x4 w = {r0[0], r1[0], r0[1], r1[1]}; OUT = *reinterpret_cast<bf16x8*>(&w); } while (0)
  PK4(p0, 0, pa0); PK4(p0, 8, pa1); PK4(p1, 0, pa2); PK4(p1, 8, pa3);
#undef PK4
}
__device__ __forceinline__ void qkt(f32x16& p0, f32x16& p1, const bf16* Ks, const bf16x8* qr, int r32, int hi) {
  p0 = f32x16{}; p1 = f32x16{};
#pragma unroll
  for (int d0 = 0; d0 < 4; ++d0) { int cb = (d0 * 16 + hi * 8) * 2;
    bf16x8 b0 = *reinterpret_cast<const bf16x8*>((const char*)Ks + KSWZ64(r32, cb));
    bf16x8 b1 = *reinterpret_cast<const bf16x8*>((const char*)Ks + KSWZ64(32 + r32, cb));
    p0 = __builtin_amdgcn_mfma_f32_32x32x16_bf16(b0, qr[d0], p0, 0, 0, 0);
    p1 = __builtin_amdgcn_mfma_f32_32x32x16_bf16(b1, qr[d0], p1, 0, 0, 0); }
}
__device__ __forceinline__ int v_st(int k, int c) { const int kk = (k & ~0xC) | ((k & 4) << 1) | ((k & 8) >> 1); return ((kk >> 3) * 4 + (c >> 5)) * 512 + ((kk & 7) * 32 + (c & 31)) * 2; }
__device__ __forceinline__ int v_rd_base(int lane) { return ((lane & 3) << 3) | (((lane >> 2) & 3) << 6) | (((lane >> 4) & 1) << 5) | (((lane >> 5) & 1) << 8); }
constexpr int v_rd_off(int d0, int ks, int half) { return d0 * 512 + ks * 4096 + half * 2048; }
template <int OFF> __device__ __forceinline__ s16x4 tr_read(int vb) {
  s16x4 r; asm volatile("ds_read_b64_tr_b16 %0, %1 offset:%2" : "=&v"(r) : "v"(vb), "i"(OFF) : "memory"); return r;
}
template <int D0> __device__ __forceinline__ void pv_one(f32x16& od, int vb, bf16x8 pa0, bf16x8 pa1, bf16x8 pa2, bf16x8 pa3) {
  const s16x4 l0 = tr_read<v_rd_off(D0, 0, 0)>(vb), h0 = tr_read<v_rd_off(D0, 0, 1)>(vb), l1 = tr_read<v_rd_off(D0, 1, 0)>(vb), h1 = tr_read<v_rd_off(D0, 1, 1)>(vb);
  const s16x4 l2 = tr_read<v_rd_off(D0, 2, 0)>(vb), h2 = tr_read<v_rd_off(D0, 2, 1)>(vb), l3 = tr_read<v_rd_off(D0, 3, 0)>(vb), h3 = tr_read<v_rd_off(D0, 3, 1)>(vb);
  asm volatile("s_waitcnt lgkmcnt(0)" ::: "memory"); SBAR();
#define PK(L, H) (bf16x8){L[0], L[1], L[2], L[3], H[0], H[1], H[2], H[3]}
  od = __builtin_amdgcn_mfma_f32_32x32x16_bf16(pa0, PK(l0, h0), od, 0, 0, 0);
  od = __builtin_amdgcn_mfma_f32_32x32x16_bf16(pa1, PK(l1, h1), od, 0, 0, 0);
  od = __builtin_amdgcn_mfma_f32_32x32x16_bf16(pa2, PK(l2, h2), od, 0, 0, 0);
  od = __builtin_amdgcn_mfma_f32_32x32x16_bf16(pa3, PK(l3, h3), od, 0, 0, 0);
#undef PK
}
__device__ __forceinline__ void pv_d0(f32x16* o, int vb, bf16x8 pa0, bf16x8 pa1, bf16x8 pa2, bf16x8 pa3) {
  pv_one<0>(o[0], vb, pa0, pa1, pa2, pa3); pv_one<1>(o[1], vb, pa0, pa1, pa2, pa3); pv_one<2>(o[2], vb, pa0, pa1, pa2, pa3); pv_one<3>(o[3], vb, pa0, pa1, pa2, pa3);
}
__device__ __forceinline__ unsigned short f2bf_rne(float f) { unsigned u = __float_as_uint(f); return (unsigned short)((u + 0x7fffu + ((u >> 16) & 1u)) >> 16); }

__device__ __forceinline__ void attn_unit(const bf16* __restrict__ proj, int qrow0, int crow0, int lrow0, int NT, int h, int p, bf16* __restrict__ Oout, char* lds) {
  int tid_ = threadIdx.x; asm volatile("" : "+v"(tid_)); const int tid = tid_, wid = tid >> 6, lane = tid & 63, r32 = lane & 31, hi = lane >> 5;
  const int CQ = 8192 + 128 * h + 64 * p, CK = 9216 + 128 * h + 64 * p, CV = 10240 + 128 * h;
  bf16* V_lds = (bf16*)lds; bf16* K_lds = (bf16*)(lds + 2 * SHM_V);
  float* ws = (float*)(lds + 2 * SHM_V + 2 * SHM_K) + wid * 64; float* li_l = ws; float* al_l = ws + 32;
  float m_reg = -1e30f, l_reg = 0; f32x16 o[4] = {}; bf16x8 qr[4];
  const bf16* Qw = proj + (size_t)(qrow0 + wid * QBLK + r32) * LDP + CQ + hi * 8;
#pragma unroll
  for (int d0 = 0; d0 < 4; ++d0) qr[d0] = ld8(Qw + d0 * 16);
  const int sr = tid >> 4, sc = (tid & 15) * 8, vst0 = v_st(sr, sc), vst1 = v_st(32 + sr, sc);
  const int kr = tid >> 3, kc = (tid & 7) * 8, kst = KSWZ64(kr, kc * 2);
  const int vb0 = (int)(uintptr_t)V_lds + v_rd_base(lane);
  struct { bf16x8 vs0, vs1, ks0; } sr_[2];
#define TROW(jt) ((jt) < 4 ? crow0 + 64 * (jt) : lrow0 + 64 * ((jt) - 4))
#define SLOAD(i, jt) do { const size_t rb_ = (size_t)TROW(jt); sr_[i].vs0 = ld8(proj + (rb_ + sr) * LDP + CV + sc); sr_[i].vs1 = ld8(proj + (rb_ + 32 + sr) * LDP + CV + sc); \
    sr_[i].ks0 = ld8(proj + (rb_ + kr) * LDP + CK + kc); } while (0)
#define SWRITE(b, i) do { *(bf16x8*)((char*)V_lds + (b) * SHM_V + vst0) = sr_[i].vs0; *(bf16x8*)((char*)V_lds + (b) * SHM_V + vst1) = sr_[i].vs1; \
    *(bf16x8*)((char*)K_lds + (b) * SHM_K + kst) = sr_[i].ks0; } while (0)
#define SWAIT() asm volatile("s_waitcnt vmcnt(3)" ::: "memory")
#define RESC(a) do { if (__any((a) < 1.f)) { if (hi == 0) al_l[r32] = (a); asm volatile("s_waitcnt lgkmcnt(0)" ::: "memory"); \
    _Pragma("unroll") for (int d = 0; d < 4; ++d) _Pragma("unroll") for (int r = 0; r < 16; ++r) o[d][r] *= al_l[crow(r, hi)]; } } while (0)
  f32x16 pA0, pA1, pB0, pB1; float mnA, mnB, alA, alB; bf16x8 pa0, pa1, pa2, pa3;
  constexpr int SE = 0, SO = 1;
  SLOAD(SE, 0); asm volatile("s_waitcnt vmcnt(0)" ::: "memory"); SWRITE(0, SE); __syncthreads();
  qkt(pA0, pA1, K_lds, qr, r32, hi); partialSM(pA0, pA1, m_reg, mnA, alA);
  SLOAD(SO, 1); if (2 < NT) SLOAD(SE, 2);
  SWAIT(); SWRITE(1, SO); __syncthreads();
  for (int j = 1; j + 1 < NT; j += 2) {
    SBAR(); qkt(pB0, pB1, (bf16*)((char*)K_lds + SHM_K), qr, r32, hi);
    finishSM(pA0, pA1, alA, l_reg, pa0, pa1, pa2, pa3); SBAR();
    SLOAD(SO, j + 2); SBAR();
    pv_d0(o, vb0, pa0, pa1, pa2, pa3); partialSM(pB0, pB1, m_reg, mnB, alB);
    __syncthreads(); SWAIT(); SWRITE(0, SE);
    RESC(alB); __syncthreads();
    SBAR(); qkt(pA0, pA1, K_lds, qr, r32, hi);
    finishSM(pB0, pB1, alB, l_reg, pa0, pa1, pa2, pa3); SBAR();
    if (j + 3 < NT) SLOAD(SE, j + 3); SBAR();
    pv_d0(o, vb0 + (int)SHM_V, pa0, pa1, pa2, pa3); partialSM(pA0, pA1, m_reg, mnA, alA);
    __syncthreads(); SWAIT(); SWRITE(1, SO);
    RESC(alA); __syncthreads();
  }
  SBAR(); qkt(pB0, pB1, (bf16*)((char*)K_lds + SHM_K), qr, r32, hi);
  finishSM(pA0, pA1, alA, l_reg, pa0, pa1, pa2, pa3); SBAR();
  pv_d0(o, vb0, pa0, pa1, pa2, pa3); partialSM(pB0, pB1, m_reg, mnB, alB);
  __syncthreads(); RESC(alB);
  finishSM(pB0, pB1, alB, l_reg, pa0, pa1, pa2, pa3); SBAR();
  pv_d0(o, vb0 + (int)SHM_V, pa0, pa1, pa2, pa3);
  if (hi == 0) li_l[r32] = l_reg; asm volatile("s_waitcnt lgkmcnt(0)" ::: "memory");
  float rli[16];
#pragma unroll
  for (int r = 0; r < 16; ++r) rli[r] = __builtin_amdgcn_rcpf(li_l[crow(r, hi)]);
  bf16* Ow = Oout + (size_t)(qrow0 + wid * QBLK) * LDO + 128 * h;
#pragma unroll
  for (int r = 0; r < 16; ++r) { const int orow = crow(r, hi);
#pragma unroll
    for (int d0 = 0; d0 < 4; ++d0) Ow[(size_t)orow * LDO + d0 * 32 + r32] = f2bf_rne(o[d0][r] * rli[r]); }
  __syncthreads();
#undef TROW
#undef SLOAD
#undef SWRITE
#undef SWAIT
#undef RESC
}
#undef SBAR
}

constexpr int NWAVES = 8;
#ifndef MK_N_LAUNCHES
#define MK_N_LAUNCHES 28
#endif
constexpr int D = 2048, NLAT = 16384, NCTX = 512, MTOT = NLAT + NCTX, SEQ = 8192, CTXL = 256, FF = 5632, WIN = 17408, MODW = 18432, MIXW = 1024;
constexpr int C_HQ = 0, C_HF = 1024, C_HB = 2048, C_HI = 3072, C_HG = 4096, C_CB = 5120, C_CC = 6144, C_CU = 7168, C_AQ = 8192, C_AK = 9216, C_AV = 10240, C_GA = 11264, C_GB = 13312, C_GC = 15360;
constexpr int NCHUNK = 132;
constexpr int NSEQ = 32;
constexpr float EPS = 1e-6f;
constexpr int NPL = 13;
constexpr int NPHASE = 1 + 2 * NPL + 1;

constexpr size_t MiB = 1u << 20;
constexpr size_t WS_CTL = 0, CTL_ZERO_BYTES = 1 * MiB;
constexpr size_t WS_MOD = 1 * MiB;
constexpr size_t WS_HCTX = 2 * MiB;
constexpr size_t WS_W13T = 6 * MiB;
constexpr size_t WS_W2T = WS_W13T + 88 * MiB;
constexpr size_t WS_WINT = WS_W2T + 44 * MiB;
constexpr size_t WS_WBT = WS_WINT + 68 * MiB;
constexpr size_t WS_WOT = WS_WBT + 12 * MiB;
constexpr size_t WS_XN = WS_WOT + 8 * MiB;
constexpr size_t WS_PROJ = WS_XN + 66 * MiB;
constexpr size_t WS_ST = WS_PROJ + 561 * MiB;
constexpr size_t WS_DEC = WS_ST + 132 * MiB;
constexpr size_t WS_BR = WS_DEC + 3 * MiB;
constexpr size_t WS_OP = WS_BR + 99 * MiB;
constexpr size_t WS_END = WS_OP + 66 * MiB;
static_assert((size_t)MTOT * WIN * 2 <= 561 * MiB && (size_t)4224 * 16384 * 2 <= 132 * MiB && (size_t)MTOT * D * 4 <= 132 * MiB && (size_t)3 * MTOT * MIXW * 2 <= 99 * MiB, "d_ws map");
constexpr int CW_BAR = 4096;

constexpr int RING_OFF = 0, RING_BYTES = 131072;
constexpr int LDSCTL_OFF = RING_BYTES, MISC_OFF = LDSCTL_OFF + 320;
constexpr int LDS_BYTES = 147456;

#define GAS __attribute__((address_space(1)))
#define LAS __attribute__((address_space(3)))
typedef unsigned short bf16;
typedef unsigned v4u __attribute__((ext_vector_type(4)));
typedef unsigned v2u __attribute__((ext_vector_type(2)));
typedef float f32x4 __attribute__((ext_vector_type(4)));
typedef short bf16x8 __attribute__((ext_vector_type(8)));
typedef GAS unsigned gu32;
#define RLX_AGENT __ATOMIC_RELAXED, __HIP_MEMORY_SCOPE_AGENT
#define LDS_WAIT() asm volatile("s_waitcnt lgkmcnt(0)" ::: "memory")
#define VM_WAIT() asm volatile("s_waitcnt vmcnt(0)" ::: "memory")
__device__ __forceinline__ unsigned f2bf(float f) { unsigned u = __builtin_bit_cast(unsigned, f); return (u + 0x7fffu + ((u >> 16) & 1u)) >> 16; }
__device__ __forceinline__ unsigned pk2(float lo, float hi) { return f2bf(lo) | (f2bf(hi) << 16); }
__device__ __forceinline__ float bflo(unsigned w) { return __uint_as_float(w << 16); }
__device__ __forceinline__ float bfhi(unsigned w) { return __uint_as_float(w & 0xffff0000u); }
__device__ __forceinline__ float silu_f(float x) { return x * __builtin_amdgcn_rcpf(1.0f + __expf(-x)); }
__device__ __forceinline__ float sigm_f(float x) { return __builtin_amdgcn_rcpf(1.0f + __expf(-x)); }

#define XB_TMO      128
#define XB_XCNT(j)  (256  + 64 * (j))
#define XB_XSUB(j)  (1280 + 64 * (j))
#define XB_XGEN(j)  (2304 + 64 * (j))
#define XB_TOP      3328
#define XB_TOPGEN   3392
#define XCD_BAR_WORDS 3456
#define XB_SPIN_CAP (1u << 18)

__device__ __forceinline__ unsigned xb_ld(unsigned* p)              { return __hip_atomic_load(p, __ATOMIC_RELAXED, __HIP_MEMORY_SCOPE_AGENT); }
__device__ __forceinline__ unsigned xb_add(unsigned* p, unsigned v) { return __hip_atomic_fetch_add(p, v, __ATOMIC_RELAXED, __HIP_MEMORY_SCOPE_AGENT); }
__device__ __forceinline__ unsigned xb_xcc_id() { return (unsigned)__builtin_amdgcn_s_getreg((3 << 11) | 20) & 0xFu; }
#define XB_SPIN(cond, bar) do { unsigned _sp = 0; while (cond) { __builtin_amdgcn_s_sleep(1); \
    if ((++_sp & 255u) == 0u) { if (xb_ld(&(bar)[XB_TMO])) break; if (_sp > XB_SPIN_CAP) { atomicAdd(&(bar)[XB_TMO], 1u); break; } } } } while (0)

struct XcdBarrier {
    unsigned* bar; unsigned x;
    volatile LAS unsigned* st;
};

__device__ __forceinline__ XcdBarrier xcd_barrier_post(unsigned* bar, volatile LAS unsigned* st) {
    XcdBarrier b; b.bar = bar; b.x = xb_xcc_id(); b.st = st;
    if (threadIdx.x == 0) (void)xb_add(&bar[XB_XCNT(b.x)], 1u);
    return b;
}
__device__ __forceinline__ void xcd_barrier_complete(unsigned* bar, unsigned x, unsigned& nloc, unsigned& nx) {
    const unsigned G = gridDim.x * gridDim.y * gridDim.z;
    unsigned sum, cnt, mine, sp = 0u;
    for (;;) {
        sum = 0u; cnt = 0u; mine = 0u;
#pragma unroll
        for (unsigned j = 0; j < 16; ++j) { const unsigned c = xb_ld(&bar[XB_XCNT(j)]); sum += c; cnt += (c > 0u) ? 1u : 0u; mine = (j == x) ? c : mine; }
        if (sum == G) break;
        __builtin_amdgcn_s_sleep(1);
        if ((++sp & 255u) == 0u) { if (xb_ld(&bar[XB_TMO])) break; if (sp > XB_SPIN_CAP) { atomicAdd(&bar[XB_TMO], 1u); break; } }
    }
    nloc = mine > 0u ? mine : 1u; nx = cnt > 0u ? cnt : 1u;
}

__device__ __forceinline__ void xcd_barrier(const XcdBarrier& b) {
    asm volatile("s_waitcnt vmcnt(0)" ::: "memory");
    __syncthreads();
    if (threadIdx.x == 0) {
        unsigned* bar = b.bar;
        __builtin_amdgcn_s_waitcnt(0);
        unsigned nloc = b.st[0], nx = b.st[1];
        if (nloc == 0u) { xcd_barrier_complete(bar, b.x, nloc, nx); b.st[0] = nloc; b.st[1] = nx; }
        const unsigned old = xb_add(&bar[XB_XSUB(b.x)], 1u);
        const unsigned gen = old / nloc;
        if (old + 1u == (gen + 1u) * nloc) {
            __builtin_amdgcn_fence(__ATOMIC_RELEASE, "agent");
            asm volatile("s_waitcnt vmcnt(0)" ::: "memory");
            const unsigned og = xb_add(&bar[XB_TOP], 1u);
            const unsigned tg = og / nx;
            if (og + 1u == (tg + 1u) * nx) xb_add(&bar[XB_TOPGEN], 1u);
            else XB_SPIN(xb_ld(&bar[XB_TOPGEN]) == tg, bar);
            __builtin_amdgcn_fence(__ATOMIC_ACQUIRE, "agent");
            xb_add(&bar[XB_XGEN(b.x)], 1u);
            asm volatile("s_waitcnt vmcnt(0)" ::: "memory");
        } else {
            XB_SPIN(xb_ld(&bar[XB_XGEN(b.x)]) == gen, bar);
            __builtin_amdgcn_fence(__ATOMIC_ACQUIRE, "agent");
            asm volatile("s_waitcnt vmcnt(0)" ::: "memory");
        }
    }
    __syncthreads();
}

struct Frame {
    LAS unsigned char* lds;
    volatile LAS unsigned* MISC;
    gu32* ctl;
    unsigned char* ws;
    float* out;
    int tid, lane, wave;
    int vcu, G, bx;
};
__device__ __forceinline__ void launder(Frame& P) {
    int t = P.tid; asm volatile("" : "+v"(t)); P.tid = t; P.lane = t & 63; P.wave = __builtin_amdgcn_readfirstlane(t >> 6);
    unsigned long long w = (unsigned long long)P.ws, o = (unsigned long long)P.out; int g = P.G, v = P.vcu, x = P.bx;
    asm volatile("" : "+s"(w), "+s"(o), "+s"(g), "+s"(v), "+s"(x));
    P.ws = (unsigned char*)w; P.out = (float*)o; P.G = g; P.vcu = v; P.bx = x;
}
__device__ __forceinline__ const float* in_ptr(int k) {
    auto kp = (const float* const __attribute__((address_space(4)))*)__builtin_amdgcn_kernarg_segment_ptr();
    int kk = k; asm volatile("" : "+s"(kk));
    return kp[kk];
}
#define IP_X in_ptr(0)
#define IP_C in_ptr(1)
#define IP_CTX in_ptr(2)
#define IP_CCTX in_ptr(3)
#define IP_WADA in_ptr(4)
#define IP_BADA in_ptr(5)
#define IP_NORMW in_ptr(6)
#define IP_W13 in_ptr(7)
#define IP_W2 in_ptr(8)
#define IP_WIN in_ptr(9)
#define IP_HLB in_ptr(10)
#define IP_HNW in_ptr(11)
#define IP_CONVW in_ptr(12)
#define IP_LAM in_ptr(13)
#define IP_DANW in_ptr(14)
#define IP_WBR in_ptr(15)
#define IP_WOUT in_ptr(16)
#define IP_FNW in_ptr(17)
#define W_HCTX ((float*)(F.ws + WS_HCTX))
#define W_MOD ((float*)(F.ws + WS_MOD))
#define W_W13T ((bf16*)(F.ws + WS_W13T))
#define W_W2T ((bf16*)(F.ws + WS_W2T))
#define W_WINT ((bf16*)(F.ws + WS_WINT))
#define W_WBT ((bf16*)(F.ws + WS_WBT))
#define W_WOT ((bf16*)(F.ws + WS_WOT))
#define W_XN ((bf16*)(F.ws + WS_XN))
#define W_PROJ ((bf16*)(F.ws + WS_PROJ))
#define W_HID ((bf16*)(F.ws + WS_PROJ))
#define W_ST ((bf16*)(F.ws + WS_ST))
#define W_BR ((bf16*)(F.ws + WS_BR))
#define W_OP ((bf16*)(F.ws + WS_OP))
#define W_Y32 ((float*)(F.ws + WS_ST))
#define W_DEC ((float*)(F.ws + WS_DEC))

__device__ __forceinline__ float wave_sum(float v) {
#pragma unroll
    for (int o = 1; o < 64; o <<= 1) v += __shfl_xor(v, o);
    return v;
}

__device__ __forceinline__ void p_ada(Frame& F) {
    LAS float* sc = (LAS float*)(F.lds + RING_OFF);
    LAS float* red = sc + 3 * D;
    const float* cvec = IP_C; const float* ccv = IP_CCTX; const float* wada = IP_WADA; const float* bada = IP_BADA; float* modp = W_MOD;
    for (int i = F.tid; i < 3 * D; i += NWAVES * 64) { const int g = i / D, k = i - g * D; const float v = (g < 2) ? cvec[g * D + k] : ccv[k]; sc[i] = silu_f(v); }
    __syncthreads();
    for (int unit = F.bx; unit < 2 * (MODW / 64); unit += F.G) {
        const int layer = unit / (MODW / 64), cb = unit - layer * (MODW / 64), col = cb * 64 + F.lane;
        const float* W = wada + (size_t)layer * D * MODW + col;
        const int k0 = F.wave * 256; float a0 = 0.f, a1 = 0.f, a2 = 0.f;
#pragma unroll 8
        for (int k = k0; k < k0 + 256; ++k) { const float w = W[(size_t)k * MODW]; a0 += sc[k] * w; a1 += sc[D + k] * w; a2 += sc[2 * D + k] * w; }
        red[(F.wave * 3 + 0) * 64 + F.lane] = a0; red[(F.wave * 3 + 1) * 64 + F.lane] = a1; red[(F.wave * 3 + 2) * 64 + F.lane] = a2;
        __syncthreads();
        if (F.wave < 3) { float s = 0.f;
#pragma unroll
            for (int w = 0; w < 8; ++w) s += red[(w * 3 + F.wave) * 64 + F.lane];
            modp[(size_t)(layer * 3 + F.wave) * MODW + col] = s + bada[(size_t)layer * MODW + col]; }
        __syncthreads();
    }
}

__device__ __forceinline__ void transpose_item(const float* W, int K, int N, bf16* WT, int k0, int n0, int drow0, LAS float* scr, int lane) {
#pragma unroll 8
    for (int i = 0; i < 32; ++i) { const int kk = 2 * i + (lane >> 5); scr[kk * 33 + (lane & 31)] = W[(size_t)(k0 + kk) * N + n0 + (lane & 31)]; }
    LDS_WAIT(); asm volatile("" ::: "memory");
    const int c = lane & 7;
#pragma unroll
    for (int j = 0; j < 4; ++j) { const int n = (lane >> 3) + 8 * j; const LAS float* s = scr + (8 * c) * 33 + n;
        v4u o; o.x = pk2(s[0 * 33], s[1 * 33]); o.y = pk2(s[2 * 33], s[3 * 33]); o.z = pk2(s[4 * 33], s[5 * 33]); o.w = pk2(s[6 * 33], s[7 * 33]);
        *(GAS v4u*)(WT + (size_t)(drow0 + n) * K + k0 + 8 * c) = o; }
    LDS_WAIT(); asm volatile("" ::: "memory");
}
__device__ __forceinline__ void p_convert(Frame& F, int layer) {
    LAS float* scr = (LAS float*)(F.lds + RING_OFF + F.wave * 16384);
    const int gw = F.vcu * NWAVES + F.wave, NGW = F.G * NWAVES;
    constexpr int I13 = (D / 64) * (2 * FF / 32), I2 = (FF / 64) * (D / 32), IIN = (D / 64) * (WIN / 32), IBR = (MIXW / 64) * (D / 32), IOUT = (D / 64) * (D / 32);
    constexpr int NITEMS = 2 * I13 + 2 * I2 + IIN + 3 * IBR + IOUT;
    const float* pw13 = IP_W13; const float* pw2 = IP_W2; const float* pwin = IP_WIN; const float* pwbr = IP_WBR; const float* pwout = IP_WOUT;
    for (int it = gw; it < NITEMS; it += NGW) {
        int r = it;
        if (r < 2 * I13) { const int f = r / I13; r -= f * I13; const int nblk = 2 * FF / 32, kb = r / nblk, nb = r - kb * nblk; const int n0 = 32 * nb;
            const int half = n0 >= FF ? 1 : 0, nn = n0 - half * FF; const int drow0 = 256 * (nn >> 7) + 128 * half + (nn & 127);
            transpose_item(pw13 + (size_t)(layer * 2 + f) * D * 2 * FF, D, 2 * FF, W_W13T + (size_t)f * 2 * FF * D, 64 * kb, n0, drow0, scr, F.lane); continue; }
        r -= 2 * I13;
        if (r < 2 * I2) { const int f = r / I2; r -= f * I2; const int nblk = D / 32, kb = r / nblk, nb = r - kb * nblk;
            transpose_item(pw2 + (size_t)(layer * 2 + f) * FF * D, FF, D, W_W2T + (size_t)f * D * FF, 64 * kb, 32 * nb, 32 * nb, scr, F.lane); continue; }
        r -= 2 * I2;
        if (r < IIN) { const int nblk = WIN / 32, kb = r / nblk, nb = r - kb * nblk;
            transpose_item(pwin + (size_t)layer * D * WIN, D, WIN, W_WINT, 64 * kb, 32 * nb, 32 * nb, scr, F.lane); continue; }
        r -= IIN;
        if (r < 3 * IBR) { const int f = r / IBR; r -= f * IBR; const int nblk = D / 32, kb = r / nblk, nb = r - kb * nblk;
            transpose_item(pwbr + (size_t)(layer * 3 + f) * MIXW * D, MIXW, D, W_WBT + (size_t)f * D * MIXW, 64 * kb, 32 * nb, 32 * nb, scr, F.lane); continue; }
        r -= 3 * IBR;
        { const int nblk = D / 32, kb = r / nblk, nb = r - kb * nblk;
            transpose_item(pwout + (size_t)layer * D * D, D, D, W_WOT, 64 * kb, 32 * nb, 32 * nb, scr, F.lane); }
    }
}

__device__ __forceinline__ void p_norm(Frame& F, const float* hl, const float* hc, const float* nw, const float* modl, int which, int nrows) {
    const int gw = F.vcu * NWAVES + F.wave, NGW = F.G * NWAVES;
    for (int row = gw; row < nrows; row += NGW) {
        const float* src = row < NLAT ? hl + (size_t)row * D : hc + (size_t)(row - NLAT) * D;
        const int g = row < SEQ ? 0 : (row < NLAT ? 1 : 2);
        const float* shift = modl + (size_t)g * MODW + (3 * which) * D; const float* scale = shift + D;
        const GAS f32x4* xr = (const GAS f32x4*)src + F.lane;
        f32x4 v[8]; float s = 0.f;
#pragma unroll
        for (int j = 0; j < 8; ++j) { v[j] = xr[64 * j]; s += (v[j].x * v[j].x + v[j].y * v[j].y) + (v[j].z * v[j].z + v[j].w * v[j].w); }
        const float rstd = 1.0f / sqrtf(wave_sum(s) * (1.f / D) + EPS);
        GAS v2u* o8 = (GAS v2u*)(W_XN + (size_t)row * D) + F.lane;
#pragma unroll
        for (int j = 0; j < 8; ++j) { const int c = 4 * (F.lane + 64 * j);
            const f32x4 wv = *(const f32x4*)(nw + c), sc = *(const f32x4*)(scale + c), sh = *(const f32x4*)(shift + c);
            const f32x4 y = (v[j] * rstd) * wv * (sc + 1.0f) + sh;
            v2u w; w.x = pk2(y.x, y.y); w.y = pk2(y.z, y.w); o8[64 * j] = w; }
    }
}
__device__ __forceinline__ void p_final(Frame& F) {
    const int gw = F.vcu * NWAVES + F.wave, NGW = F.G * NWAVES; const float* fnw = IP_FNW;
    for (int row = gw; row < NLAT; row += NGW) {
        GAS f32x4* xr = (GAS f32x4*)(F.out + (size_t)row * D) + F.lane;
        f32x4 v[8]; float s = 0.f;
#pragma unroll
        for (int j = 0; j < 8; ++j) { v[j] = xr[64 * j]; s += (v[j].x * v[j].x + v[j].y * v[j].y) + (v[j].z * v[j].z + v[j].w * v[j].w); }
        const float rstd = 1.0f / sqrtf(wave_sum(s) * (1.f / D) + EPS);
#pragma unroll
        for (int j = 0; j < 8; ++j) { const int c = 4 * (F.lane + 64 * j); const f32x4 wv = *(const f32x4*)(fnw + c); xr[64 * j] = (v[j] * rstd) * wv; }
    }
}

__device__ __forceinline__ void p_rope(Frame& F) {
    const int gw = F.vcu * NWAVES + F.wave, NGW = F.G * NWAVES;
    for (int row = gw; row < NLAT; row += NGW) {
        const int t = row & (SEQ - 1), prow = t >> 6, pcol = t & 63;
        bf16* base = W_PROJ + (size_t)row * WIN + C_AQ;
#pragma unroll
        for (int s = 0; s < 2; ++s) {
            const int item = F.lane + 64 * s, grp = item >> 1, half = item & 1;
            bf16* pa = base + grp * 32 + 8 * half; bf16* pb = pa + 16;
            const v4u xa = *(const v4u*)pa, xb = *(const v4u*)pb;
            const float pos = (float)((grp & 1) ? pcol : prow);
            float a[8], b[8];
            a[0] = bflo(xa.x); a[1] = bfhi(xa.x); a[2] = bflo(xa.y); a[3] = bfhi(xa.y); a[4] = bflo(xa.z); a[5] = bfhi(xa.z); a[6] = bflo(xa.w); a[7] = bfhi(xa.w);
            b[0] = bflo(xb.x); b[1] = bfhi(xb.x); b[2] = bflo(xb.y); b[3] = bfhi(xb.y); b[4] = bflo(xb.z); b[5] = bfhi(xb.z); b[6] = bflo(xb.w); b[7] = bfhi(xb.w);
            float oa[8], ob[8];
#pragma unroll
            for (int e = 0; e < 8; ++e) { const int d = 8 * half + e;
                const float invf = exp2f(-(float)d * (13.287712379549449f / 16.0f));
                const float rev = pos * invf * 0.15915494309189535f;
                const float fr = rev - floorf(rev);
                const float sn = __builtin_amdgcn_sinf(fr), cs = __builtin_amdgcn_cosf(fr);
                oa[e] = a[e] * cs - b[e] * sn; ob[e] = b[e] * cs + a[e] * sn; }
            v4u wa, wb;
            wa.x = pk2(oa[0], oa[1]); wa.y = pk2(oa[2], oa[3]); wa.z = pk2(oa[4], oa[5]); wa.w = pk2(oa[6], oa[7]);
            wb.x = pk2(ob[0], ob[1]); wb.y = pk2(ob[2], ob[3]); wb.z = pk2(ob[4], ob[5]); wb.w = pk2(ob[6], ob[7]);
            *(v4u*)pa = wa; *(v4u*)pb = wb;
        }
    }
}

__device__ __forceinline__ void hg_gate(float z, float lb, float& logf, float& kv) {
    const float e = __expf(-fabsf(z)), r = __builtin_amdgcn_rcpf(1.0f + e);
    const float sig = z >= 0.f ? r : e * r, nsig = z >= 0.f ? e * r : r;
    kv = (1.0f - lb) * nsig;
    logf = lb > 0.f ? __logf(lb + (1.0f - lb) * sig) : (fminf(z, 0.f) - __logf(1.0f + e));
}
__device__ __forceinline__ int chunk_row(int b, int c) { return c < 4 ? NLAT + CTXL * b + 64 * c : SEQ * b + 64 * (c - 4); }
__device__ __forceinline__ void unpack16(const v4u a, const v4u b, float* o) {
    o[0] = bflo(a.x); o[1] = bfhi(a.x); o[2] = bflo(a.y); o[3] = bfhi(a.y); o[4] = bflo(a.z); o[5] = bfhi(a.z); o[6] = bflo(a.w); o[7] = bfhi(a.w);
    o[8] = bflo(b.x); o[9] = bfhi(b.x); o[10] = bflo(b.y); o[11] = bfhi(b.y); o[12] = bflo(b.z); o[13] = bfhi(b.z); o[14] = bflo(b.w); o[15] = bfhi(b.w);
}
__device__ __forceinline__ void scan16(float* cum, int lane) {
#pragma unroll
    for (int off = 1; off < 64; off <<= 1) {
#pragma unroll
        for (int e = 0; e < 16; ++e) { const float t = __shfl_up(cum[e], off); if (lane >= off) cum[e] += t; }
    }
}
__device__ __forceinline__ bf16x8 ldfrag(const LAS unsigned char* base, int row, int stride, int kbyte) { return *(const LAS bf16x8*)(base + row * stride + kbyte); }

constexpr int H_KT = 0, H_VT = 18432, H_ESC = 36864;
__device__ __forceinline__ void p_h1(Frame& F, int layer) {
    LAS unsigned char* L = F.lds + RING_OFF;
    LAS bf16* KT = (LAS bf16*)(L + H_KT); LAS bf16* VT = (LAS bf16*)(L + H_VT); LAS float* esc = (LAS float*)(L + H_ESC);
    const int lane = F.lane, w = F.wave, fr = lane & 15, fq = lane >> 4; const float* hlb = IP_HLB;
    for (int u = F.bx; u < NSEQ * NCHUNK; u += F.G) {
        const int s = u / NCHUNK, c = u - s * NCHUNK, b = s >> 4, dir = (s >> 3) & 1, h = s & 7;
        const int tok = dir ? 63 - lane : lane;
        const bf16* rowp = W_PROJ + (size_t)(chunk_row(b, c) + tok) * WIN;
        const int ch0 = 128 * h + 16 * w;
        const v4u z0 = *(const v4u*)(rowp + (dir ? C_HB : C_HF) + ch0), z1 = *(const v4u*)(rowp + (dir ? C_HB : C_HF) + ch0 + 8);
        const v4u v0 = *(const v4u*)(rowp + C_HI + ch0), v1 = *(const v4u*)(rowp + C_HI + ch0 + 8);
        float z[16], cum[16], kv[16]; unpack16(z0, z1, z);
#pragma unroll
        for (int e = 0; e < 16; ++e) { float lb = 0.f;
            if (layer) { const float r0 = hlb[(dir * 2 + 0) * 1024 + ch0 + e], r1 = hlb[(dir * 2 + 1) * 1024 + ch0 + e]; lb = sigm_f(r1 - r0); }
            hg_gate(z[e], lb, cum[e], kv[e]); }
        scan16(cum, lane);
        unsigned short vb[16];
        { const unsigned ww[8] = {v0.x, v0.y, v0.z, v0.w, v1.x, v1.y, v1.z, v1.w};
#pragma unroll
          for (int e = 0; e < 8; ++e) { vb[2 * e] = (unsigned short)(ww[e] & 0xffffu); vb[2 * e + 1] = (unsigned short)(ww[e] >> 16); } }
#pragma unroll
        for (int e = 0; e < 16; ++e) { const float cmid = __shfl(cum[e], 31), cend = __shfl(cum[e], 63);
            const float ks = kv[e] * __expf(fminf(cmid - cum[e], 80.f));
            KT[(16 * w + e) * 72 + tok] = (bf16)f2bf(ks); VT[(16 * w + e) * 72 + tok] = vb[e];
            if (lane == 0) { esc[16 * w + e] = __expf(cend - cmid); W_DEC[(size_t)u * 128 + 16 * w + e] = __expf(cend); } }
        __syncthreads();
        f32x4 acc[8];
#pragma unroll
        for (int nb = 0; nb < 8; ++nb) acc[nb] = (f32x4){0.f, 0.f, 0.f, 0.f};
#pragma unroll
        for (int ks = 0; ks < 2; ++ks) { const bf16x8 a = ldfrag((const LAS unsigned char*)KT, 16 * w + fr, 144, (32 * ks + 8 * fq) * 2);
#pragma unroll
            for (int nb = 0; nb < 8; ++nb) { const bf16x8 bb = ldfrag((const LAS unsigned char*)VT, 16 * nb + fr, 144, (32 * ks + 8 * fq) * 2);
                acc[nb] = __builtin_amdgcn_mfma_f32_16x16x32_bf16(a, bb, acc[nb], 0, 0, 0); } }
        const f32x4 e4 = *(const LAS f32x4*)(esc + 16 * w + 4 * fq);
        bf16* dst = W_ST + (size_t)u * 16384 + 16 * w + 4 * fq;
#pragma unroll
        for (int nb = 0; nb < 8; ++nb) { const f32x4 val = acc[nb] * e4; v2u o; o.x = pk2(val[0], val[1]); o.y = pk2(val[2], val[3]); *(v2u*)(dst + (size_t)(16 * nb + fr) * 128) = o; }
        __syncthreads();
    }
}

__device__ __forceinline__ void p_h2(Frame& F) {
    for (int unit = F.bx; unit < NSEQ * 8; unit += F.G) {
        const int s = unit >> 3, slice = unit & 7, dir = (s >> 3) & 1;
        const int e0 = slice * 2048 + 4 * F.tid, dk0 = e0 & 127;
        float S[4] = {0.f, 0.f, 0.f, 0.f};
        for (int st = 0; st < NCHUNK; st += 4) {
            v2u uu[4]; f32x4 dd[4]; bf16* pp[4];
#pragma unroll
            for (int i = 0; i < 4; ++i) { const int step = st + i; const int c = dir == 0 ? step : (step < 4 ? 3 - step : 135 - step); const size_t u = (size_t)s * NCHUNK + c;
                pp[i] = W_ST + u * 16384 + e0; uu[i] = *(const v2u*)pp[i]; dd[i] = *(const f32x4*)(W_DEC + u * 128 + dk0); }
#pragma unroll
            for (int i = 0; i < 4; ++i) { v2u o; o.x = pk2(S[0], S[1]); o.y = pk2(S[2], S[3]); *(v2u*)pp[i] = o;
                S[0] = dd[i][0] * S[0] + bflo(uu[i].x); S[1] = dd[i][1] * S[1] + bfhi(uu[i].x); S[2] = dd[i][2] * S[2] + bflo(uu[i].y); S[3] = dd[i][3] * S[3] + bfhi(uu[i].y); }
        }
    }
}

constexpr int H3_Q = 0, H3_K = 17408, H3_VT = 34816, H3_P = 53248, H3_S = 62464, H3_EM = 97280, H3_SS = 97792;
__device__ __forceinline__ void p_h3(Frame& F, int layer) {
    LAS unsigned char* L = F.lds + RING_OFF;
    LAS bf16* Qs = (LAS bf16*)(L + H3_Q); LAS bf16* Ks = (LAS bf16*)(L + H3_K); LAS bf16* VT = (LAS bf16*)(L + H3_VT); LAS bf16* Ps = (LAS bf16*)(L + H3_P); LAS bf16* Ss = (LAS bf16*)(L + H3_S);
    LAS float* emid = (LAS float*)(L + H3_EM); LAS float* ssq = (LAS float*)(L + H3_SS);
    const int lane = F.lane, w = F.wave, fr = lane & 15, fq = lane >> 4;
    const float* hlb = IP_HLB; const float* hnw = IP_HNW;
    const int c_lo = layer ? 4 : 0, ncpb = NCHUNK - c_lo;
    for (int u = F.bx; u < 16 * ncpb; u += F.G) {
        const int bh = u / ncpb, c = c_lo + (u - bh * ncpb), b = bh >> 3, h = bh & 7;
        const int rb = chunk_row(b, c), ch0 = 128 * h + 16 * w;
        f32x4 acc[4];
#pragma unroll
        for (int tb = 0; tb < 4; ++tb) acc[tb] = (f32x4){0.f, 0.f, 0.f, 0.f};
#pragma unroll 1
        for (int dir = 0; dir < 2; ++dir) {
            const int tok = dir ? 63 - lane : lane;
            const bf16* rowp = W_PROJ + (size_t)(rb + tok) * WIN;
            const v4u z0 = *(const v4u*)(rowp + (dir ? C_HB : C_HF) + ch0), z1 = *(const v4u*)(rowp + (dir ? C_HB : C_HF) + ch0 + 8);
            const v4u q0 = *(const v4u*)(rowp + C_HQ + ch0), q1 = *(const v4u*)(rowp + C_HQ + ch0 + 8);
            float z[16], q[16], cum[16], kv[16]; unpack16(z0, z1, z); unpack16(q0, q1, q);
#pragma unroll
            for (int e = 0; e < 16; ++e) { float lb = 0.f;
                if (layer) { const float r0 = hlb[(dir * 2 + 0) * 1024 + ch0 + e], r1 = hlb[(dir * 2 + 1) * 1024 + ch0 + e]; lb = sigm_f(r1 - r0); }
                hg_gate(z[e], lb, cum[e], kv[e]); }
            scan16(cum, lane);
            float qs[16], ks[16];
#pragma unroll
            for (int e = 0; e < 16; ++e) { const float cmid = __shfl(cum[e], 31);
                qs[e] = q[e] * __expf(fminf(cum[e] - cmid, 80.f)); ks[e] = kv[e] * __expf(fminf(cmid - cum[e], 80.f));
                if (lane == 0) emid[16 * w + e] = __expf(cmid); }
            { v4u o; o.x = pk2(qs[0], qs[1]); o.y = pk2(qs[2], qs[3]); o.z = pk2(qs[4], qs[5]); o.w = pk2(qs[6], qs[7]); *(LAS v4u*)(Qs + tok * 136 + 16 * w) = o;
              o.x = pk2(qs[8], qs[9]); o.y = pk2(qs[10], qs[11]); o.z = pk2(qs[12], qs[13]); o.w = pk2(qs[14], qs[15]); *(LAS v4u*)(Qs + tok * 136 + 16 * w + 8) = o;
              o.x = pk2(ks[0], ks[1]); o.y = pk2(ks[2], ks[3]); o.z = pk2(ks[4], ks[5]); o.w = pk2(ks[6], ks[7]); *(LAS v4u*)(Ks + tok * 136 + 16 * w) = o;
              o.x = pk2(ks[8], ks[9]); o.y = pk2(ks[10], ks[11]); o.z = pk2(ks[12], ks[13]); o.w = pk2(ks[14], ks[15]); *(LAS v4u*)(Ks + tok * 136 + 16 * w + 8) = o; }
            if (dir == 0) {
                const v4u v0 = *(const v4u*)(rowp + C_HI + ch0), v1 = *(const v4u*)(rowp + C_HI + ch0 + 8);
                const unsigned ww[8] = {v0.x, v0.y, v0.z, v0.w, v1.x, v1.y, v1.z, v1.w};
#pragma unroll
                for (int e = 0; e < 8; ++e) { VT[(16 * w + 2 * e) * 72 + tok] = (bf16)(ww[e] & 0xffffu); VT[(16 * w + 2 * e + 1) * 72 + tok] = (bf16)(ww[e] >> 16); }
            }
            __syncthreads();
            { const size_t us = ((size_t)((b * 2 + dir) * 8 + h)) * NCHUNK + c; const bf16* sp = W_ST + us * 16384;
#pragma unroll
              for (int j = 0; j < 4; ++j) { const int qd = F.tid + 512 * j, dv = qd >> 4, dk0 = (qd & 15) * 8;
                  const v4u sv = *(const v4u*)(sp + dv * 128 + dk0); const f32x4 ea = *(const LAS f32x4*)(emid + dk0), eb = *(const LAS f32x4*)(emid + dk0 + 4);
                  v4u o; o.x = pk2(bflo(sv.x) * ea[0], bfhi(sv.x) * ea[1]); o.y = pk2(bflo(sv.y) * ea[2], bfhi(sv.y) * ea[3]); o.z = pk2(bflo(sv.z) * eb[0], bfhi(sv.z) * eb[1]); o.w = pk2(bflo(sv.w) * eb[2], bfhi(sv.w) * eb[3]);
                  *(LAS v4u*)(Ss + dv * 136 + dk0) = o; } }
#pragma unroll
            for (int bi = 0; bi < 2; ++bi) { const int blk = 2 * w + bi, I = blk >> 2, J = blk & 3;
                f32x4 pacc = (f32x4){0.f, 0.f, 0.f, 0.f};
                const bool need = dir == 0 ? (J <= I) : (J >= I);
                if (need) {
#pragma unroll
                    for (int ks4 = 0; ks4 < 4; ++ks4) { const bf16x8 a = ldfrag((const LAS unsigned char*)Ks, 16 * J + fr, 272, (32 * ks4 + 8 * fq) * 2), bb = ldfrag((const LAS unsigned char*)Qs, 16 * I + fr, 272, (32 * ks4 + 8 * fq) * 2);
                        pacc = __builtin_amdgcn_mfma_f32_16x16x32_bf16(a, bb, pacc, 0, 0, 0); }
                    if (I == J) {
#pragma unroll
                        for (int r = 0; r < 4; ++r) { const int jj = 4 * fq + r; const bool keep = dir == 0 ? (jj <= fr) : (jj >= fr); if (!keep) pacc[r] = 0.f; } }
                }
                v2u o; o.x = pk2(pacc[0], pacc[1]); o.y = pk2(pacc[2], pacc[3]);
                *(LAS v2u*)(Ps + (16 * I + fr) * 72 + 16 * J + 4 * fq) = o; }
            __syncthreads();
#pragma unroll
            for (int ks2 = 0; ks2 < 2; ++ks2) { const bf16x8 a = ldfrag((const LAS unsigned char*)VT, 16 * w + fr, 144, (32 * ks2 + 8 * fq) * 2);
#pragma unroll
                for (int tb = 0; tb < 4; ++tb) { const bf16x8 bb = ldfrag((const LAS unsigned char*)Ps, 16 * tb + fr, 144, (32 * ks2 + 8 * fq) * 2);
                    acc[tb] = __builtin_amdgcn_mfma_f32_16x16x32_bf16(a, bb, acc[tb], 0, 0, 0); } }
#pragma unroll
            for (int ks4 = 0; ks4 < 4; ++ks4) { const bf16x8 a = ldfrag((const LAS unsigned char*)Ss, 16 * w + fr, 272, (32 * ks4 + 8 * fq) * 2);
#pragma unroll
                for (int tb = 0; tb < 4; ++tb) { const bf16x8 bb = ldfrag((const LAS unsigned char*)Qs, 16 * tb + fr, 272, (32 * ks4 + 8 * fq) * 2);
                    acc[tb] = __builtin_amdgcn_mfma_f32_16x16x32_bf16(a, bb, acc[tb], 0, 0, 0); } }
            __syncthreads();
        }
#pragma unroll
        for (int tb = 0; tb < 4; ++tb) { float p = (acc[tb][0] * acc[tb][0] + acc[tb][1] * acc[tb][1]) + (acc[tb][2] * acc[tb][2] + acc[tb][3] * acc[tb][3]);
            p += __shfl_xor(p, 16); p += __shfl_xor(p, 32);
            if (fq == 0) ssq[w * 64 + 16 * tb + fr] = p; }
        __syncthreads();
        const f32x4 nwv = *(const f32x4*)(hnw + layer * 128 + 16 * w + 4 * fq);
#pragma unroll
        for (int tb = 0; tb < 4; ++tb) { const int tk = 16 * tb + fr; float tot = 0.f;
#pragma unroll
            for (int ww = 0; ww < 8; ++ww) tot += ssq[ww * 64 + tk];
            const float rstd = 1.0f / sqrtf(tot * (1.f / 128.f) + EPS);
            const size_t row = (size_t)(rb + tk);
            const v2u gv = *(const v2u*)(W_PROJ + row * WIN + C_HG + ch0 + 4 * fq);
            const float y0 = acc[tb][0] * rstd * nwv[0] * silu_f(bflo(gv.x)), y1 = acc[tb][1] * rstd * nwv[1] * silu_f(bfhi(gv.x));
            const float y2 = acc[tb][2] * rstd * nwv[2] * silu_f(bflo(gv.y)), y3 = acc[tb][3] * rstd * nwv[3] * silu_f(bfhi(gv.y));
            v2u o; o.x = pk2(y0, y1); o.y = pk2(y2, y3);
            *(v2u*)(W_BR + row * MIXW + ch0 + 4 * fq) = o; }
        __syncthreads();
    }
}

__device__ __forceinline__ void p_pm(Frame& F, int layer, int nrows) {
    const int gw = F.vcu * NWAVES + F.wave, NGW = F.G * NWAVES, lane = F.lane;
    const float lam_init = 0.8f - 0.6f * expf(-0.3f * (float)layer);
    float lam;
    { const float* lp = IP_LAM + layer * 256; const float s1 = wave_sum(lp[lane] * lp[64 + lane]), s2 = wave_sum(lp[128 + lane] * lp[192 + lane]); lam = expf(s1) - expf(s2) + lam_init; }
    const float* cw = IP_CONVW + (size_t)layer * 3 * MIXW; const float* danw = IP_DANW;
    bf16* B1 = W_BR + (size_t)MTOT * MIXW; bf16* B2 = W_BR + (size_t)2 * MTOT * MIXW;
    const bf16* O0 = W_OP; const bf16* O1 = W_OP + (size_t)MTOT * MIXW;
    for (int row = gw; row < nrows; row += NGW) {
        int pos, len; if (row < NLAT) { pos = row & (SEQ - 1); len = SEQ; } else { pos = (row - NLAT) & (CTXL - 1); len = CTXL; }
        const bool hasp = pos > 0, hasn = pos < len - 1;
        const bf16* pr = W_PROJ + (size_t)row * WIN;
#pragma unroll
        for (int s = 0; s < 2; ++s) {
            const int c0 = 512 * s + 8 * lane;
            float cbv[8], pm[8], pc[8], pn[8];
            { const v4u a = *(const v4u*)(pr + C_CB + c0); cbv[0] = bflo(a.x); cbv[1] = bfhi(a.x); cbv[2] = bflo(a.y); cbv[3] = bfhi(a.y); cbv[4] = bflo(a.z); cbv[5] = bfhi(a.z); cbv[6] = bflo(a.w); cbv[7] = bfhi(a.w); }
#define LDPROD(dst, rp) do { const v4u a_ = *(const v4u*)((rp) + C_CC + c0), b_ = *(const v4u*)((rp) + C_CU + c0); \
            dst[0] = bflo(a_.x) * bflo(b_.x); dst[1] = bfhi(a_.x) * bfhi(b_.x); dst[2] = bflo(a_.y) * bflo(b_.y); dst[3] = bfhi(a_.y) * bfhi(b_.y); \
            dst[4] = bflo(a_.z) * bflo(b_.z); dst[5] = bfhi(a_.z) * bfhi(b_.z); dst[6] = bflo(a_.w) * bflo(b_.w); dst[7] = bfhi(a_.w) * bfhi(b_.w); } while (0)
            LDPROD(pc, pr);
            if (hasp) { LDPROD(pm, pr - WIN); } else {
#pragma unroll
                for (int e = 0; e < 8; ++e) pm[e] = 0.f; }
            if (hasn) { LDPROD(pn, pr + WIN); } else {
#pragma unroll
                for (int e = 0; e < 8; ++e) pn[e] = 0.f; }
#undef LDPROD
            float yb[8];
#pragma unroll
            for (int e = 0; e < 8; ++e) yb[e] = cbv[e] * (cw[c0 + e] * pm[e] + cw[MIXW + c0 + e] * pc[e] + cw[2 * MIXW + c0 + e] * pn[e]);
            { v4u o; o.x = pk2(yb[0], yb[1]); o.y = pk2(yb[2], yb[3]); o.z = pk2(yb[4], yb[5]); o.w = pk2(yb[6], yb[7]); *(v4u*)(B1 + (size_t)row * MIXW + c0) = o; }
            float dd[8];
            { const v4u a = *(const v4u*)(O0 + (size_t)row * MIXW + c0), b2 = *(const v4u*)(O1 + (size_t)row * MIXW + c0);
              dd[0] = bflo(a.x) - lam * bflo(b2.x); dd[1] = bfhi(a.x) - lam * bfhi(b2.x); dd[2] = bflo(a.y) - lam * bflo(b2.y); dd[3] = bfhi(a.y) - lam * bfhi(b2.y);
              dd[4] = bflo(a.z) - lam * bflo(b2.z); dd[5] = bfhi(a.z) - lam * bfhi(b2.z); dd[6] = bflo(a.w) - lam * bflo(b2.w); dd[7] = bfhi(a.w) - lam * bfhi(b2.w); }
            float ss = 0.f;
#pragma unroll
            for (int e = 0; e < 8; ++e) ss += dd[e] * dd[e];
            ss += __shfl_xor(ss, 1); ss += __shfl_xor(ss, 2); ss += __shfl_xor(ss, 4); ss += __shfl_xor(ss, 8);
            const float rstd = 1.0f / sqrtf(ss * (1.f / 128.f) + EPS) * (1.0f - lam_init);
            const float* dn = danw + layer * 128 + ((8 * lane) & 127);
            float yc[8];
#pragma unroll
            for (int e = 0; e < 8; ++e) yc[e] = dd[e] * rstd * dn[e];
            { v4u o; o.x = pk2(yc[0], yc[1]); o.y = pk2(yc[2], yc[3]); o.z = pk2(yc[4], yc[5]); o.w = pk2(yc[6], yc[7]); *(v4u*)(B2 + (size_t)row * MIXW + c0) = o; }
        }
    }
}

__device__ __forceinline__ void p_attn(Frame& F, int layer, char* ldsg) {
    const int nunits = 1024 + (layer == 0 ? 32 : 0);
    for (int id = F.vcu; id < nunits; id += F.G) {
        if (id < 1024) { const int qb = id & 31, p = (id >> 5) & 1, h = (id >> 6) & 7, b = id >> 9;
            att::attn_unit(W_PROJ, SEQ * b + 256 * qb, NLAT + CTXL * b, SEQ * b, NCHUNK, h, p, W_OP + (size_t)p * MTOT * MIXW, ldsg); }
        else { const int j = id - 1024, p = j & 1, h = (j >> 1) & 7, b = j >> 4;
            att::attn_unit(W_PROJ, NLAT + CTXL * b, NLAT + CTXL * b, SEQ * b, 4, h, p, W_OP + (size_t)p * MTOT * MIXW, ldsg); }
    }
}

struct Args { const float* in[18]; float* out; unsigned char* ws; int ph_lo, ph_hi, li, pad; };
__global__ void __launch_bounds__(NWAVES * 64, 2) mk_fwd(Args args) {
    extern __shared__ __attribute__((aligned(16))) unsigned char lds[];
    Frame F;
    F.lds = (LAS unsigned char*)lds;
    F.MISC = (volatile LAS unsigned*)(F.lds + MISC_OFF);
    F.tid = threadIdx.x; F.lane = F.tid & 63; F.wave = __builtin_amdgcn_readfirstlane(F.tid >> 6);
    F.G = gridDim.x; F.bx = blockIdx.x; { const int bx = blockIdx.x; F.vcu = (F.G % 8 == 0) ? (bx % 8) * (F.G / 8) + bx / 8 : bx; }
    F.ws = args.ws; F.out = args.out;
    F.ctl = (gu32*)(F.ws + WS_CTL);
    for (int u = F.tid; u < (LDS_BYTES - LDSCTL_OFF) / 4; u += NWAVES * 64) ((LAS unsigned*)(F.lds + LDSCTL_OFF))[u] = 0u;
    __syncthreads();
    XcdBarrier bar; bar.bar = (unsigned*)(F.ctl + CW_BAR) + args.li * XCD_BAR_WORDS; bar.x = 0; bar.st = nullptr;
    if (MK_N_LAUNCHES == 1) bar = xcd_barrier_post((unsigned*)(F.ctl + CW_BAR), F.MISC + 8);
    const int lo = args.ph_lo, hi = args.ph_hi;
#ifndef PHMASK
#define PHMASK 0x7fff
#endif
#define PON(b) (((PHMASK) >> (b)) & 1)
#define IN(k) (lo <= (k) && (k) < hi)
#define PHASE(cond) if (cond) { Frame P_ = F; launder(P_); { Frame& F = P_; (void)F;
#define PHASE_END } }
#define SEAM(k) do { if (IN(k) && IN((k) + 1)) xcd_barrier(bar); } while (0)

    PHASE(PON(13) && IN(0)) p_ada(F); p_convert(F, 0); PHASE_END
    SEAM(0);

#pragma unroll 1
    for (int l = 0; l < 2; ++l) {
        const int pb = 1 + l * NPL;
        const float* modl = W_MOD + (size_t)l * 3 * MODW;
        const int Mm = (l == 1) ? NLAT : MTOT;
        const float* hl = (l == 0) ? IP_X : (const float*)F.out; const float* hc = (l == 0) ? IP_CTX : (const float*)W_HCTX;
        PHASE(PON(0) && IN(pb + 0)) if (l == 1) p_convert(F, 1); p_norm(F, hl, hc, IP_NORMW + (size_t)(l * 3 + 0) * D, modl, 0, MTOT);  PHASE_END
        SEAM(pb + 0);
        PHASE(PON(1) && IN(pb + 1)) pg8::Gemm g{W_XN, W_W13T, MTOT, 2 * FF, D}; pg8::StaticOrder S; S.init(MTOT, 2 * FF, F.G, F.bx);
            pg8::EpiSwiglu E{W_HID, FF}; pg8::gemm_phase<pg8::EpiSwiglu, pg8::StaticOrder, true, true>(F.lds + RING_OFF, g, S, E);  PHASE_END
        SEAM(pb + 1);
        PHASE(PON(2) && IN(pb + 2)) pg8::Gemm g{W_HID, W_W2T, MTOT, D, FF}; pg8::StaticOrder S; S.init(MTOT, D, F.G, F.bx);
            pg8::EpiResid E{hl, hc, F.out, W_HCTX, modl + 2 * D, 0.5f}; pg8::gemm_phase<pg8::EpiResid, pg8::StaticOrder, true, true>(F.lds + RING_OFF, g, S, E);  PHASE_END
        SEAM(pb + 2);
        PHASE(PON(3) && IN(pb + 3)) p_norm(F, F.out, W_HCTX, IP_NORMW + (size_t)(l * 3 + 1) * D, modl, 1, MTOT); PHASE_END
        SEAM(pb + 3);
        PHASE(PON(4) && IN(pb + 4)) pg8::Gemm g{W_XN, W_WINT, MTOT, WIN, D}; pg8::StaticOrder S; S.init(MTOT, WIN, F.G, F.bx);
            pg8::EpiStoreBf16 E{W_PROJ, WIN}; pg8::gemm_phase<pg8::EpiStoreBf16, pg8::StaticOrder, true, true>(F.lds + RING_OFF, g, S, E);  PHASE_END
        SEAM(pb + 4);
        PHASE(PON(5) && IN(pb + 5)) p_rope(F); p_h1(F, l);  PHASE_END
        SEAM(pb + 5);
        PHASE(PON(6) && IN(pb + 6)) p_h2(F); p_attn(F, l, (char*)lds + RING_OFF);  PHASE_END
        SEAM(pb + 6);
        PHASE(PON(7) && IN(pb + 7)) p_h3(F, l); p_pm(F, l, Mm);  PHASE_END
        SEAM(pb + 7);
        PHASE(PON(8) && IN(pb + 8))
            { pg8::Gemm g{W_BR, W_WBT, Mm, D, MIXW}; pg8::StaticOrder S; S.init(Mm, D, F.G, F.bx);
              pg8::EpiMerge<0> E{W_PROJ + C_GA, WIN, W_Y32, W_XN}; pg8::gemm_phase<pg8::EpiMerge<0>, pg8::StaticOrder, true, true>(F.lds + RING_OFF, g, S, E); }
            { pg8::Gemm g{W_BR + (size_t)MTOT * MIXW, W_WBT + (size_t)D * MIXW, Mm, D, MIXW}; pg8::StaticOrder S; S.init(Mm, D, F.G, F.bx);
              pg8::EpiMerge<1> E{W_PROJ + C_GB, WIN, W_Y32, W_XN}; pg8::gemm_phase<pg8::EpiMerge<1>, pg8::StaticOrder, true, true>(F.lds + RING_OFF, g, S, E); }
            { pg8::Gemm g{W_BR + (size_t)2 * MTOT * MIXW, W_WBT + (size_t)2 * D * MIXW, Mm, D, MIXW}; pg8::StaticOrder S; S.init(Mm, D, F.G, F.bx);
              pg8::EpiMerge<2> E{W_PROJ + C_GC, WIN, W_Y32, W_XN}; pg8::gemm_phase<pg8::EpiMerge<2>, pg8::StaticOrder, true, true>(F.lds + RING_OFF, g, S, E); }
         PHASE_END
        SEAM(pb + 8);
        PHASE(PON(9) && IN(pb + 9)) pg8::Gemm g{W_XN, W_WOT, Mm, D, D}; pg8::StaticOrder S; S.init(Mm, D, F.G, F.bx);
            pg8::EpiResid E{F.out, W_HCTX, F.out, W_HCTX, modl + 5 * D, 1.0f}; pg8::gemm_phase<pg8::EpiResid, pg8::StaticOrder, true, true>(F.lds + RING_OFF, g, S, E);  PHASE_END
        SEAM(pb + 9);
        PHASE(PON(10) && IN(pb + 10)) p_norm(F, F.out, W_HCTX, IP_NORMW + (size_t)(l * 3 + 2) * D, modl, 2, Mm); PHASE_END
        SEAM(pb + 10);
        PHASE(PON(11) && IN(pb + 11)) pg8::Gemm g{W_XN, W_W13T + (size_t)2 * FF * D, Mm, 2 * FF, D}; pg8::StaticOrder S; S.init(Mm, 2 * FF, F.G, F.bx);
            pg8::EpiSwiglu E{W_HID, FF}; pg8::gemm_phase<pg8::EpiSwiglu, pg8::StaticOrder, true, true>(F.lds + RING_OFF, g, S, E);  PHASE_END
        SEAM(pb + 11);
        PHASE(PON(12) && IN(pb + 12)) pg8::Gemm g{W_HID, W_W2T + (size_t)D * FF, Mm, D, FF}; pg8::StaticOrder S; S.init(Mm, D, F.G, F.bx);
            pg8::EpiResid E{F.out, W_HCTX, F.out, W_HCTX, modl + 8 * D, 0.5f}; pg8::gemm_phase<pg8::EpiResid, pg8::StaticOrder, true, true>(F.lds + RING_OFF, g, S, E);  PHASE_END
        SEAM(pb + 12);
    }
    PHASE(PON(14) && IN(NPHASE - 1)) p_final(F); PHASE_END
#undef IN
#undef SEAM
}

extern "C" void kernel_launch(void* const* d_in, const int* in_sizes, int n_in, void* d_out, int out_size, void* d_ws, size_t ws_size, hipStream_t stream) {
    static int grid = 0;
    if (grid == 0) {
        if (n_in != 18 || in_sizes[0] != NLAT * D || out_size != NLAT * D || ws_size < WS_END) { fprintf(stderr, "kernel_launch: shape/workspace mismatch (n_in %d, in0 %d, out %d, ws %zu, need %zu)\n", n_in, n_in > 0 ? in_sizes[0] : -1, out_size, ws_size, (size_t)WS_END); grid = -1; return; }
        int dev = 0, cus = 0, per_cu = 0;
        if (hipGetDevice(&dev) != hipSuccess || hipDeviceGetAttribute(&cus, hipDeviceAttributeMultiprocessorCount, dev) != hipSuccess) { grid = -1; return; }
        if (hipFuncSetAttribute((const void*)mk_fwd, hipFuncAttributeMaxDynamicSharedMemorySize, LDS_BYTES) != hipSuccess) { fprintf(stderr, "kernel_launch: hipFuncSetAttribute failed\n"); grid = -1; return; }
        if (hipOccupancyMaxActiveBlocksPerMultiprocessor(&per_cu, (const void*)mk_fwd, NWAVES * 64, LDS_BYTES) != hipSuccess || per_cu < 1) fprintf(stderr, "kernel_launch: occupancy query reports %d\n", per_cu);
        (void)hipGetLastError();
        grid = cus;
    }
    if (grid < 0) return;
    if (hipMemsetAsync((char*)d_ws + WS_CTL, 0, CTL_ZERO_BYTES, stream) != hipSuccess) return;
    Args a{};
    for (int i = 0; i < 18; ++i) a.in[i] = (const float*)d_in[i];
    a.out = (float*)d_out; a.ws = (unsigned char*)d_ws;
#if MK_N_LAUNCHES == 1
    a.ph_lo = 0; a.ph_hi = NPHASE; a.li = 0;
    hipLaunchKernelGGL(mk_fwd, dim3(grid), dim3(NWAVES * 64), LDS_BYTES, stream, a);
#else
    for (int ph = 0; ph < NPHASE; ++ph) { a.ph_lo = ph; a.ph_hi = ph + 1; a.li = 0; hipLaunchKernelGGL(mk_fwd, dim3(grid), dim3(NWAVES * 64), LDS_BYTES, stream, a); }
#endif
    const hipError_t le = hipPeekAtLastError();
    if (le != hipSuccess) fprintf(stderr, "kernel_launch: launch failed: %s\n", hipGetErrorName(le));
}
```

```cpp
#include <hip/hip_runtime.h>
#include <cstdio>
#include <cstdint>
namespace pg8 {
#define PG8_LAS __attribute__((address_space(3)))
typedef unsigned short bf16_t;
typedef short bf16x8 __attribute__((ext_vector_type(8)));
typedef float f32x4 __attribute__((ext_vector_type(4)));
typedef unsigned u32x4 __attribute__((ext_vector_type(4)));
constexpr int BM = 256, BK = 64, HALF = 128, HTB = HALF * BK * 2  , STAGE_BYTES = 8 * HTB, NXCD = 8, WGM = 8;

__host__ __device__ __forceinline__ int lds_byte(int r, int c) { const int st = (r >> 4) * 2 + (c >> 5), rr = r & 15, cc = c & 31, ob = rr * 64 + cc * 2; return st * 1024 + (ob ^ (((ob >> 9) & 1) << 5)); }
__host__ __device__ __forceinline__ void stage_rc(int b, int& R, int& C) { const int st = b / 1024, sb = b % 1024, swz = sb ^ (((sb >> 9) & 1) << 5); R = (st >> 1) * 16 + swz / 64; C = (st & 1) * 32 + (swz % 64) / 2; }
__host__ __device__ __forceinline__ int perm32(int rho) { const int n = rho >> 4, i = rho & 15; return 8 * (i >> 2) + 4 * n + (i & 3); }

struct Unit { int pm, pn; };
struct Gemm { const bf16_t* A; const bf16_t* Bt; int M, N, K; };

struct StaticOrder {
    int nM, nN, nwg, G, c;
    __host__ __device__ void init(int M, int N, int G_, int c_) { nM = M / BM; nN = N / BM; nwg = nM * nN; G = G_; c = c_; }
    __host__ __device__ bool next(int i, Unit& u) const {
        const long L = (long)i * G + c; if (L >= nwg) return false;
        int wgid = (int)L; { const int q = nwg / NXCD, r = nwg % NXCD, xcd = wgid % NXCD, off = wgid / NXCD; wgid = (xcd < r ? xcd * (q + 1) : r * (q + 1) + (xcd - r) * q) + off; }
        const int nig = WGM * nN, gid = wgid / nig, fm = gid * WGM, gsz = (nM - fm) < WGM ? (nM - fm) : WGM;
        u.pm = fm + ((wgid % nig) % gsz); u.pn = (wgid % nig) / gsz; return true;
    }
    __device__ __forceinline__ void a_ready(const Unit&) const {}
    __device__ __forceinline__ void done(const Unit&) const {}
};

__device__ __forceinline__ unsigned cvt_pk_bf16(float lo, float hi) { unsigned r; asm volatile("v_cvt_pk_bf16_f32 %0, %1, %2" : "=v"(r) : "v"(lo), "v"(hi)); return r; }
__device__ __forceinline__ float silu_f(float x) { return x * __builtin_amdgcn_rcpf(1.0f + __expf(-x)); }
__device__ __forceinline__ float sigm_f(float x) { return __builtin_amdgcn_rcpf(1.0f + __expf(-x)); }
__device__ __forceinline__ float bfbits2f(unsigned short b) { return __uint_as_float(((unsigned)b) << 16); }
typedef unsigned u32x2 __attribute__((ext_vector_type(2)));
constexpr int MODW = 18432;
constexpr int NLAT = 16384;
constexpr int DM = 2048;

struct EpiStoreBf16 {
    static constexpr bool PERM = true, AFTER_DRAIN = false;
    bf16_t* O; int ldc;
    __device__ __forceinline__ void operator()(const f32x4 (&acc)[2][2][4][2], const Unit& u, int wr, int wc, int fr, int fq) const {
        const int row0 = u.pm * BM + wr * 64 + fr; const int col0 = u.pn * BM + wc * 32 + 8 * fq;
#pragma unroll
        for (int ai = 0; ai < 2; ++ai)
#pragma unroll
            for (int m = 0; m < 4; ++m) { bf16_t* rowp = O + (size_t)(row0 + ai * HALF + m * 16) * ldc + col0;
#pragma unroll
                for (int bj = 0; bj < 2; ++bj) { const f32x4 v0 = acc[ai][bj][m][0], v1 = acc[ai][bj][m][1];
                    u32x4 w; w.x = cvt_pk_bf16(v0[0], v0[1]); w.y = cvt_pk_bf16(v0[2], v0[3]); w.z = cvt_pk_bf16(v1[0], v1[1]); w.w = cvt_pk_bf16(v1[2], v1[3]);
                    *(u32x4*)(rowp + bj * HALF) = w; } }
    }
};
struct EpiSwiglu {
    static constexpr bool PERM = true, AFTER_DRAIN = false;
    bf16_t* O; int ldc;
    __device__ __forceinline__ void operator()(const f32x4 (&acc)[2][2][4][2], const Unit& u, int wr, int wc, int fr, int fq) const {
        const int row0 = u.pm * BM + wr * 64 + fr; const int col0 = u.pn * HALF + wc * 32 + 8 * fq;
#pragma unroll
        for (int ai = 0; ai < 2; ++ai)
#pragma unroll
            for (int m = 0; m < 4; ++m) { bf16_t* rowp = O + (size_t)(row0 + ai * HALF + m * 16) * ldc + col0;
                const f32x4 g0 = acc[ai][0][m][0], g1 = acc[ai][0][m][1], u0 = acc[ai][1][m][0], u1 = acc[ai][1][m][1];
                float r[8];
#pragma unroll
                for (int i = 0; i < 4; ++i) { r[i] = silu_f(g0[i]) * u0[i]; r[4 + i] = silu_f(g1[i]) * u1[i]; }
                u32x4 w; w.x = cvt_pk_bf16(r[0], r[1]); w.y = cvt_pk_bf16(r[2], r[3]); w.z = cvt_pk_bf16(r[4], r[5]); w.w = cvt_pk_bf16(r[6], r[7]);
                *(u32x4*)rowp = w; }
    }
};
struct EpiResid {
    static constexpr bool PERM = false, AFTER_DRAIN = false;
    const float* baseL; const float* baseC; float* outL; float* outC; const float* coef; float mul;
    __device__ __forceinline__ void operator()(const f32x4 (&acc)[2][2][4][2], const Unit& u, int wr, int wc, int fr, int fq) const {
        const int g = u.pm < 32 ? 0 : (u.pm < 64 ? 1 : 2);
        const bool lat = u.pm < 64;
        const float* bp = lat ? baseL : baseC; float* op = lat ? outL : outC;
        const int rsub = lat ? 0 : NLAT;
        const int col0 = u.pn * BM + wc * 32 + 4 * fq;
        f32x4 cf[2][2];
#pragma unroll
        for (int bj = 0; bj < 2; ++bj)
#pragma unroll
            for (int n = 0; n < 2; ++n) cf[bj][n] = *(const f32x4*)(coef + (size_t)g * MODW + col0 + bj * HALF + n * 16) * mul;
#pragma unroll
        for (int ai = 0; ai < 2; ++ai)
#pragma unroll
            for (int m = 0; m < 4; ++m) { const int r = u.pm * BM + ai * HALF + wr * 64 + m * 16 + fr - rsub; const size_t off = (size_t)r * DM + col0;
#pragma unroll
                for (int bj = 0; bj < 2; ++bj)
#pragma unroll
                    for (int n = 0; n < 2; ++n) { const f32x4 bs = *(const f32x4*)(bp + off + bj * HALF + n * 16);
                        *(f32x4*)(op + off + bj * HALF + n * 16) = bs + cf[bj][n] * acc[ai][bj][m][n]; }
                if (m & 1) asm volatile("" ::: "memory"); }
    }
};
template <int MODE> struct EpiMerge {
    static constexpr bool PERM = false, AFTER_DRAIN = false;
    const bf16_t* gate; int ldg; float* y32; bf16_t* ybf;
    __device__ __forceinline__ void operator()(const f32x4 (&acc)[2][2][4][2], const Unit& u, int wr, int wc, int fr, int fq) const {
        const int col0 = u.pn * BM + wc * 32 + 4 * fq;
#pragma unroll
        for (int ai = 0; ai < 2; ++ai)
#pragma unroll
            for (int m = 0; m < 4; ++m) { const int r = u.pm * BM + ai * HALF + wr * 64 + m * 16 + fr; const size_t off = (size_t)r * DM + col0; const bf16_t* gp = gate + (size_t)r * ldg + col0;
#pragma unroll
                for (int bj = 0; bj < 2; ++bj)
#pragma unroll
                    for (int n = 0; n < 2; ++n) { const int co = bj * HALF + n * 16;
                        const u32x2 gv = *(const u32x2*)(gp + co);
                        f32x4 s; s[0] = sigm_f(__uint_as_float(gv.x << 16)); s[1] = sigm_f(__uint_as_float(gv.x & 0xffff0000u)); s[2] = sigm_f(__uint_as_float(gv.y << 16)); s[3] = sigm_f(__uint_as_float(gv.y & 0xffff0000u));
                        f32x4 val = s * acc[ai][bj][m][n];
                        if (MODE == 0) { *(f32x4*)(y32 + off + co) = val; }
                        else if (MODE == 1) { *(f32x4*)(y32 + off + co) = *(const f32x4*)(y32 + off + co) + val; }
                        else { val = val + *(const f32x4*)(y32 + off + co); u32x2 w; w.x = cvt_pk_bf16(val[0], val[1]); w.y = cvt_pk_bf16(val[2], val[3]); *(u32x2*)(ybf + off + co) = w; } }
                if (m & 1) asm volatile("" ::: "memory"); }
    }
};

template <class Epi, class Sched, bool ALIGN_EPI = false, bool SP2 = false>
__device__ __forceinline__ void gemm_phase(PG8_LAS unsigned char* lds, const Gemm g, const Sched& S, const Epi& E) {
    int tid_ = threadIdx.x; asm volatile("" : "+v"(tid_)); const int tid = tid_, wid = __builtin_amdgcn_readfirstlane(tid >> 6), lane = tid & 63, wr = wid >> 2, wc = wid & 3, fr = lane & 15, fq = lane >> 4;
    const int K = g.K, nt = K / BK;
    unsigned voffA[2], voffB[2];
#pragma unroll
    for (int i = 0; i < 2; ++i) { int R, C; stage_rc(tid * 16 + i * 8192, R, C); const int Rb = Epi::PERM ? ((R & ~31) + perm32(R & 31)) : R;
        voffA[i] = (unsigned)(R * K + C) * 2u; voffB[i] = (unsigned)(Rb * K + C) * 2u; }
    const size_t kstep = (size_t)(BK * 2);
    const size_t hstep = (size_t)HALF * K * 2;
    const size_t tstep = 2 * hstep;
    const unsigned ldsw = (unsigned)wid * 1024u;
    const int aoff = lds_byte(wr * 64 + fr, fq * 8), boff = lds_byte(wc * 32 + fr, fq * 8);
#define PG8_SA(b, h) (((b) * 2 + (h)) * HTB)
#define PG8_SB(b, h) ((4 + (b) * 2 + (h)) * HTB)
#define PG8_STAGE(bufoff, gbase, voff) do { _Pragma("unroll") for (int _i = 0; _i < 2; ++_i) \
        __builtin_amdgcn_global_load_lds((const unsigned*)((const char*)(gbase) + (voff)[_i]), (PG8_LAS unsigned*)(lds + (bufoff) + ldsw + _i * 8192), 16, 0, 0); } while (0)
#define PG8_LDA(dst, b, h) do { _Pragma("unroll") for (int m = 0; m < 4; ++m) _Pragma("unroll") for (int k = 0; k < 2; ++k) dst[m][k] = *(const PG8_LAS bf16x8*)(lds + PG8_SA(b, h) + aoff + m * 2048 + k * 1024); } while (0)
#define PG8_LDB(dst, b, h) do { _Pragma("unroll") for (int n = 0; n < 2; ++n) _Pragma("unroll") for (int k = 0; k < 2; ++k) dst[n][k] = *(const PG8_LAS bf16x8*)(lds + PG8_SB(b, h) + boff + n * 2048 + k * 1024); } while (0)
#define PG8_MMA(ai, bj, At, Bt) do { __builtin_amdgcn_s_setprio(1); _Pragma("unroll") for (int m = 0; m < 4; ++m) _Pragma("unroll") for (int n = 0; n < 2; ++n) _Pragma("unroll") for (int k = 0; k < 2; ++k) \
        acc[ai][bj][m][n] = __builtin_amdgcn_mfma_f32_16x16x32_bf16(Bt[n][k], At[m][k], acc[ai][bj][m][n], 0, 0, 0); __builtin_amdgcn_s_setprio(0); } while (0)
#define PG8_WAIT_V(n) asm volatile("s_waitcnt vmcnt(" #n ")" ::: "memory")
#define PG8_WAIT_L(n) asm volatile("s_waitcnt lgkmcnt(" #n ")" ::: "memory")
#define PG8_BAR __builtin_amdgcn_s_barrier()
#define PG8_SCHED __builtin_amdgcn_sched_barrier(0)
    Unit cur, nxt; int ui = 0;
    if (!S.next(0, cur)) return;
    f32x4 acc[2][2][4][2];
#pragma unroll
    for (int a = 0; a < 2; ++a)
#pragma unroll
        for (int b = 0; b < 2; ++b)
#pragma unroll
            for (int m = 0; m < 4; ++m)
#pragma unroll
                for (int n = 0; n < 2; ++n) acc[a][b][m][n] = (f32x4){0.f, 0.f, 0.f, 0.f};
    bf16x8 At[4][2], B0[2][2], B1[2][2];
    const char* cA = (const char*)g.A + (size_t)cur.pm * tstep; const char* cB = (const char*)g.Bt + (size_t)cur.pn * tstep;
    S.a_ready(cur);
    if constexpr (SP2) {
        PG8_STAGE(PG8_SB(0, 0), cB, voffB); PG8_STAGE(PG8_SB(0, 1), cB + hstep, voffB); PG8_STAGE(PG8_SA(0, 0), cA, voffA); PG8_STAGE(PG8_SA(0, 1), cA + hstep, voffA);
        if (wr == 1) PG8_BAR;
        PG8_WAIT_V(2); PG8_BAR;
        PG8_STAGE(PG8_SB(1, 0), cB + kstep, voffB); PG8_STAGE(PG8_SA(1, 0), cA + kstep, voffA); PG8_STAGE(PG8_SB(1, 1), cB + hstep + kstep, voffB);
        PG8_WAIT_V(6); PG8_BAR;
    } else {
        PG8_STAGE(PG8_SB(0, 0), cB, voffB); PG8_STAGE(PG8_SA(0, 0), cA, voffA); PG8_STAGE(PG8_SB(0, 1), cB + hstep, voffB); PG8_STAGE(PG8_SA(0, 1), cA + hstep, voffA);
        if (wr == 1) PG8_BAR;
        PG8_WAIT_V(4); PG8_BAR;
        PG8_STAGE(PG8_SB(1, 0), cB + kstep, voffB); PG8_STAGE(PG8_SA(1, 0), cA + kstep, voffA); PG8_STAGE(PG8_SB(1, 1), cB + hstep + kstep, voffB);
        PG8_WAIT_V(6); PG8_BAR;
    }
    for (;;) {
        const bool has_next = S.next(ui + 1, nxt);
        const char* nA = has_next ? (const char*)g.A + (size_t)nxt.pm * tstep : cA; const char* nB = has_next ? (const char*)g.Bt + (size_t)nxt.pn * tstep : cB;
        for (int t = 0; t < nt; t += 2) {
            const bool last = (t == nt - 2);
            const char* a1 = cA + (size_t)(t + 1) * kstep;
            const char* a2 = last ? nA : cA + (size_t)(t + 2) * kstep; const char* b2 = last ? nB : cB + (size_t)(t + 2) * kstep;
            const char* a3 = a2 + kstep; const char* b3 = b2 + kstep;
            if (last && has_next) S.a_ready(nxt);
            if constexpr (SP2) {
            PG8_LDB(B0, 0, 0); PG8_LDB(B1, 0, 1); PG8_SCHED; PG8_LDA(At, 0, 0); PG8_STAGE(PG8_SA(1, 1), a1 + hstep, voffA);
            PG8_WAIT_V(8); PG8_WAIT_L(0); PG8_BAR; PG8_MMA(0, 0, At, B0); PG8_MMA(0, 1, At, B1); PG8_BAR; PG8_SCHED;
            PG8_LDA(At, 0, 1); PG8_STAGE(PG8_SB(0, 0), b2, voffB); PG8_STAGE(PG8_SB(0, 1), b2 + hstep, voffB); PG8_STAGE(PG8_SA(0, 0), a2, voffA);
            PG8_WAIT_V(8); PG8_WAIT_L(0); PG8_BAR; PG8_MMA(1, 0, At, B0); PG8_MMA(1, 1, At, B1); PG8_BAR; PG8_SCHED;
            PG8_LDB(B0, 1, 0); PG8_LDB(B1, 1, 1); PG8_SCHED; PG8_LDA(At, 1, 0); PG8_STAGE(PG8_SA(0, 1), a2 + hstep, voffA);
            PG8_WAIT_V(8); PG8_WAIT_L(0); PG8_BAR; PG8_MMA(0, 0, At, B0); PG8_MMA(0, 1, At, B1); PG8_BAR; PG8_SCHED;
            PG8_LDA(At, 1, 1); PG8_STAGE(PG8_SB(1, 0), b3, voffB); PG8_STAGE(PG8_SB(1, 1), b3 + hstep, voffB); PG8_STAGE(PG8_SA(1, 0), a3, voffA);
            PG8_WAIT_V(8); PG8_WAIT_L(0); PG8_BAR; PG8_MMA(1, 0, At, B0); PG8_MMA(1, 1, At, B1); PG8_BAR; PG8_SCHED;
            } else {
            PG8_LDB(B0, 0, 0); PG8_SCHED; PG8_LDA(At, 0, 0); PG8_STAGE(PG8_SA(1, 1), a1 + hstep, voffA);
            PG8_WAIT_L(8); PG8_BAR; PG8_WAIT_L(0); PG8_MMA(0, 0, At, B0); PG8_BAR; PG8_SCHED;
            PG8_LDB(B1, 0, 1); PG8_STAGE(PG8_SB(0, 0), b2, voffB);
            PG8_BAR; PG8_WAIT_L(0); PG8_MMA(0, 1, At, B1); PG8_BAR;
            PG8_LDA(At, 0, 1); PG8_STAGE(PG8_SA(0, 0), a2, voffA);
            PG8_BAR; PG8_WAIT_L(0); PG8_MMA(1, 0, At, B0); PG8_BAR; PG8_SCHED;
            PG8_STAGE(PG8_SB(0, 1), b2 + hstep, voffB);
            PG8_WAIT_V(6); PG8_BAR; PG8_MMA(1, 1, At, B1); PG8_BAR;
            PG8_LDB(B0, 1, 0); PG8_SCHED; PG8_LDA(At, 1, 0); PG8_STAGE(PG8_SA(0, 1), a2 + hstep, voffA);
            PG8_WAIT_L(8); PG8_BAR; PG8_WAIT_L(0); PG8_MMA(0, 0, At, B0); PG8_BAR; PG8_SCHED;
            PG8_LDB(B1, 1, 1); PG8_STAGE(PG8_SB(1, 0), b3, voffB);
            PG8_BAR; PG8_WAIT_L(0); PG8_MMA(0, 1, At, B1); PG8_BAR;
            PG8_LDA(At, 1, 1); PG8_STAGE(PG8_SA(1, 0), a3, voffA);
            PG8_BAR; PG8_WAIT_L(0); PG8_MMA(1, 0, At, B0); PG8_BAR; PG8_SCHED;
            PG8_STAGE(PG8_SB(1, 1), b3 + hstep, voffB);
            PG8_WAIT_V(6); PG8_BAR; PG8_MMA(1, 1, At, B1); PG8_BAR;
            }
        }
        if constexpr (ALIGN_EPI) { if (wr == 0) PG8_BAR; }
        if constexpr (!Epi::AFTER_DRAIN) { E(acc, cur, wr, wc, fr, fq); S.done(cur); }
        if (!has_next) break;
#pragma unroll
        for (int a = 0; a < 2; ++a)
#pragma unroll
            for (int b = 0; b < 2; ++b)
#pragma unroll
                for (int m = 0; m < 4; ++m)
#pragma unroll
                    for (int n = 0; n < 2; ++n) acc[a][b][m][n] = (f32x4){0.f, 0.f, 0.f, 0.f};
        cur = nxt; cA = nA; cB = nB; ++ui;
        if constexpr (ALIGN_EPI) { if (wr == 1) PG8_BAR; }
    }
    PG8_WAIT_V(0);
    if constexpr (!ALIGN_EPI) { if (wr == 0) PG8_BAR; }
    PG8_BAR;
    if constexpr (Epi::AFTER_DRAIN) { E.fused(acc, cur, wr, wc, fr, fq, lds, wid, lane); S.done(cur); }
#undef PG8_SA
#undef PG8_SB
#undef PG8_STAGE
#undef PG8_LDA
#undef PG8_LDB
#undef PG8_MMA
#undef PG8_WAIT_V
#undef PG8_WAIT_L
#undef PG8_BAR
#undef PG8_SCHED
}
}
namespace att {
typedef unsigned short bf16;
using bf16x8 = __attribute__((ext_vector_type(8))) short;
using s16x4  = __attribute__((ext_vector_type(4))) short;
using f32x16 = __attribute__((ext_vector_type(16))) float;
using u32x4  = __attribute__((ext_vector_type(4))) unsigned;
constexpr int NW = 8, QBLK = 32, KVBLK = 64;
constexpr float SCALE = 0.125f;
constexpr float THR = 8.f;
constexpr int LDP = 17408;
constexpr int LDO = 1024;
constexpr size_t SHM_V = KVBLK * 128 * 2, SHM_K = KVBLK * 64 * 2, SHM_ATTN = 2 * SHM_V + 2 * SHM_K + NW * 64 * 4;
#define KSWZ64(row, colB) ((row) * 128 + ((colB) ^ ((((row) >> 1) & 7) << 4)))
#define SBAR() __builtin_amdgcn_sched_barrier(0)
__device__ __forceinline__ int crow(int r, int hi) { return (r & 3) + 8 * (r >> 2) + 4 * hi; }
__device__ __forceinline__ unsigned cvtpk(float lo, float hi) { unsigned r; asm volatile("v_cvt_pk_bf16_f32 %0, %1, %2" : "=v"(r) : "v"(lo), "v"(hi)); return r; }
__device__ __forceinline__ bf16x8 ld8(const bf16* p) { return *reinterpret_cast<const bf16x8*>(p); }

__device__ __forceinline__ void partialSM(f32x16& p0, f32x16& p1, float& m_reg, float& mn, float& alpha) {
  constexpr float C = SCALE * 1.4426950408889634f;
  float pmax = p0[0];
#pragma unroll
  for (int r = 1; r < 16; ++r) pmax = fmaxf(pmax, p0[r]);
#pragma unroll
  for (int r = 0; r < 16; ++r) pmax = fmaxf(pmax, p1[r]);
  { auto rr = __builtin_amdgcn_permlane32_swap(__float_as_uint(pmax), __float_as_uint(pmax), false, false);
    pmax = fmaxf(__uint_as_float(rr[0]), __uint_as_float(rr[1])); }
  if (__builtin_expect(__all(pmax - m_reg <= THR / SCALE), 1)) { mn = m_reg; alpha = 1.f; }
  else { mn = fmaxf(m_reg, pmax); alpha = __builtin_amdgcn_exp2f((m_reg - mn) * C); m_reg = mn; }
  float mnC = -mn * C;
#pragma unroll
  for (int r = 0; r < 16; ++r) p0[r] = fmaf(p0[r], C, mnC);
#pragma unroll
  for (int r = 0; r < 16; ++r) p1[r] = fmaf(p1[r], C, mnC);
#pragma unroll
  for (int r = 0; r < 16; ++r) p0[r] = __builtin_amdgcn_exp2f(p0[r]);
}
__device__ __forceinline__ void finishSM(f32x16& p0, f32x16& p1, float alpha, float& l_reg, bf16x8& pa0, bf16x8& pa1, bf16x8& pa2, bf16x8& pa3) {
#pragma unroll
  for (int r = 0; r < 16; ++r) p1[r] = __builtin_amdgcn_exp2f(p1[r]);
  float ps = 0;
#pragma unroll
  for (int r = 0; r < 16; ++r) ps += p0[r];
#pragma unroll
  for (int r = 0; r < 16; ++r) ps += p1[r];
  { auto rr = __builtin_amdgcn_permlane32_swap(__float_as_uint(ps), __float_as_uint(ps), false, false);
    ps = __uint_as_float(rr[0]) + __uint_as_float(rr[1]); }
  l_reg = l_reg * alpha + ps;
#define PK4(P, BASE, OUT) do { unsigned a0 = cvtpk(P[BASE + 0], P[BASE + 1]), a1 = cvtpk(P[BASE + 2], P[BASE + 3]);   \
    unsigned b0 = cvtpk(P[BASE + 4], P[BASE + 5]), b1 = cvtpk(P[BASE + 6], P[BASE + 7]);                              \
    auto r0 = __builtin_amdgcn_permlane32_swap(a0, b0, false, false); auto r1 = __builtin_amdgcn_permlane32_swap(a1, b1, false, false); \
    u32x4 w = {r0[0], r1[0], r0[1], r1[1]}; OUT = *reinterpret_cast<bf16x8*>(&w); } while (0)
  PK4(p0, 0, pa0); PK4(p0, 8, pa1); PK4(p1, 0, pa2); PK4(p1, 8, pa3);
#undef PK4
}
__device__ __forceinline__ void qkt(f32x16& p0, f32x16& p1, const bf16* Ks, const bf16x8* qr, int r32, int hi) {
  p0 = f32x16{}; p1 = f32x16{};
#pragma unroll
  for (int d0 = 0; d0 < 4; ++d0) { int cb = (d0 * 16 + hi * 8) * 2;
    bf16x8 b0 = *reinterpret_cast<const bf16x8*>((const char*)Ks + KSWZ64(r32, cb));
    bf16x8 b1 = *reinterpret_cast<const bf16x8*>((const char*)Ks + KSWZ64(32 + r32, cb));
    p0 = __builtin_amdgcn_mfma_f32_32x32x16_bf16(b0, qr[d0], p0, 0, 0, 0);
    p1 = __builtin_amdgcn_mfma_f32_32x32x16_bf16(b1, qr[d0], p1, 0, 0, 0); }
}
__device__ __forceinline__ int v_st(int k, int c) { const int kk = (k & ~0xC) | ((k & 4) << 1) | ((k & 8) >> 1); return ((kk >> 3) * 4 + (c >> 5)) * 512 + ((kk & 7) * 32 + (c & 31)) * 2; }
__device__ __forceinline__ int v_rd_base(int lane) { return ((lane & 3) << 3) | (((lane >> 2) & 3) << 6) | (((lane >> 4) & 1) << 5) | (((lane >> 5) & 1) << 8); }
constexpr int v_rd_off(int d0, int ks, int half) { return d0 * 512 + ks * 4096 + half * 2048; }
template <int OFF> __device__ __forceinline__ s16x4 tr_read(int vb) {
  s16x4 r; asm volatile("ds_read_b64_tr_b16 %0, %1 offset:%2" : "=&v"(r) : "v"(vb), "i"(OFF) : "memory"); return r;
}
template <int D0> __device__ __forceinline__ void pv_one(f32x16& od, int vb, bf16x8 pa0, bf16x8 pa1, bf16x8 pa2, bf16x8 pa3) {
  const s16x4 l0 = tr_read<v_rd_off(D0, 0, 0)>(vb), h0 = tr_read<v_rd_off(D0, 0, 1)>(vb), l1 = tr_read<v_rd_off(D0, 1, 0)>(vb), h1 = tr_read<v_rd_off(D0, 1, 1)>(vb);
  const s16x4 l2 = tr_read<v_rd_off(D0, 2, 0)>(vb), h2 = tr_read<v_rd_off(D0, 2, 1)>(vb), l3 = tr_read<v_rd_off(D0, 3, 0)>(vb), h3 = tr_read<v_rd_off(D0, 3, 1)>(vb);
  asm volatile("s_waitcnt lgkmcnt(0)" ::: "memory"); SBAR();
#define PK(L, H) (bf16x8){L[0], L[1], L[2], L[3], H[0], H[1], H[2], H[3]}
  od = __builtin_amdgcn_mfma_f32_32x32x16_bf16(pa0, PK(l0, h0), od, 0, 0, 0);
  od = __builtin_amdgcn_mfma_f32_32x32x16_bf16(pa1, PK(l1, h1), od, 0, 0, 0);
  od = __builtin_amdgcn_mfma_f32_32x32x16_bf16(pa2, PK(l2, h2), od, 0, 0, 0);
  od = __builtin_amdgcn_mfma_f32_32x32x16_bf16(pa3, PK(l3, h3), od, 0, 0, 0);
#undef PK
}
__device__ __forceinline__ void pv_d0(f32x16* o, int vb, bf16x8 pa0, bf16x8 pa1, bf16x8 pa2, bf16x8 pa3) {
  pv_one<0>(o[0], vb, pa0, pa1, pa2, pa3); pv_one<1>(o[1], vb, pa0, pa1, pa2, pa3); pv_one<2>(o[2], vb, pa0, pa1, pa2, pa3); pv_one<3>(o[3], vb, pa0, pa1, pa2, pa3);
}
__device__ __forceinline__ unsigned short f2bf_rne(float f) { unsigned u = __float_as_uint(f); return (unsigned short)((u + 0x7fffu + ((u >> 16) & 1u)) >> 16); }

__device__ __forceinline__ void attn_unit(const bf16* __restrict__ proj, int qrow0, int crow0, int lrow0, int NT, int h, int p, bf16* __restrict__ Oout, char* lds) {
  int tid_ = threadIdx.x; asm volatile("" : "+v"(tid_)); const int tid = tid_, wid = tid >> 6, lane = tid & 63, r32 = lane & 31, hi = lane >> 5;
  const int CQ = 8192 + 128 * h + 64 * p, CK = 9216 + 128 * h + 64 * p, CV = 10240 + 128 * h;
  bf16* V_lds = (bf16*)lds; bf16* K_lds = (bf16*)(lds + 2 * SHM_V);
  float* ws = (float*)(lds + 2 * SHM_V + 2 * SHM_K) + wid * 64; float* li_l = ws; float* al_l = ws + 32;
  float m_reg = -1e30f, l_reg = 0; f32x16 o[4] = {}; bf16x8 qr[4];
  const bf16* Qw = proj + (size_t)(qrow0 + wid * QBLK + r32) * LDP + CQ + hi * 8;
#pragma unroll
  for (int d0 = 0; d0 < 4; ++d0) qr[d0] = ld8(Qw + d0 * 16);
  const int sr = tid >> 4, sc = (tid & 15) * 8, vst0 = v_st(sr, sc), vst1 = v_st(32 + sr, sc);
  const int kr = tid >> 3, kc = (tid & 7) * 8, kst = KSWZ64(kr, kc * 2);
  const int vb0 = (int)(uintptr_t)V_lds + v_rd_base(lane);
  struct { bf16x8 vs0, vs1, ks0; } sr_[2];
#define TROW(jt) ((jt) < 4 ? crow0 + 64 * (jt) : lrow0 + 64 * ((jt) - 4))
#define SLOAD(i, jt) do { const size_t rb_ = (size_t)TROW(jt); sr_[i].vs0 = ld8(proj + (rb_ + sr) * LDP + CV + sc); sr_[i].vs1 = ld8(proj + (rb_ + 32 + sr) * LDP + CV + sc); \
    sr_[i].ks0 = ld8(proj + (rb_ + kr) * LDP + CK + kc); } while (0)
#define SWRITE(b, i) do { *(bf16x8*)((char*)V_lds + (b) * SHM_V + vst0) = sr_[i].vs0; *(bf16x8*)((char*)V_lds + (b) * SHM_V + vst1) = sr_[i].vs1; \
    *(bf16x8*)((char*)K_lds + (b) * SHM_K + kst) = sr_[i].ks0; } while (0)
#define SWAIT() asm volatile("s_waitcnt vmcnt(3)" ::: "memory")
#define RESC(a) do { if (__any((a) < 1.f)) { if (hi == 0) al_l[r32] = (a); asm volatile("s_waitcnt lgkmcnt(0)" ::: "memory"); \
    _Pragma("unroll") for (int d = 0; d < 4; ++d) _Pragma("unroll") for (int r = 0; r < 16; ++r) o[d][r] *= al_l[crow(r, hi)]; } } while (0)
  f32x16 pA0, pA1, pB0, pB1; float mnA, mnB, alA, alB; bf16x8 pa0, pa1, pa2, pa3;
  constexpr int SE = 0, SO = 1;
  SLOAD(SE, 0); asm volatile("s_waitcnt vmcnt(0)" ::: "memory"); SWRITE(0, SE); __syncthreads();
  qkt(pA0, pA1, K_lds, qr, r32, hi); partialSM(pA0, pA1, m_reg, mnA, alA);
  SLOAD(SO, 1); if (2 < NT) SLOAD(SE, 2);
  SWAIT(); SWRITE(1, SO); __syncthreads();
  for (int j = 1; j + 1 < NT; j += 2) {
    SBAR(); qkt(pB0, pB1, (bf16*)((char*)K_lds + SHM_K), qr, r32, hi);
    finishSM(pA0, pA1, alA, l_reg, pa0, pa1, pa2, pa3); SBAR();
    SLOAD(SO, j + 2); SBAR();
    pv_d0(o, vb0, pa0, pa1, pa2, pa3); partialSM(pB0, pB1, m_reg, mnB, alB);
    __syncthreads(); SWAIT(); SWRITE(0, SE);
    RESC(alB); __syncthreads();
    SBAR(); qkt(pA0, pA1, K_lds, qr, r32, hi);
    finishSM(pB0, pB1, alB, l_reg, pa0, pa1, pa2, pa3); SBAR();
    if (j + 3 < NT) SLOAD(SE, j + 3); SBAR();
    pv_d0(o, vb0 + (int)SHM_V, pa0, pa1, pa2, pa3); partialSM(pA0, pA1, m_reg, mnA, alA);
    __syncthreads(); SWAIT(); SWRITE(1, SO);
    RESC(alA); __syncthreads();
  }
  SBAR(); qkt(pB0, pB1, (bf16*)((char*)K_lds + SHM_K), qr, r32, hi);
  finishSM(pA0, pA1, alA, l_reg, pa0, pa1, pa2, pa3); SBAR();
  pv_d0(o, vb0, pa0, pa1, pa2, pa3); partialSM(pB0, pB1, m_reg, mnB, alB);
  __syncthreads(); RESC(alB);
  finishSM(pB0, pB1, alB, l_reg, pa0, pa1, pa2, pa3); SBAR();
  pv_d0(o, vb0 + (int)SHM_V, pa0, pa1, pa2, pa3);
  if (hi == 0) li_l[r32] = l_reg; asm volatile("s_waitcnt lgkmcnt(0)" ::: "memory");
  float rli[16];
#pragma unroll
  for (int r = 0; r < 16; ++r) rli[r] = __builtin_amdgcn_rcpf(li_l[crow(r, hi)]);
  bf16* Ow = Oout + (size_t)(qrow0 + wid * QBLK) * LDO + 128 * h;
#pragma unroll
  for (int r = 0; r < 16; ++r) { const int orow = crow(r, hi);
#pragma unroll
    for (int d0 = 0; d0 < 4; ++d0) Ow[(size_t)orow * LDO + d0 * 32 + r32] = f2bf_rne(o[d0][r] * rli[r]); }
  __syncthreads();
#undef TROW
#undef SLOAD
#undef SWRITE
#undef SWAIT
#undef RESC
}
#undef SBAR
}

constexpr int NWAVES = 8;
#ifndef MK_N_LAUNCHES
#define MK_N_LAUNCHES 1
#endif
constexpr int D = 2048, NLAT = 16384, NCTX = 512, MTOT = NLAT + NCTX, SEQ = 8192, CTXL = 256, FF = 5632, WIN = 17408, MODW = 18432, MIXW = 1024;
constexpr int C_HQ = 0, C_HF = 1024, C_HB = 2048, C_HI = 3072, C_HG = 4096, C_CB = 5120, C_CC = 6144, C_CU = 7168, C_AQ = 8192, C_AK = 9216, C_AV = 10240, C_GA = 11264, C_GB = 13312, C_GC = 15360;
constexpr int NCHUNK = 132;
constexpr int NSEQ = 32;
constexpr float EPS = 1e-6f;
constexpr int NPL = 13;
constexpr int NPHASE = 1 + 2 * NPL + 1;

constexpr size_t MiB = 1u << 20;
constexpr size_t WS_CTL = 0, CTL_ZERO_BYTES = 1 * MiB;
constexpr size_t WS_MOD = 1 * MiB;
constexpr size_t WS_HCTX = 2 * MiB;
constexpr size_t WS_W13T = 6 * MiB;
constexpr size_t WS_W2T = WS_W13T + 88 * MiB;
constexpr size_t WS_WINT = WS_W2T + 44 * MiB;
constexpr size_t WS_WBT = WS_WINT + 68 * MiB;
constexpr size_t WS_WOT = WS_WBT + 12 * MiB;
constexpr size_t WS_XN = WS_WOT + 8 * MiB;
constexpr size_t WS_PROJ = WS_XN + 66 * MiB;
constexpr size_t WS_ST = WS_PROJ + 561 * MiB;
constexpr size_t WS_DEC = WS_ST + 132 * MiB;
constexpr size_t WS_BR = WS_DEC + 3 * MiB;
constexpr size_t WS_OP = WS_BR + 99 * MiB;
constexpr size_t WS_END = WS_OP + 66 * MiB;
static_assert((size_t)MTOT * WIN * 2 <= 561 * MiB && (size_t)4224 * 16384 * 2 <= 132 * MiB && (size_t)MTOT * D * 4 <= 132 * MiB && (size_t)3 * MTOT * MIXW * 2 <= 99 * MiB, "d_ws map");
constexpr int CW_BAR = 4096;

constexpr int RING_OFF = 0, RING_BYTES = 131072;
constexpr int LDSCTL_OFF = RING_BYTES, MISC_OFF = LDSCTL_OFF + 320;
constexpr int LDS_BYTES = 147456;

#define GAS __attribute__((address_space(1)))
#define LAS __attribute__((address_space(3)))
typedef unsigned short bf16;
typedef unsigned v4u __attribute__((ext_vector_type(4)));
typedef unsigned v2u __attribute__((ext_vector_type(2)));
typedef float f32x4 __attribute__((ext_vector_type(4)));
typedef short bf16x8 __attribute__((ext_vector_type(8)));
typedef GAS unsigned gu32;
#define RLX_AGENT __ATOMIC_RELAXED, __HIP_MEMORY_SCOPE_AGENT
#define LDS_WAIT() asm volatile("s_waitcnt lgkmcnt(0)" ::: "memory")
#define VM_WAIT() asm volatile("s_waitcnt vmcnt(0)" ::: "memory")
__device__ __forceinline__ unsigned f2bf(float f) { unsigned u = __builtin_bit_cast(unsigned, f); return (u + 0x7fffu + ((u >> 16) & 1u)) >> 16; }
__device__ __forceinline__ unsigned pk2(float lo, float hi) { return f2bf(lo) | (f2bf(hi) << 16); }
__device__ __forceinline__ float bflo(unsigned w) { return __uint_as_float(w << 16); }
__device__ __forceinline__ float bfhi(unsigned w) { return __uint_as_float(w & 0xffff0000u); }
__device__ __forceinline__ float silu_f(float x) { return x * __builtin_amdgcn_rcpf(1.0f + __expf(-x)); }
__device__ __forceinline__ float sigm_f(float x) { return __builtin_amdgcn_rcpf(1.0f + __expf(-x)); }

#define XB_TMO      128
#define XB_XCNT(j)  (256  + 64 * (j))
#define XB_XSUB(j)  (1280 + 64 * (j))
#define XB_XGEN(j)  (2304 + 64 * (j))
#define XB_TOP      3328
#define XB_TOPGEN   3392
#define XCD_BAR_WORDS 3456
#define XB_SPIN_CAP (1u << 18)

__device__ __forceinline__ unsigned xb_ld(unsigned* p)              { return __hip_atomic_load(p, __ATOMIC_RELAXED, __HIP_MEMORY_SCOPE_AGENT); }
__device__ __forceinline__ unsigned xb_add(unsigned* p, unsigned v) { return __hip_atomic_fetch_add(p, v, __ATOMIC_RELAXED, __HIP_MEMORY_SCOPE_AGENT); }
__device__ __forceinline__ unsigned xb_xcc_id() { return (unsigned)__builtin_amdgcn_s_getreg((3 << 11) | 20) & 0xFu; }
#define XB_SPIN(cond, bar) do { unsigned _sp = 0; while (cond) { __builtin_amdgcn_s_sleep(1); \
    if ((++_sp & 255u) == 0u) { if (xb_ld(&(bar)[XB_TMO])) break; if (_sp > XB_SPIN_CAP) { atomicAdd(&(bar)[XB_TMO], 1u); break; } } } } while (0)

struct XcdBarrier {
    unsigned* bar; unsigned x;
    volatile LAS unsigned* st;
};

__device__ __forceinline__ XcdBarrier xcd_barrier_post(unsigned* bar, volatile LAS unsigned* st) {
    XcdBarrier b; b.bar = bar; b.x = xb_xcc_id(); b.st = st;
    if (threadIdx.x == 0) (void)xb_add(&bar[XB_XCNT(b.x)], 1u);
    return b;
}
__device__ __forceinline__ void xcd_barrier_complete(unsigned* bar, unsigned x, unsigned& nloc, unsigned& nx) {
    const unsigned G = gridDim.x * gridDim.y * gridDim.z;
    unsigned sum, cnt, mine, sp = 0u;
    for (;;) {
        sum = 0u; cnt = 0u; mine = 0u;
#pragma unroll
        for (unsigned j = 0; j < 16; ++j) { const unsigned c = xb_ld(&bar[XB_XCNT(j)]); sum += c; cnt += (c > 0u) ? 1u : 0u; mine = (j == x) ? c : mine; }
        if (sum == G) break;
        __builtin_amdgcn_s_sleep(1);
        if ((++sp & 255u) == 0u) { if (xb_ld(&bar[XB_TMO])) break; if (sp > XB_SPIN_CAP) { atomicAdd(&bar[XB_TMO], 1u); break; } }
    }
    nloc = mine > 0u ? mine : 1u; nx = cnt > 0u ? cnt : 1u;
}

__device__ __forceinline__ void xcd_barrier(const XcdBarrier& b) {
    asm volatile("s_waitcnt vmcnt(0)" ::: "memory");
    __syncthreads();
    if (threadIdx.x == 0) {
        unsigned* bar = b.bar;
        __builtin_amdgcn_s_waitcnt(0);
        unsigned nloc = b.st[0], nx = b.st[1];
        if (nloc == 0u) { xcd_barrier_complete(bar, b.x, nloc, nx); b.st[0] = nloc; b.st[1] = nx; }
        const unsigned old = xb_add(&bar[XB_XSUB(b.x)], 1u);
        const unsigned gen = old / nloc;
        if (old + 1u == (gen + 1u) * nloc) {
            __builtin_amdgcn_fence(__ATOMIC_RELEASE, "agent");
            asm volatile("s_waitcnt vmcnt(0)" ::: "memory");
            const unsigned og = xb_add(&bar[XB_TOP], 1u);
            const unsigned tg = og / nx;
            if (og + 1u == (tg + 1u) * nx) xb_add(&bar[XB_TOPGEN], 1u);
            else XB_SPIN(xb_ld(&bar[XB_TOPGEN]) == tg, bar);
            __builtin_amdgcn_fence(__ATOMIC_ACQUIRE, "agent");
            xb_add(&bar[XB_XGEN(b.x)], 1u);
            asm volatile("s_waitcnt vmcnt(0)" ::: "memory");
        } else {
            XB_SPIN(xb_ld(&bar[XB_XGEN(b.x)]) == gen, bar);
            __builtin_amdgcn_fence(__ATOMIC_ACQUIRE, "agent");
            asm volatile("s_waitcnt vmcnt(0)" ::: "memory");
        }
    }
    __syncthreads();
}

struct Frame {
    LAS unsigned char* lds;
    volatile LAS unsigned* MISC;
    gu32* ctl;
    unsigned char* ws;
    float* out;
    int tid, lane, wave;
    int vcu, G, bx;
};
__device__ __forceinline__ void launder(Frame& P) {
    int t = P.tid; asm volatile("" : "+v"(t)); P.tid = t; P.lane = t & 63; P.wave = __builtin_amdgcn_readfirstlane(t >> 6);
    unsigned long long w = (unsigned long long)P.ws, o = (unsigned long long)P.out; int g = P.G, v = P.vcu, x = P.bx;
    asm volatile("" : "+s"(w), "+s"(o), "+s"(g), "+s"(v), "+s"(x));
    P.ws = (unsigned char*)w; P.out = (float*)o; P.G = g; P.vcu = v; P.bx = x;
}
__device__ __forceinline__ const float* in_ptr(int k) {
    auto kp = (const float* const __attribute__((address_space(4)))*)__builtin_amdgcn_kernarg_segment_ptr();
    int kk = k; asm volatile("" : "+s"(kk));
    return kp[kk];
}
#define IP_X in_ptr(0)
#define IP_C in_ptr(1)
#define IP_CTX in_ptr(2)
#define IP_CCTX in_ptr(3)
#define IP_WADA in_ptr(4)
#define IP_BADA in_ptr(5)
#define IP_NORMW in_ptr(6)
#define IP_W13 in_ptr(7)
#define IP_W2 in_ptr(8)
#define IP_WIN in_ptr(9)
#define IP_HLB in_ptr(10)
#define IP_HNW in_ptr(11)
#define IP_CONVW in_ptr(12)
#define IP_LAM in_ptr(13)
#define IP_DANW in_ptr(14)
#define IP_WBR in_ptr(15)
#define IP_WOUT in_ptr(16)
#define IP_FNW in_ptr(17)
#define W_HCTX ((float*)(F.ws + WS_HCTX))
#define W_MOD ((float*)(F.ws + WS_MOD))
#define W_W13T ((bf16*)(F.ws + WS_W13T))
#define W_W2T ((bf16*)(F.ws + WS_W2T))
#define W_WINT ((bf16*)(F.ws + WS_WINT))
#define W_WBT ((bf16*)(F.ws + WS_WBT))
#define W_WOT ((bf16*)(F.ws + WS_WOT))
#define W_XN ((bf16*)(F.ws + WS_XN))
#define W_PROJ ((bf16*)(F.ws + WS_PROJ))
#define W_HID ((bf16*)(F.ws + WS_PROJ))
#define W_ST ((bf16*)(F.ws + WS_ST))
#define W_BR ((bf16*)(F.ws + WS_BR))
#define W_OP ((bf16*)(F.ws + WS_OP))
#define W_Y32 ((float*)(F.ws + WS_ST))
#define W_DEC ((float*)(F.ws + WS_DEC))

__device__ __forceinline__ float wave_sum(float v) {
#pragma unroll
    for (int o = 1; o < 64; o <<= 1) v += __shfl_xor(v, o);
    return v;
}

__device__ __forceinline__ void p_ada(Frame& F) {
    LAS float* sc = (LAS float*)(F.lds + RING_OFF);
    LAS float* red = sc + 3 * D;
    const float* cvec = IP_C; const float* ccv = IP_CCTX; const float* wada = IP_WADA; const float* bada = IP_BADA; float* modp = W_MOD;
    for (int i = F.tid; i < 3 * D; i += NWAVES * 64) { const int g = i / D, k = i - g * D; const float v = (g < 2) ? cvec[g * D + k] : ccv[k]; sc[i] = silu_f(v); }
    __syncthreads();
    for (int unit = F.bx; unit < 2 * (MODW / 64); unit += F.G) {
        const int layer = unit / (MODW / 64), cb = unit - layer * (MODW / 64), col = cb * 64 + F.lane;
        const float* W = wada + (size_t)layer * D * MODW + col;
        const int k0 = F.wave * 256; float a0 = 0.f, a1 = 0.f, a2 = 0.f;
#pragma unroll 8
        for (int k = k0; k < k0 + 256; ++k) { const float w = W[(size_t)k * MODW]; a0 += sc[k] * w; a1 += sc[D + k] * w; a2 += sc[2 * D + k] * w; }
        red[(F.wave * 3 + 0) * 64 + F.lane] = a0; red[(F.wave * 3 + 1) * 64 + F.lane] = a1; red[(F.wave * 3 + 2) * 64 + F.lane] = a2;
        __syncthreads();
        if (F.wave < 3) { float s = 0.f;
#pragma unroll
            for (int w = 0; w < 8; ++w) s += red[(w * 3 + F.wave) * 64 + F.lane];
            modp[(size_t)(layer * 3 + F.wave) * MODW + col] = s + bada[(size_t)layer * MODW + col]; }
        __syncthreads();
    }
}

__device__ __forceinline__ void transpose_item(const float* W, int K, int N, bf16* WT, int k0, int n0, int drow0, LAS float* scr, int lane) {
#pragma unroll 8
    for (int i = 0; i < 32; ++i) { const int kk = 2 * i + (lane >> 5); scr[kk * 33 + (lane & 31)] = W[(size_t)(k0 + kk) * N + n0 + (lane & 31)]; }
    LDS_WAIT(); asm volatile("" ::: "memory");
    const int c = lane & 7;
#pragma unroll
    for (int j = 0; j < 4; ++j) { const int n = (lane >> 3) + 8 * j; const LAS float* s = scr + (8 * c) * 33 + n;
        v4u o; o.x = pk2(s[0 * 33], s[1 * 33]); o.y = pk2(s[2 * 33], s[3 * 33]); o.z = pk2(s[4 * 33], s[5 * 33]); o.w = pk2(s[6 * 33], s[7 * 33]);
        *(GAS v4u*)(WT + (size_t)(drow0 + n) * K + k0 + 8 * c) = o; }
    LDS_WAIT(); asm volatile("" ::: "memory");
}
__device__ __forceinline__ void p_convert(Frame& F, int layer) {
    LAS float* scr = (LAS float*)(F.lds + RING_OFF + F.wave * 16384);
    const int gw = F.vcu * NWAVES + F.wave, NGW = F.G * NWAVES;
    constexpr int I13 = (D / 64) * (2 * FF / 32), I2 = (FF / 64) * (D / 32), IIN = (D / 64) * (WIN / 32), IBR = (MIXW / 64) * (D / 32), IOUT = (D / 64) * (D / 32);
    constexpr int NITEMS = 2 * I13 + 2 * I2 + IIN + 3 * IBR + IOUT;
    const float* pw13 = IP_W13; const float* pw2 = IP_W2; const float* pwin = IP_WIN; const float* pwbr = IP_WBR; const float* pwout = IP_WOUT;
    for (int it = gw; it < NITEMS; it += NGW) {
        int r = it;
        if (r < 2 * I13) { const int f = r / I13; r -= f * I13; const int nblk = 2 * FF / 32, kb = r / nblk, nb = r - kb * nblk; const int n0 = 32 * nb;
            const int half = n0 >= FF ? 1 : 0, nn = n0 - half * FF; const int drow0 = 256 * (nn >> 7) + 128 * half + (nn & 127);
            transpose_item(pw13 + (size_t)(layer * 2 + f) * D * 2 * FF, D, 2 * FF, W_W13T + (size_t)f * 2 * FF * D, 64 * kb, n0, drow0, scr, F.lane); continue; }
        r -= 2 * I13;
        if (r < 2 * I2) { const int f = r / I2; r -= f * I2; const int nblk = D / 32, kb = r / nblk, nb = r - kb * nblk;
            transpose_item(pw2 + (size_t)(layer * 2 + f) * FF * D, FF, D, W_W2T + (size_t)f * D * FF, 64 * kb, 32 * nb, 32 * nb, scr, F.lane); continue; }
        r -= 2 * I2;
        if (r < IIN) { const int nblk = WIN / 32, kb = r / nblk, nb = r - kb * nblk;
            transpose_item(pwin + (size_t)layer * D * WIN, D, WIN, W_WINT, 64 * kb, 32 * nb, 32 * nb, scr, F.lane); continue; }
        r -= IIN;
        if (r < 3 * IBR) { const int f = r / IBR; r -= f * IBR; const int nblk = D / 32, kb = r / nblk, nb = r - kb * nblk;
            transpose_item(pwbr + (size_t)(layer * 3 + f) * MIXW * D, MIXW, D, W_WBT + (size_t)f * D * MIXW, 64 * kb, 32 * nb, 32 * nb, scr, F.lane); continue; }
        r -= 3 * IBR;
        { const int nblk = D / 32, kb = r / nblk, nb = r - kb * nblk;
            transpose_item(pwout + (size_t)layer * D * D, D, D, W_WOT, 64 * kb, 32 * nb, 32 * nb, scr, F.lane); }
    }
}

__device__ __forceinline__ void p_norm(Frame& F, const float* hl, const float* hc, const float* nw, const float* modl, int which, int nrows) {
    const int gw = F.vcu * NWAVES + F.wave, NGW = F.G * NWAVES;
    for (int row = gw; row < nrows; row += NGW) {
        const float* src = row < NLAT ? hl + (size_t)row * D : hc + (size_t)(row - NLAT) * D;
        const int g = row < SEQ ? 0 : (row < NLAT ? 1 : 2);
        const float* shift = modl + (size_t)g * MODW + (3 * which) * D; const float* scale = shift + D;
        const GAS f32x4* xr = (const GAS f32x4*)src + F.lane;
        f32x4 v[8]; float s = 0.f;
#pragma unroll
        for (int j = 0; j < 8; ++j) { v[j] = xr[64 * j]; s += (v[j].x * v[j].x + v[j].y * v[j].y) + (v[j].z * v[j].z + v[j].w * v[j].w); }
        const float rstd = 1.0f / sqrtf(wave_sum(s) * (1.f / D) + EPS);
        GAS v2u* o8 = (GAS v2u*)(W_XN + (size_t)row * D) + F.lane;
#pragma unroll
        for (int j = 0; j < 8; ++j) { const int c = 4 * (F.lane + 64 * j);
            const f32x4 wv = *(const f32x4*)(nw + c), sc = *(const f32x4*)(scale + c), sh = *(const f32x4*)(shift + c);
            const f32x4 y = (v[j] * rstd) * wv * (sc + 1.0f) + sh;
            v2u w; w.x = pk2(y.x, y.y); w.y = pk2(y.z, y.w); o8[64 * j] = w; }
    }
}
__device__ __forceinline__ void p_final(Frame& F) {
    const int gw = F.vcu * NWAVES + F.wave, NGW = F.G * NWAVES; const float* fnw = IP_FNW;
    for (int row = gw; row < NLAT; row += NGW) {
        GAS f32x4* xr = (GAS f32x4*)(F.out + (size_t)row * D) + F.lane;
        f32x4 v[8]; float s = 0.f;
#pragma unroll
        for (int j = 0; j < 8; ++j) { v[j] = xr[64 * j]; s += (v[j].x * v[j].x + v[j].y * v[j].y) + (v[j].z * v[j].z + v[j].w * v[j].w); }
        const float rstd = 1.0f / sqrtf(wave_sum(s) * (1.f / D) + EPS);
#pragma unroll
        for (int j = 0; j < 8; ++j) { const int c = 4 * (F.lane + 64 * j); const f32x4 wv = *(const f32x4*)(fnw + c); xr[64 * j] = (v[j] * rstd) * wv; }
    }
}

__device__ __forceinline__ void p_rope(Frame& F) {
    const int gw = F.vcu * NWAVES + F.wave, NGW = F.G * NWAVES;
    for (int row = gw; row < NLAT; row += NGW) {
        const int t = row & (SEQ - 1), prow = t >> 6, pcol = t & 63;
        bf16* base = W_PROJ + (size_t)row * WIN + C_AQ;
#pragma unroll
        for (int s = 0; s < 2; ++s) {
            const int item = F.lane + 64 * s, grp = item >> 1, half = item & 1;
            bf16* pa = base + grp * 32 + 8 * half; bf16* pb = pa + 16;
            const v4u xa = *(const v4u*)pa, xb = *(const v4u*)pb;
            const float pos = (float)((grp & 1) ? pcol : prow);
            float a[8], b[8];
            a[0] = bflo(xa.x); a[1] = bfhi(xa.x); a[2] = bflo(xa.y); a[3] = bfhi(xa.y); a[4] = bflo(xa.z); a[5] = bfhi(xa.z); a[6] = bflo(xa.w); a[7] = bfhi(xa.w);
            b[0] = bflo(xb.x); b[1] = bfhi(xb.x); b[2] = bflo(xb.y); b[3] = bfhi(xb.y); b[4] = bflo(xb.z); b[5] = bfhi(xb.z); b[6] = bflo(xb.w); b[7] = bfhi(xb.w);
            float oa[8], ob[8];
#pragma unroll
            for (int e = 0; e < 8; ++e) { const int d = 8 * half + e;
                const float invf = exp2f(-(float)d * (13.287712379549449f / 16.0f));
                const float rev = pos * invf * 0.15915494309189535f;
                const float fr = rev - floorf(rev);
                const float sn = __builtin_amdgcn_sinf(fr), cs = __builtin_amdgcn_cosf(fr);
                oa[e] = a[e] * cs - b[e] * sn; ob[e] = b[e] * cs + a[e] * sn; }
            v4u wa, wb;
            wa.x = pk2(oa[0], oa[1]); wa.y = pk2(oa[2], oa[3]); wa.z = pk2(oa[4], oa[5]); wa.w = pk2(oa[6], oa[7]);
            wb.x = pk2(ob[0], ob[1]); wb.y = pk2(ob[2], ob[3]); wb.z = pk2(ob[4], ob[5]); wb.w = pk2(ob[6], ob[7]);
            *(v4u*)pa = wa; *(v4u*)pb = wb;
        }
    }
}

__device__ __forceinline__ void hg_gate(float z, float lb, float& logf, float& kv) {
    const float e = __expf(-fabsf(z)), r = __builtin_amdgcn_rcpf(1.0f + e);
    const float sig = z >= 0.f ? r : e * r, nsig = z >= 0.f ? e * r : r;
    kv = (1.0f - lb) * nsig;
    logf = lb > 0.f ? __logf(lb + (1.0f - lb) * sig) : (fminf(z, 0.f) - __logf(1.0f + e));
}
__device__ __forceinline__ int chunk_row(int b, int c) { return c < 4 ? NLAT + CTXL * b + 64 * c : SEQ * b + 64 * (c - 4); }
__device__ __forceinline__ void unpack16(const v4u a, const v4u b, float* o) {
    o[0] = bflo(a.x); o[1] = bfhi(a.x); o[2] = bflo(a.y); o[3] = bfhi(a.y); o[4] = bflo(a.z); o[5] = bfhi(a.z); o[6] = bflo(a.w); o[7] = bfhi(a.w);
    o[8] = bflo(b.x); o[9] = bfhi(b.x); o[10] = bflo(b.y); o[11] = bfhi(b.y); o[12] = bflo(b.z); o[13] = bfhi(b.z); o[14] = bflo(b.w); o[15] = bfhi(b.w);
}
__device__ __forceinline__ void scan16(float* cum, int lane) {
#pragma unroll
    for (int off = 1; off < 64; off <<= 1) {
#pragma unroll
        for (int e = 0; e < 16; ++e) { const float t = __shfl_up(cum[e], off); if (lane >= off) cum[e] += t; }
    }
}
__device__ __forceinline__ bf16x8 ldfrag(const LAS unsigned char* base, int row, int stride, int kbyte) { return *(const LAS bf16x8*)(base + row * stride + kbyte); }

constexpr int H_KT = 0, H_VT = 18432, H_ESC = 36864;
__device__ __forceinline__ void p_h1(Frame& F, int layer) {
    LAS unsigned char* L = F.lds + RING_OFF;
    LAS bf16* KT = (LAS bf16*)(L + H_KT); LAS bf16* VT = (LAS bf16*)(L + H_VT); LAS float* esc = (LAS float*)(L + H_ESC);
    const int lane = F.lane, w = F.wave, fr = lane & 15, fq = lane >> 4; const float* hlb = IP_HLB;
    for (int u = F.bx; u < NSEQ * NCHUNK; u += F.G) {
        const int s = u / NCHUNK, c = u - s * NCHUNK, b = s >> 4, dir = (s >> 3) & 1, h = s & 7;
        const int tok = dir ? 63 - lane : lane;
        const bf16* rowp = W_PROJ + (size_t)(chunk_row(b, c) + tok) * WIN;
        const int ch0 = 128 * h + 16 * w;
        const v4u z0 = *(const v4u*)(rowp + (dir ? C_HB : C_HF) + ch0), z1 = *(const v4u*)(rowp + (dir ? C_HB : C_HF) + ch0 + 8);
        const v4u v0 = *(const v4u*)(rowp + C_HI + ch0), v1 = *(const v4u*)(rowp + C_HI + ch0 + 8);
        float z[16], cum[16], kv[16]; unpack16(z0, z1, z);
#pragma unroll
        for (int e = 0; e < 16; ++e) { float lb = 0.f;
            if (layer) { const float r0 = hlb[(dir * 2 + 0) * 1024 + ch0 + e], r1 = hlb[(dir * 2 + 1) * 1024 + ch0 + e]; lb = sigm_f(r1 - r0); }
            hg_gate(z[e], lb, cum[e], kv[e]); }
        scan16(cum, lane);
        unsigned short vb[16];
        { const unsigned ww[8] = {v0.x, v0.y, v0.z, v0.w, v1.x, v1.y, v1.z, v1.w};
#pragma unroll
          for (int e = 0; e < 8; ++e) { vb[2 * e] = (unsigned short)(ww[e] & 0xffffu); vb[2 * e + 1] = (unsigned short)(ww[e] >> 16); } }
#pragma unroll
        for (int e = 0; e < 16; ++e) { const float cmid = __shfl(cum[e], 31), cend = __shfl(cum[e], 63);
            const float ks = kv[e] * __expf(fminf(cmid - cum[e], 80.f));
            KT[(16 * w + e) * 72 + tok] = (bf16)f2bf(ks); VT[(16 * w + e) * 72 + tok] = vb[e];
            if (lane == 0) { esc[16 * w + e] = __expf(cend - cmid); W_DEC[(size_t)u * 128 + 16 * w + e] = __expf(cend); } }
        __syncthreads();
        f32x4 acc[8];
#pragma unroll
        for (int nb = 0; nb < 8; ++nb) acc[nb] = (f32x4){0.f, 0.f, 0.f, 0.f};
#pragma unroll
        for (int ks = 0; ks < 2; ++ks) { const bf16x8 a = ldfrag((const LAS unsigned char*)KT, 16 * w + fr, 144, (32 * ks + 8 * fq) * 2);
#pragma unroll
            for (int nb = 0; nb < 8; ++nb) { const bf16x8 bb = ldfrag((const LAS unsigned char*)VT, 16 * nb + fr, 144, (32 * ks + 8 * fq) * 2);
                acc[nb] = __builtin_amdgcn_mfma_f32_16x16x32_bf16(a, bb, acc[nb], 0, 0, 0); } }
        const f32x4 e4 = *(const LAS f32x4*)(esc + 16 * w + 4 * fq);
        bf16* dst = W_ST + (size_t)u * 16384 + 16 * w + 4 * fq;
#pragma unroll
        for (int nb = 0; nb < 8; ++nb) { const f32x4 val = acc[nb] * e4; v2u o; o.x = pk2(val[0], val[1]); o.y = pk2(val[2], val[3]); *(v2u*)(dst + (size_t)(16 * nb + fr) * 128) = o; }
        __syncthreads();
    }
}

__device__ __forceinline__ void p_h2(Frame& F) {
    for (int unit = F.bx; unit < NSEQ * 8; unit += F.G) {
        const int s = unit >> 3, slice = unit & 7, dir = (s >> 3) & 1;
        const int e0 = slice * 2048 + 4 * F.tid, dk0 = e0 & 127;
        float S[4] = {0.f, 0.f, 0.f, 0.f};
        for (int st = 0; st < NCHUNK; st += 4) {
            v2u uu[4]; f32x4 dd[4]; bf16* pp[4];
#pragma unroll
            for (int i = 0; i < 4; ++i) { const int step = st + i; const int c = dir == 0 ? step : (step < 4 ? 3 - step : 135 - step); const size_t u = (size_t)s * NCHUNK + c;
                pp[i] = W_ST + u * 16384 + e0; uu[i] = *(const v2u*)pp[i]; dd[i] = *(const f32x4*)(W_DEC + u * 128 + dk0); }
#pragma unroll
            for (int i = 0; i < 4; ++i) { v2u o; o.x = pk2(S[0], S[1]); o.y = pk2(S[2], S[3]); *(v2u*)pp[i] = o;
                S[0] = dd[i][0] * S[0] + bflo(uu[i].x); S[1] = dd[i][1] * S[1] + bfhi(uu[i].x); S[2] = dd[i][2] * S[2] + bflo(uu[i].y); S[3] = dd[i][3] * S[3] + bfhi(uu[i].y); }
        }
    }
}

constexpr int H3_Q = 0, H3_K = 17408, H3_VT = 34816, H3_P = 53248, H3_S = 62464, H3_EM = 97280, H3_SS = 97792;
__device__ __forceinline__ void p_h3(Frame& F, int layer) {
    LAS unsigned char* L = F.lds + RING_OFF;
    LAS bf16* Qs = (LAS bf16*)(L + H3_Q); LAS bf16* Ks = (LAS bf16*)(L + H3_K); LAS bf16* VT = (LAS bf16*)(L + H3_VT); LAS bf16* Ps = (LAS bf16*)(L + H3_P); LAS bf16* Ss = (LAS bf16*)(L + H3_S);
    LAS float* emid = (LAS float*)(L + H3_EM); LAS float* ssq = (LAS float*)(L + H3_SS);
    const int lane = F.lane, w = F.wave, fr = lane & 15, fq = lane >> 4;
    const float* hlb = IP_HLB; const float* hnw = IP_HNW;
    const int c_lo = layer ? 4 : 0, ncpb = NCHUNK - c_lo;
    for (int u = F.bx; u < 16 * ncpb; u += F.G) {
        const int bh = u / ncpb, c = c_lo + (u - bh * ncpb), b = bh >> 3, h = bh & 7;
        const int rb = chunk_row(b, c), ch0 = 128 * h + 16 * w;
        f32x4 acc[4];
#pragma unroll
        for (int tb = 0; tb < 4; ++tb) acc[tb] = (f32x4){0.f, 0.f, 0.f, 0.f};
#pragma unroll 1
        for (int dir = 0; dir < 2; ++dir) {
            const int tok = dir ? 63 - lane : lane;
            const bf16* rowp = W_PROJ + (size_t)(rb + tok) * WIN;
            const v4u z0 = *(const v4u*)(rowp + (dir ? C_HB : C_HF) + ch0), z1 = *(const v4u*)(rowp + (dir ? C_HB : C_HF) + ch0 + 8);
            const v4u q0 = *(const v4u*)(rowp + C_HQ + ch0), q1 = *(const v4u*)(rowp + C_HQ + ch0 + 8);
            float z[16], q[16], cum[16], kv[16]; unpack16(z0, z1, z); unpack16(q0, q1, q);
#pragma unroll
            for (int e = 0; e < 16; ++e) { float lb = 0.f;
                if (layer) { const float r0 = hlb[(dir * 2 + 0) * 1024 + ch0 + e], r1 = hlb[(dir * 2 + 1) * 1024 + ch0 + e]; lb = sigm_f(r1 - r0); }
                hg_gate(z[e], lb, cum[e], kv[e]); }
            scan16(cum, lane);
            float qs[16], ks[16];
#pragma unroll
            for (int e = 0; e < 16; ++e) { const float cmid = __shfl(cum[e], 31);
                qs[e] = q[e] * __expf(fminf(cum[e] - cmid, 80.f)); ks[e] = kv[e] * __expf(fminf(cmid - cum[e], 80.f));
                if (lane == 0) emid[16 * w + e] = __expf(cmid); }
            { v4u o; o.x = pk2(qs[0], qs[1]); o.y = pk2(qs[2], qs[3]); o.z = pk2(qs[4], qs[5]); o.w = pk2(qs[6], qs[7]); *(LAS v4u*)(Qs + tok * 136 + 16 * w) = o;
              o.x = pk2(qs[8], qs[9]); o.y = pk2(qs[10], qs[11]); o.z = pk2(qs[12], qs[13]); o.w = pk2(qs[14], qs[15]); *(LAS v4u*)(Qs + tok * 136 + 16 * w + 8) = o;
              o.x = pk2(ks[0], ks[1]); o.y = pk2(ks[2], ks[3]); o.z = pk2(ks[4], ks[5]); o.w = pk2(ks[6], ks[7]); *(LAS v4u*)(Ks + tok * 136 + 16 * w) = o;
              o.x = pk2(ks[8], ks[9]); o.y = pk2(ks[10], ks[11]); o.z = pk2(ks[12], ks[13]); o.w = pk2(ks[14], ks[15]); *(LAS v4u*)(Ks + tok * 136 + 16 * w + 8) = o; }
            if (dir == 0) {
                const v4u v0 = *(const v4u*)(rowp + C_HI + ch0), v1 = *(const v4u*)(rowp + C_HI + ch0 + 8);
                const unsigned ww[8] = {v0.x, v0.y, v0.z, v0.w, v1.x, v1.y, v1.z, v1.w};
#pragma unroll
                for (int e = 0; e < 8; ++e) { VT[(16 * w + 2 * e) * 72 + tok] = (bf16)(ww[e] & 0xffffu); VT[(16 * w + 2 * e + 1) * 72 + tok] = (bf16)(ww[e] >> 16); }
            }
            __syncthreads();
            { const size_t us = ((size_t)((b * 2 + dir) * 8 + h)) * NCHUNK + c; const bf16* sp = W_ST + us * 16384;
#pragma unroll
              for (int j = 0; j < 4; ++j) { const int qd = F.tid + 512 * j, dv = qd >> 4, dk0 = (qd & 15) * 8;
                  const v4u sv = *(const v4u*)(sp + dv * 128 + dk0); const f32x4 ea = *(const LAS f32x4*)(emid + dk0), eb = *(const LAS f32x4*)(emid + dk0 + 4);
                  v4u o; o.x = pk2(bflo(sv.x) * ea[0], bfhi(sv.x) * ea[1]); o.y = pk2(bflo(sv.y) * ea[2], bfhi(sv.y) * ea[3]); o.z = pk2(bflo(sv.z) * eb[0], bfhi(sv.z) * eb[1]); o.w = pk2(bflo(sv.w) * eb[2], bfhi(sv.w) * eb[3]);
                  *(LAS v4u*)(Ss + dv * 136 + dk0) = o; } }
#pragma unroll
            for (int bi = 0; bi < 2; ++bi) { const int blk = 2 * w + bi, I = blk >> 2, J = blk & 3;
                f32x4 pacc = (f32x4){0.f, 0.f, 0.f, 0.f};
                const bool need = dir == 0 ? (J <= I) : (J >= I);
                if (need) {
#pragma unroll
                    for (int ks4 = 0; ks4 < 4; ++ks4) { const bf16x8 a = ldfrag((const LAS unsigned char*)Ks, 16 * J + fr, 272, (32 * ks4 + 8 * fq) * 2), bb = ldfrag((const LAS unsigned char*)Qs, 16 * I + fr, 272, (32 * ks4 + 8 * fq) * 2);
                        pacc = __builtin_amdgcn_mfma_f32_16x16x32_bf16(a, bb, pacc, 0, 0, 0); }
                    if (I == J) {
#pragma unroll
                        for (int r = 0; r < 4; ++r) { const int jj = 4 * fq + r; const bool keep = dir == 0 ? (jj <= fr) : (jj >= fr); if (!keep) pacc[r] = 0.f; } }
                }
                v2u o; o.x = pk2(pacc[0], pacc[1]); o.y = pk2(pacc[2], pacc[3]);
                *(LAS v2u*)(Ps + (16 * I + fr) * 72 + 16 * J + 4 * fq) = o; }
            __syncthreads();
#pragma unroll
            for (int ks2 = 0; ks2 < 2; ++ks2) { const bf16x8 a = ldfrag((const LAS unsigned char*)VT, 16 * w + fr, 144, (32 * ks2 + 8 * fq) * 2);
#pragma unroll
                for (int tb = 0; tb < 4; ++tb) { const bf16x8 bb = ldfrag((const LAS unsigned char*)Ps, 16 * tb + fr, 144, (32 * ks2 + 8 * fq) * 2);
                    acc[tb] = __builtin_amdgcn_mfma_f32_16x16x32_bf16(a, bb, acc[tb], 0, 0, 0); } }
#pragma unroll
            for (int ks4 = 0; ks4 < 4; ++ks4) { const bf16x8 a = ldfrag((const LAS unsigned char*)Ss, 16 * w + fr, 272, (32 * ks4 + 8 * fq) * 2);
#pragma unroll
                for (int tb = 0; tb < 4; ++tb) { const bf16x8 bb = ldfrag((const LAS unsigned char*)Qs, 16 * tb + fr, 272, (32 * ks4 + 8 * fq) * 2);
                    acc[tb] = __builtin_amdgcn_mfma_f32_16x16x32_bf16(a, bb, acc[tb], 0, 0, 0); } }
            __syncthreads();
        }
#pragma unroll
        for (int tb = 0; tb < 4; ++tb) { float p = (acc[tb][0] * acc[tb][0] + acc[tb][1] * acc[tb][1]) + (acc[tb][2] * acc[tb][2] + acc[tb][3] * acc[tb][3]);
            p += __shfl_xor(p, 16); p += __shfl_xor(p, 32);
            if (fq == 0) ssq[w * 64 + 16 * tb + fr] = p; }
        __syncthreads();
        const f32x4 nwv = *(const f32x4*)(hnw + layer * 128 + 16 * w + 4 * fq);
#pragma unroll
        for (int tb = 0; tb < 4; ++tb) { const int tk = 16 * tb + fr; float tot = 0.f;
#pragma unroll
            for (int ww = 0; ww < 8; ++ww) tot += ssq[ww * 64 + tk];
            const float rstd = 1.0f / sqrtf(tot * (1.f / 128.f) + EPS);
            const size_t row = (size_t)(rb + tk);
            const v2u gv = *(const v2u*)(W_PROJ + row * WIN + C_HG + ch0 + 4 * fq);
            const float y0 = acc[tb][0] * rstd * nwv[0] * silu_f(bflo(gv.x)), y1 = acc[tb][1] * rstd * nwv[1] * silu_f(bfhi(gv.x));
            const float y2 = acc[tb][2] * rstd * nwv[2] * silu_f(bflo(gv.y)), y3 = acc[tb][3] * rstd * nwv[3] * silu_f(bfhi(gv.y));
            v2u o; o.x = pk2(y0, y1); o.y = pk2(y2, y3);
            *(v2u*)(W_BR + row * MIXW + ch0 + 4 * fq) = o; }
        __syncthreads();
    }
}

__device__ __forceinline__ void p_pm(Frame& F, int layer, int nrows) {
    const int gw = F.vcu * NWAVES + F.wave, NGW = F.G * NWAVES, lane = F.lane;
    const float lam_init = 0.8f - 0.6f * expf(-0.3f * (float)layer);
    float lam;
    { const float* lp = IP_LAM + layer * 256; const float s1 = wave_sum(lp[lane] * lp[64 + lane]), s2 = wave_sum(lp[128 + lane] * lp[192 + lane]); lam = expf(s1) - expf(s2) + lam_init; }
    const float* cw = IP_CONVW + (size_t)layer * 3 * MIXW; const float* danw = IP_DANW;
    bf16* B1 = W_BR + (size_t)MTOT * MIXW; bf16* B2 = W_BR + (size_t)2 * MTOT * MIXW;
    const bf16* O0 = W_OP; const bf16* O1 = W_OP + (size_t)MTOT * MIXW;
    for (int row = gw; row < nrows; row += NGW) {
        int pos, len; if (row < NLAT) { pos = row & (SEQ - 1); len = SEQ; } else { pos = (row - NLAT) & (CTXL - 1); len = CTXL; }
        const bool hasp = pos > 0, hasn = pos < len - 1;
        const bf16* pr = W_PROJ + (size_t)row * WIN;
#pragma unroll
        for (int s = 0; s < 2; ++s) {
            const int c0 = 512 * s + 8 * lane;
            float cbv[8], pm[8], pc[8], pn[8];
            { const v4u a = *(const v4u*)(pr + C_CB + c0); cbv[0] = bflo(a.x); cbv[1] = bfhi(a.x); cbv[2] = bflo(a.y); cbv[3] = bfhi(a.y); cbv[4] = bflo(a.z); cbv[5] = bfhi(a.z); cbv[6] = bflo(a.w); cbv[7] = bfhi(a.w); }
#define LDPROD(dst, rp) do { const v4u a_ = *(const v4u*)((rp) + C_CC + c0), b_ = *(const v4u*)((rp) + C_CU + c0); \
            dst[0] = bflo(a_.x) * bflo(b_.x); dst[1] = bfhi(a_.x) * bfhi(b_.x); dst[2] = bflo(a_.y) * bflo(b_.y); dst[3] = bfhi(a_.y) * bfhi(b_.y); \
            dst[4] = bflo(a_.z) * bflo(b_.z); dst[5] = bfhi(a_.z) * bfhi(b_.z); dst[6] = bflo(a_.w) * bflo(b_.w); dst[7] = bfhi(a_.w) * bfhi(b_.w); } while (0)
            LDPROD(pc, pr);
            if (hasp) { LDPROD(pm, pr - WIN); } else {
#pragma unroll
                for (int e = 0; e < 8; ++e) pm[e] = 0.f; }
            if (hasn) { LDPROD(pn, pr + WIN); } else {
#pragma unroll
                for (int e = 0; e < 8; ++e) pn[e] = 0.f; }
#undef LDPROD
            float yb[8];
#pragma unroll
            for (int e = 0; e < 8; ++e) yb[e] = cbv[e] * (cw[c0 + e] * pm[e] + cw[MIXW + c0 + e] * pc[e] + cw[2 * MIXW + c0 + e] * pn[e]);
            { v4u o; o.x = pk2(yb[0], yb[1]); o.y = pk2(yb[2], yb[3]); o.z = pk2(yb[4], yb[5]); o.w = pk2(yb[6], yb[7]); *(v4u*)(B1 + (size_t)row * MIXW + c0) = o; }
            float dd[8];
            { const v4u a = *(const v4u*)(O0 + (size_t)row * MIXW + c0), b2 = *(const v4u*)(O1 + (size_t)row * MIXW + c0);
              dd[0] = bflo(a.x) - lam * bflo(b2.x); dd[1] = bfhi(a.x) - lam * bfhi(b2.x); dd[2] = bflo(a.y) - lam * bflo(b2.y); dd[3] = bfhi(a.y) - lam * bfhi(b2.y);
              dd[4] = bflo(a.z) - lam * bflo(b2.z); dd[5] = bfhi(a.z) - lam * bfhi(b2.z); dd[6] = bflo(a.w) - lam * bflo(b2.w); dd[7] = bfhi(a.w) - lam * bfhi(b2.w); }
            float ss = 0.f;
#pragma unroll
            for (int e = 0; e < 8; ++e) ss += dd[e] * dd[e];
            ss += __shfl_xor(ss, 1); ss += __shfl_xor(ss, 2); ss += __shfl_xor(ss, 4); ss += __shfl_xor(ss, 8);
            const float rstd = 1.0f / sqrtf(ss * (1.f / 128.f) + EPS) * (1.0f - lam_init);
            const float* dn = danw + layer * 128 + ((8 * lane) & 127);
            float yc[8];
#pragma unroll
            for (int e = 0; e < 8; ++e) yc[e] = dd[e] * rstd * dn[e];
            { v4u o; o.x = pk2(yc[0], yc[1]); o.y = pk2(yc[2], yc[3]); o.z = pk2(yc[4], yc[5]); o.w = pk2(yc[6], yc[7]); *(v4u*)(B2 + (size_t)row * MIXW + c0) = o; }
        }
    }
}

__device__ __forceinline__ void p_attn(Frame& F, int layer, char* ldsg) {
    const int nunits = 1024 + (layer == 0 ? 32 : 0);
    for (int id = F.vcu; id < nunits; id += F.G) {
        if (id < 1024) { const int qb = id & 31, p = (id >> 5) & 1, h = (id >> 6) & 7, b = id >> 9;
            att::attn_unit(W_PROJ, SEQ * b + 256 * qb, NLAT + CTXL * b, SEQ * b, NCHUNK, h, p, W_OP + (size_t)p * MTOT * MIXW, ldsg); }
        else { const int j = id - 1024, p = j & 1, h = (j >> 1) & 7, b = j >> 4;
            att::attn_unit(W_PROJ, NLAT + CTXL * b, NLAT + CTXL * b, SEQ * b, 4, h, p, W_OP + (size_t)p * MTOT * MIXW, ldsg); }
    }
}

struct Args { const float* in[18]; float* out; unsigned char* ws; int ph_lo, ph_hi, li, pad; };
__global__ void __launch_bounds__(NWAVES * 64, 2) mk_fwd(Args args) {
    extern __shared__ __attribute__((aligned(16))) unsigned char lds[];
    Frame F;
    F.lds = (LAS unsigned char*)lds;
    F.MISC = (volatile LAS unsigned*)(F.lds + MISC_OFF);
    F.tid = threadIdx.x; F.lane = F.tid & 63; F.wave = __builtin_amdgcn_readfirstlane(F.tid >> 6);
    F.G = gridDim.x; F.bx = blockIdx.x; { const int bx = blockIdx.x; F.vcu = (F.G % 8 == 0) ? (bx % 8) * (F.G / 8) + bx / 8 : bx; }
    F.ws = args.ws; F.out = args.out;
    F.ctl = (gu32*)(F.ws + WS_CTL);
    for (int u = F.tid; u < (LDS_BYTES - LDSCTL_OFF) / 4; u += NWAVES * 64) ((LAS unsigned*)(F.lds + LDSCTL_OFF))[u] = 0u;
    __syncthreads();
    XcdBarrier bar; bar.bar = (unsigned*)(F.ctl + CW_BAR) + args.li * XCD_BAR_WORDS; bar.x = 0; bar.st = nullptr;
    if (MK_N_LAUNCHES == 1) bar = xcd_barrier_post((unsigned*)(F.ctl + CW_BAR), F.MISC + 8);
    const int lo = args.ph_lo, hi = args.ph_hi;
#ifndef PHMASK
#define PHMASK 0x7fff
#endif
#define PON(b) (((PHMASK) >> (b)) & 1)
#define IN(k) (lo <= (k) && (k) < hi)
#define PHASE(cond) if (cond) { Frame P_ = F; launder(P_); { Frame& F = P_; (void)F;
#define PHASE_END } }
#define SEAM(k) do { if (IN(k) && IN((k) + 1)) xcd_barrier(bar); } while (0)

    PHASE(PON(13) && IN(0)) p_ada(F); p_convert(F, 0); PHASE_END
    SEAM(0);

#pragma unroll 1
    for (int l = 0; l < 2; ++l) {
        const int pb = 1 + l * NPL;
        const float* modl = W_MOD + (size_t)l * 3 * MODW;
        const int Mm = (l == 1) ? NLAT : MTOT;
        const float* hl = (l == 0) ? IP_X : (const float*)F.out; const float* hc = (l == 0) ? IP_CTX : (const float*)W_HCTX;
        PHASE(PON(0) && IN(pb + 0)) if (l == 1) p_convert(F, 1); p_norm(F, hl, hc, IP_NORMW + (size_t)(l * 3 + 0) * D, modl, 0, MTOT);  PHASE_END
        SEAM(pb + 0);
        PHASE(PON(1) && IN(pb + 1)) pg8::Gemm g{W_XN, W_W13T, MTOT, 2 * FF, D}; pg8::StaticOrder S; S.init(MTOT, 2 * FF, F.G, F.bx);
            pg8::EpiSwiglu E{W_HID, FF}; pg8::gemm_phase<pg8::EpiSwiglu, pg8::StaticOrder, true, true>(F.lds + RING_OFF, g, S, E);  PHASE_END
        SEAM(pb + 1);
        PHASE(PON(2) && IN(pb + 2)) pg8::Gemm g{W_HID, W_W2T, MTOT, D, FF}; pg8::StaticOrder S; S.init(MTOT, D, F.G, F.bx);
            pg8::EpiResid E{hl, hc, F.out, W_HCTX, modl + 2 * D, 0.5f}; pg8::gemm_phase<pg8::EpiResid, pg8::StaticOrder, true, true>(F.lds + RING_OFF, g, S, E);  PHASE_END
        SEAM(pb + 2);
        PHASE(PON(3) && IN(pb + 3)) p_norm(F, F.out, W_HCTX, IP_NORMW + (size_t)(l * 3 + 1) * D, modl, 1, MTOT); PHASE_END
        SEAM(pb + 3);
        PHASE(PON(4) && IN(pb + 4)) pg8::Gemm g{W_XN, W_WINT, MTOT, WIN, D}; pg8::StaticOrder S; S.init(MTOT, WIN, F.G, F.bx);
            pg8::EpiStoreBf16 E{W_PROJ, WIN}; pg8::gemm_phase<pg8::EpiStoreBf16, pg8::StaticOrder, true, true>(F.lds + RING_OFF, g, S, E);  PHASE_END
        SEAM(pb + 4);
        PHASE(PON(5) && IN(pb + 5)) p_rope(F); p_h1(F, l);  PHASE_END
        SEAM(pb + 5);
        PHASE(PON(6) && IN(pb + 6)) p_h2(F); p_attn(F, l, (char*)lds + RING_OFF);  PHASE_END
        SEAM(pb + 6);
        PHASE(PON(7) && IN(pb + 7)) p_h3(F, l); p_pm(F, l, Mm);  PHASE_END
        SEAM(pb + 7);
        PHASE(PON(8) && IN(pb + 8))
            { pg8::Gemm g{W_BR, W_WBT, Mm, D, MIXW}; pg8::StaticOrder S; S.init(Mm, D, F.G, F.bx);
              pg8::EpiMerge<0> E{W_PROJ + C_GA, WIN, W_Y32, W_XN}; pg8::gemm_phase<pg8::EpiMerge<0>, pg8::StaticOrder, true, true>(F.lds + RING_OFF, g, S, E); }
            { pg8::Gemm g{W_BR + (size_t)MTOT * MIXW, W_WBT + (size_t)D * MIXW, Mm, D, MIXW}; pg8::StaticOrder S; S.init(Mm, D, F.G, F.bx);
              pg8::EpiMerge<1> E{W_PROJ + C_GB, WIN, W_Y32, W_XN}; pg8::gemm_phase<pg8::EpiMerge<1>, pg8::StaticOrder, true, true>(F.lds + RING_OFF, g, S, E); }
            { pg8::Gemm g{W_BR + (size_t)2 * MTOT * MIXW, W_WBT + (size_t)2 * D * MIXW, Mm, D, MIXW}; pg8::StaticOrder S; S.init(Mm, D, F.G, F.bx);
              pg8::EpiMerge<2> E{W_PROJ + C_GC, WIN, W_Y32, W_XN}; pg8::gemm_phase<pg8::EpiMerge<2>, pg8::StaticOrder, true, true>(F.lds + RING_OFF, g, S, E); }
         PHASE_END
        SEAM(pb + 8);
        PHASE(PON(9) && IN(pb + 9)) pg8::Gemm g{W_XN, W_WOT, Mm, D, D}; pg8::StaticOrder S; S.init(Mm, D, F.G, F.bx);
            pg8::EpiResid E{F.out, W_HCTX, F.out, W_HCTX, modl + 5 * D, 1.0f}; pg8::gemm_phase<pg8::EpiResid, pg8::StaticOrder, true, true>(F.lds + RING_OFF, g, S, E);  PHASE_END
        SEAM(pb + 9);
        PHASE(PON(10) && IN(pb + 10)) p_norm(F, F.out, W_HCTX, IP_NORMW + (size_t)(l * 3 + 2) * D, modl, 2, Mm); PHASE_END
        SEAM(pb + 10);
        PHASE(PON(11) && IN(pb + 11)) pg8::Gemm g{W_XN, W_W13T + (size_t)2 * FF * D, Mm, 2 * FF, D}; pg8::StaticOrder S; S.init(Mm, 2 * FF, F.G, F.bx);
            pg8::EpiSwiglu E{W_HID, FF}; pg8::gemm_phase<pg8::EpiSwiglu, pg8::StaticOrder, true, true>(F.lds + RING_OFF, g, S, E);  PHASE_END
        SEAM(pb + 11);
        PHASE(PON(12) && IN(pb + 12)) pg8::Gemm g{W_HID, W_W2T + (size_t)D * FF, Mm, D, FF}; pg8::StaticOrder S; S.init(Mm, D, F.G, F.bx);
            pg8::EpiResid E{F.out, W_HCTX, F.out, W_HCTX, modl + 8 * D, 0.5f}; pg8::gemm_phase<pg8::EpiResid, pg8::StaticOrder, true, true>(F.lds + RING_OFF, g, S, E);  PHASE_END
        SEAM(pb + 12);
    }
    PHASE(PON(14) && IN(NPHASE - 1)) p_final(F); PHASE_END
#undef IN
#undef SEAM
}

extern "C" void kernel_launch(void* const* d_in, const int* in_sizes, int n_in, void* d_out, int out_size, void* d_ws, size_t ws_size, hipStream_t stream) {
    static int grid = 0;
    if (grid == 0) {
        if (n_in != 18 || in_sizes[0] != NLAT * D || out_size != NLAT * D || ws_size < WS_END) { fprintf(stderr, "kernel_launch: shape/workspace mismatch (n_in %d, in0 %d, out %d, ws %zu, need %zu)\n", n_in, n_in > 0 ? in_sizes[0] : -1, out_size, ws_size, (size_t)WS_END); grid = -1; return; }
        int dev = 0, cus = 0, per_cu = 0;
        if (hipGetDevice(&dev) != hipSuccess || hipDeviceGetAttribute(&cus, hipDeviceAttributeMultiprocessorCount, dev) != hipSuccess) { grid = -1; return; }
        if (hipFuncSetAttribute((const void*)mk_fwd, hipFuncAttributeMaxDynamicSharedMemorySize, LDS_BYTES) != hipSuccess) { fprintf(stderr, "kernel_launch: hipFuncSetAttribute failed\n"); grid = -1; return; }
        if (hipOccupancyMaxActiveBlocksPerMultiprocessor(&per_cu, (const void*)mk_fwd, NWAVES * 64, LDS_BYTES) != hipSuccess || per_cu < 1) fprintf(stderr, "kernel_launch: occupancy query reports %d\n", per_cu);
        (void)hipGetLastError();
        grid = cus;
    }
    if (grid < 0) return;
    if (hipMemsetAsync((char*)d_ws + WS_CTL, 0, CTL_ZERO_BYTES, stream) != hipSuccess) return;
    Args a{};
    for (int i = 0; i < 18; ++i) a.in[i] = (const float*)d_in[i];
    a.out = (float*)d_out; a.ws = (unsigned char*)d_ws;
#if MK_N_LAUNCHES == 1
    a.ph_lo = 0; a.ph_hi = NPHASE; a.li = 0;
    hipLaunchKernelGGL(mk_fwd, dim3(grid), dim3(NWAVES * 64), LDS_BYTES, stream, a);
#else
    for (int ph = 0; ph < NPHASE; ++ph) { a.ph_lo = ph; a.ph_hi = ph + 1; a.li = 0; hipLaunchKernelGGL(mk_fwd, dim3(grid), dim3(NWAVES * 64), LDS_BYTES, stream, a); }
#endif
    const hipError_t le = hipPeekAtLastError();
    if (le != hipSuccess) fprintf(stderr, "kernel_launch: launch failed: %s\n", hipGetErrorName(le));
}
```

```cpp
#include <hip/hip_runtime.h>
#include <cstdio>
#include <cstdint>
#ifndef WGM_N8
#define WGM_N8 4
#endif
namespace pg8 {
#define PG8_LAS __attribute__((address_space(3)))
typedef unsigned short bf16_t;
typedef short bf16x8 __attribute__((ext_vector_type(8)));
typedef float f32x4 __attribute__((ext_vector_type(4)));
typedef unsigned u32x4 __attribute__((ext_vector_type(4)));
constexpr int BM = 256, BK = 64, HALF = 128, HTB = HALF * BK * 2  , STAGE_BYTES = 8 * HTB, NXCD = 8, WGM = 4;

__host__ __device__ __forceinline__ int lds_byte(int r, int c) { const int st = (r >> 4) * 2 + (c >> 5), rr = r & 15, cc = c & 31, ob = rr * 64 + cc * 2; return st * 1024 + (ob ^ (((ob >> 9) & 1) << 5)); }
__host__ __device__ __forceinline__ void stage_rc(int b, int& R, int& C) { const int st = b / 1024, sb = b % 1024, swz = sb ^ (((sb >> 9) & 1) << 5); R = (st >> 1) * 16 + swz / 64; C = (st & 1) * 32 + (swz % 64) / 2; }
__host__ __device__ __forceinline__ int perm32(int rho) { const int n = rho >> 4, i = rho & 15; return 8 * (i >> 2) + 4 * n + (i & 3); }

struct Unit { int pm, pn, pk; };
struct Gemm { const bf16_t* A; const bf16_t* Bt; int M, N, K; int ld; };

struct StaticOrder {
    int nM, nN, nwg, G, c, wgm;
    __host__ __device__ void init(int M, int N, int G_, int c_, int wgm_ = WGM) { nM = M / BM; nN = N / BM; nwg = nM * nN; G = G_; c = c_; wgm = wgm_; }
    __host__ __device__ bool next(int i, Unit& u) const {
        const long L = (long)i * G + c; if (L >= nwg) return false;
        int wgid = (int)L; { const int q = nwg / NXCD, r = nwg % NXCD, xcd = wgid % NXCD, off = wgid / NXCD; wgid = (xcd < r ? xcd * (q + 1) : r * (q + 1) + (xcd - r) * q) + off; }
        const int nig = wgm * nN, gid = wgid / nig, fm = gid * wgm, gsz = (nM - fm) < wgm ? (nM - fm) : wgm;
        u.pm = fm + ((wgid % nig) % gsz); u.pn = (wgid % nig) / gsz; u.pk = 0; return true;
    }
    __device__ __forceinline__ void a_ready(const Unit&) const {}
    __device__ __forceinline__ void done(const Unit&) const {}
};

typedef __bf16 cvbf2 __attribute__((ext_vector_type(2)));
typedef float cvf2 __attribute__((ext_vector_type(2)));
__device__ __forceinline__ unsigned cvt_pk_bf16(float lo, float hi) { const cvf2 v = {lo, hi}; return __builtin_bit_cast(unsigned, __builtin_convertvector(v, cvbf2)); }
__device__ __forceinline__ float silu_f(float x) { return x * __builtin_amdgcn_rcpf(1.0f + __builtin_amdgcn_exp2f(-1.4426950408889634f * x)); }
__device__ __forceinline__ float sigm_f(float x) { return __builtin_amdgcn_rcpf(1.0f + __builtin_amdgcn_exp2f(-1.4426950408889634f * x)); }
__device__ __forceinline__ float bfbits2f(unsigned short b) { return __uint_as_float(((unsigned)b) << 16); }
typedef unsigned u32x2 __attribute__((ext_vector_type(2)));
constexpr int MODW = 18432;
constexpr int NLAT = 16384;
constexpr int DM = 2048;

struct EpiStoreBf16 {
    static constexpr bool PERM = true, AFTER_DRAIN = false, CHAIN = false;
    bf16_t* O; int ldc; int rope_lo, rope_hi; float qscale; int gate_lo;
    __device__ __forceinline__ void operator()(const f32x4 (&acc)[2][2][4][2], const Unit& u, int wr, int wc, int fr, int fq) const {
        const int row0 = u.pm * BM + wr * 64 + fr; const int col0 = u.pn * BM + wc * 32 + 8 * fq;
        if (u.pn >= rope_lo && u.pn < rope_hi) {
            const bool isq = u.pn < (rope_lo + rope_hi) / 2, lat = u.pm < 64;
            const float osc = isq ? qscale : 1.0f, sgn = fq < 2 ? -1.0f : 1.0f;
            float invf[8];
#pragma unroll
            for (int e = 0; e < 8; ++e) invf[e] = exp2f(-(float)(8 * (fq & 1) + e) * (13.287712379549449f / 16.0f)) * 0.15915494309189535f;
#pragma unroll
            for (int ai = 0; ai < 2; ++ai)
#pragma unroll
                for (int m = 0; m < 4; ++m) { const int r = row0 + ai * HALF + m * 16; bf16_t* rowp = O + (size_t)r * ldc + col0;
                    const int t = r & 8191; const float pos = (float)((wc & 1) ? (t & 63) : (t >> 6));
                    float cs[8], sn[8];
#pragma unroll
                    for (int e = 0; e < 8; ++e) { const float rev = pos * invf[e], frc = rev - floorf(rev); cs[e] = lat ? __builtin_amdgcn_cosf(frc) * osc : osc; sn[e] = lat ? __builtin_amdgcn_sinf(frc) * osc * sgn : 0.f; }
#pragma unroll
                    for (int bj = 0; bj < 2; ++bj) { const f32x4 v0 = acc[ai][bj][m][0], v1 = acc[ai][bj][m][1];
                        float mine[8] = {v0[0], v0[1], v0[2], v0[3], v1[0], v1[1], v1[2], v1[3]}, outv[8];
#pragma unroll
                        for (int e = 0; e < 8; ++e) { const float other = __shfl_xor(mine[e], 32); outv[e] = mine[e] * cs[e] + other * sn[e]; }
                        u32x4 w; w.x = cvt_pk_bf16(outv[0], outv[1]); w.y = cvt_pk_bf16(outv[2], outv[3]); w.z = cvt_pk_bf16(outv[4], outv[5]); w.w = cvt_pk_bf16(outv[6], outv[7]);
                        *(u32x4*)(rowp + bj * HALF) = w; } }
            return;
        }
        const bool isg = u.pn >= gate_lo;
#pragma unroll
        for (int ai = 0; ai < 2; ++ai)
#pragma unroll
            for (int m = 0; m < 4; ++m) { bf16_t* rowp = O + (size_t)(row0 + ai * HALF + m * 16) * ldc + col0;
#pragma unroll
                for (int bj = 0; bj < 2; ++bj) { f32x4 v0 = acc[ai][bj][m][0], v1 = acc[ai][bj][m][1];
                    if (isg) {
#pragma unroll
                        for (int i = 0; i < 4; ++i) { v0[i] = sigm_f(v0[i]); v1[i] = sigm_f(v1[i]); } }
                    u32x4 w; w.x = cvt_pk_bf16(v0[0], v0[1]); w.y = cvt_pk_bf16(v0[2], v0[3]); w.z = cvt_pk_bf16(v1[0], v1[1]); w.w = cvt_pk_bf16(v1[2], v1[3]);
                    *(u32x4*)(rowp + bj * HALF) = w; } }
    }
};
struct EpiSwiglu {
    static constexpr bool PERM = true, AFTER_DRAIN = false, CHAIN = false;
    bf16_t* O; int ldc;
    __device__ __forceinline__ void operator()(const f32x4 (&acc)[2][2][4][2], const Unit& u, int wr, int wc, int fr, int fq) const {
        const int row0 = u.pm * BM + wr * 64 + fr; const int col0 = u.pn * HALF + wc * 32 + 8 * fq;
#pragma unroll
        for (int ai = 0; ai < 2; ++ai)
#pragma unroll
            for (int m = 0; m < 4; ++m) { bf16_t* rowp = O + (size_t)(row0 + ai * HALF + m * 16) * ldc + col0;
                const f32x4 g0 = acc[ai][0][m][0], g1 = acc[ai][0][m][1], u0 = acc[ai][1][m][0], u1 = acc[ai][1][m][1];
                float r[8];
#pragma unroll
                for (int i = 0; i < 4; ++i) { r[i] = silu_f(g0[i]) * u0[i]; r[4 + i] = silu_f(g1[i]) * u1[i]; }
                u32x4 w; w.x = cvt_pk_bf16(r[0], r[1]); w.y = cvt_pk_bf16(r[2], r[3]); w.z = cvt_pk_bf16(r[4], r[5]); w.w = cvt_pk_bf16(r[6], r[7]);
                *(u32x4*)rowp = w; }
    }
};
struct EpiResid {
    static constexpr bool PERM = true, AFTER_DRAIN = false, CHAIN = false;
    const float* base32; const bf16_t* base16; bf16_t* out; const float* coef; float mul, pad_;
    __device__ __forceinline__ void operator()(const f32x4 (&acc)[2][2][4][2], const Unit& u, int wr, int wc, int fr, int fq) const {
        const int g = u.pm < 32 ? 0 : 1;
        const int col0 = u.pn * BM + wc * 32 + 8 * fq;
        f32x4 cf[2][2];
#pragma unroll
        for (int bj = 0; bj < 2; ++bj)
#pragma unroll
            for (int n = 0; n < 2; ++n) cf[bj][n] = *(const f32x4*)(coef + (size_t)g * MODW + col0 + bj * HALF + 4 * n) * mul;
#pragma unroll
        for (int ai = 0; ai < 2; ++ai)
#pragma unroll
            for (int mp = 0; mp < 2; ++mp) {
                f32x4 pre[2][2][2];
                if (base32) {
#pragma unroll
                    for (int mm = 0; mm < 2; ++mm) { const int m = 2 * mp + mm; const size_t off = (size_t)(u.pm * BM + ai * HALF + wr * 64 + m * 16 + fr) * DM + col0;
#pragma unroll
                        for (int bj = 0; bj < 2; ++bj)
#pragma unroll
                            for (int n = 0; n < 2; ++n) pre[mm][bj][n] = *(const f32x4*)(base32 + off + bj * HALF + 4 * n); }
                } else {
                    u32x4 raw[2][2];
#pragma unroll
                    for (int mm = 0; mm < 2; ++mm) { const int m = 2 * mp + mm; const size_t off = (size_t)(u.pm * BM + ai * HALF + wr * 64 + m * 16 + fr) * DM + col0;
#pragma unroll
                        for (int bj = 0; bj < 2; ++bj) raw[mm][bj] = *(const u32x4*)(base16 + off + bj * HALF); }
#pragma unroll
                    for (int mm = 0; mm < 2; ++mm)
#pragma unroll
                        for (int bj = 0; bj < 2; ++bj) { const u32x4 w = raw[mm][bj];
                            pre[mm][bj][0] = (f32x4){__uint_as_float(w.x << 16), __uint_as_float(w.x & 0xffff0000u), __uint_as_float(w.y << 16), __uint_as_float(w.y & 0xffff0000u)};
                            pre[mm][bj][1] = (f32x4){__uint_as_float(w.z << 16), __uint_as_float(w.z & 0xffff0000u), __uint_as_float(w.w << 16), __uint_as_float(w.w & 0xffff0000u)}; }
                }
                asm volatile("" ::: "memory");
#pragma unroll
                for (int mm = 0; mm < 2; ++mm) { const int m = 2 * mp + mm; const size_t off = (size_t)(u.pm * BM + ai * HALF + wr * 64 + m * 16 + fr) * DM + col0;
#pragma unroll
                    for (int bj = 0; bj < 2; ++bj) { const f32x4 v0 = pre[mm][bj][0] + cf[bj][0] * acc[ai][bj][m][0], v1 = pre[mm][bj][1] + cf[bj][1] * acc[ai][bj][m][1];
                        u32x4 w; w.x = cvt_pk_bf16(v0[0], v0[1]); w.y = cvt_pk_bf16(v0[2], v0[3]); w.z = cvt_pk_bf16(v1[0], v1[1]); w.w = cvt_pk_bf16(v1[2], v1[3]);
                        *(u32x4*)(out + off + bj * HALF) = w; } }
                asm volatile("" ::: "memory");
            }
    }
};
struct EpiMergeChain {
    static constexpr bool PERM = true, AFTER_DRAIN = false, CHAIN = true;
    const bf16_t* gate; int ldg; bf16_t* ybf;
    __device__ __forceinline__ bool chain(f32x4 (&acc)[2][2][4][2], const Unit& u, int wr, int wc, int fr, int fq) const {
        const int br = u.pn >> 3, pn = u.pn & 7, pm = u.pm - 66 * br;
        const int row0 = pm * BM + wr * 64 + fr, col0 = pn * BM + wc * 32 + 8 * fq;
        const bf16_t* g0 = gate + (size_t)br * 2048 + col0;
#pragma unroll
        for (int ai = 0; ai < 2; ++ai)
#pragma unroll
            for (int m = 0; m < 4; ++m) { const size_t r = (size_t)(row0 + ai * HALF + m * 16);
#pragma unroll
                for (int bj = 0; bj < 2; ++bj) {
                    const u32x4 ga = *(const u32x4*)(g0 + r * ldg + bj * HALF);
                    float sa[8] = {__uint_as_float(ga.x << 16), __uint_as_float(ga.x & 0xffff0000u), __uint_as_float(ga.y << 16), __uint_as_float(ga.y & 0xffff0000u),
                                   __uint_as_float(ga.z << 16), __uint_as_float(ga.z & 0xffff0000u), __uint_as_float(ga.w << 16), __uint_as_float(ga.w & 0xffff0000u)};
                    if (br < 2) {
                        const u32x4 gb = *(const u32x4*)(g0 + 2048 + r * ldg + bj * HALF);
                        const float sb[8] = {__uint_as_float(gb.x << 16), __uint_as_float(gb.x & 0xffff0000u), __uint_as_float(gb.y << 16), __uint_as_float(gb.y & 0xffff0000u),
                                             __uint_as_float(gb.z << 16), __uint_as_float(gb.z & 0xffff0000u), __uint_as_float(gb.w << 16), __uint_as_float(gb.w & 0xffff0000u)};
#pragma unroll
                        for (int i = 0; i < 8; ++i) sa[i] *= __builtin_amdgcn_rcpf(sb[i]);
                        acc[ai][bj][m][0] = acc[ai][bj][m][0] * (f32x4){sa[0], sa[1], sa[2], sa[3]}; acc[ai][bj][m][1] = acc[ai][bj][m][1] * (f32x4){sa[4], sa[5], sa[6], sa[7]};
                    } else {
                        const f32x4 v0 = acc[ai][bj][m][0] * (f32x4){sa[0], sa[1], sa[2], sa[3]}, v1 = acc[ai][bj][m][1] * (f32x4){sa[4], sa[5], sa[6], sa[7]};
                        u32x4 w; w.x = cvt_pk_bf16(v0[0], v0[1]); w.y = cvt_pk_bf16(v0[2], v0[3]); w.z = cvt_pk_bf16(v1[0], v1[1]); w.w = cvt_pk_bf16(v1[2], v1[3]);
                        *(u32x4*)(ybf + r * DM + col0 + bj * HALF) = w; } }
                if (m & 1) asm volatile("" ::: "memory"); }
        return br == 2;
    }
};
struct MergeOrder {
    StaticOrder base;
    __host__ __device__ void init(int M, int G_, int c_) { base.init(M, 8 * BM, G_, c_, WGM_N8); }
    __host__ __device__ bool next(int i, Unit& u) const { const int t = i / 3, br = i - 3 * t; if (!base.next(t, u)) return false; u.pm += 66 * br; u.pn += 8 * br; return true; }
    __device__ __forceinline__ void a_ready(const Unit&) const {}
    __device__ __forceinline__ void done(const Unit&) const {}
};
struct SplitKOrder {
    int nM, nN, nK, G, c;
    __host__ __device__ void init(int M, int N, int nK_, int G_, int c_) { nM = M / BM; nN = N / BM; nK = nK_; G = G_; c = c_; }
    __host__ __device__ bool next(int i, Unit& u) const { const int L = i * G + c; if (L >= nM * nN * nK) return false; u.pk = L % nK; const int t = L / nK; u.pm = t % nM; u.pn = t / nM; return true; }
    __device__ __forceinline__ void a_ready(const Unit&) const {}
    __device__ __forceinline__ void done(const Unit&) const {}
};
struct EpiPartial {
    static constexpr bool PERM = false, AFTER_DRAIN = false, CHAIN = false;
    float* part; const float* coef; float mul;
    __device__ __forceinline__ void operator()(const f32x4 (&acc)[2][2][4][2], const Unit& u, int wr, int wc, int fr, int fq) const {
        const int col0 = u.pn * BM + wc * 32 + 4 * fq;
        f32x4 cf[2][2];
#pragma unroll
        for (int bj = 0; bj < 2; ++bj)
#pragma unroll
            for (int n = 0; n < 2; ++n) cf[bj][n] = *(const f32x4*)(coef + col0 + bj * HALF + n * 16) * mul;
#pragma unroll
        for (int ai = 0; ai < 2; ++ai)
#pragma unroll
            for (int m = 0; m < 4; ++m) { const int r = u.pm * BM + ai * HALF + wr * 64 + m * 16 + fr; const size_t off = ((size_t)u.pk * 512 + r) * DM + col0;
#pragma unroll
                for (int bj = 0; bj < 2; ++bj)
#pragma unroll
                    for (int n = 0; n < 2; ++n) *(f32x4*)(part + off + bj * HALF + n * 16) = cf[bj][n] * acc[ai][bj][m][n]; }
    }
};

template <class Epi, class Sched, bool ALIGN_EPI = false, bool SP2 = false>
__device__ __forceinline__ void gemm_phase(PG8_LAS unsigned char* lds, const Gemm g, const Sched& S, const Epi& E) {
    int tid_ = threadIdx.x; asm volatile("" : "+v"(tid_)); const int tid = tid_, wid = __builtin_amdgcn_readfirstlane(tid >> 6), lane = tid & 63, wr = wid >> 2, wc = wid & 3, fr = lane & 15, fq = lane >> 4;
    const int K = g.K, nt = K / BK, LD = g.ld ? g.ld : g.K;
    unsigned voffA[2], voffB[2];
#pragma unroll
    for (int i = 0; i < 2; ++i) { int R, C; stage_rc(tid * 16 + i * 8192, R, C); const int Rb = Epi::PERM ? ((R & ~31) + perm32(R & 31)) : R;
        voffA[i] = (unsigned)(R * LD + C) * 2u; voffB[i] = (unsigned)(Rb * LD + C) * 2u; }
    const size_t kstep = (size_t)(BK * 2);
    const size_t hstep = (size_t)HALF * LD * 2;
    const size_t tstep = 2 * hstep;
    const unsigned ldsw = (unsigned)wid * 1024u;
    const int aoff = lds_byte(wr * 64 + fr, fq * 8), boff = lds_byte(wc * 32 + fr, fq * 8);
#define PG8_SA(b, h) (((b) * 2 + (h)) * HTB)
#define PG8_SB(b, h) ((4 + (b) * 2 + (h)) * HTB)
#define PG8_STAGE(bufoff, gbase, voff) do { _Pragma("unroll") for (int _i = 0; _i < 2; ++_i) \
        __builtin_amdgcn_global_load_lds((const unsigned*)((const char*)(gbase) + (voff)[_i]), (PG8_LAS unsigned*)(lds + (bufoff) + ldsw + _i * 8192), 16, 0, 0); } while (0)
#define PG8_LDA(dst, b, h) do { _Pragma("unroll") for (int m = 0; m < 4; ++m) _Pragma("unroll") for (int k = 0; k < 2; ++k) dst[m][k] = *(const PG8_LAS bf16x8*)(lds + PG8_SA(b, h) + aoff + m * 2048 + k * 1024); } while (0)
#define PG8_LDB(dst, b, h) do { _Pragma("unroll") for (int n = 0; n < 2; ++n) _Pragma("unroll") for (int k = 0; k < 2; ++k) dst[n][k] = *(const PG8_LAS bf16x8*)(lds + PG8_SB(b, h) + boff + n * 2048 + k * 1024); } while (0)
#define PG8_MMA(ai, bj, At, Bt) do { __builtin_amdgcn_s_setprio(1); _Pragma("unroll") for (int m = 0; m < 4; ++m) _Pragma("unroll") for (int n = 0; n < 2; ++n) _Pragma("unroll") for (int k = 0; k < 2; ++k) \
        acc[ai][bj][m][n] = __builtin_amdgcn_mfma_f32_16x16x32_bf16(Bt[n][k], At[m][k], acc[ai][bj][m][n], 0, 0, 0); __builtin_amdgcn_s_setprio(0); } while (0)
#define PG8_WAIT_V(n) asm volatile("s_waitcnt vmcnt(" #n ")" ::: "memory")
#define PG8_WAIT_L(n) asm volatile("s_waitcnt lgkmcnt(" #n ")" ::: "memory")
#define PG8_BAR __builtin_amdgcn_s_barrier()
#define PG8_SCHED __builtin_amdgcn_sched_barrier(0)
    Unit cur, nxt; int ui = 0;
    if (!S.next(0, cur)) return;
    f32x4 acc[2][2][4][2];
#pragma unroll
    for (int a = 0; a < 2; ++a)
#pragma unroll
        for (int b = 0; b < 2; ++b)
#pragma unroll
            for (int m = 0; m < 4; ++m)
#pragma unroll
                for (int n = 0; n < 2; ++n) acc[a][b][m][n] = (f32x4){0.f, 0.f, 0.f, 0.f};
    bf16x8 At[4][2], B0[2][2], B1[2][2];
    const size_t kslice = (size_t)K * 2;
    const char* cA = (const char*)g.A + (size_t)cur.pm * tstep + (size_t)cur.pk * kslice; const char* cB = (const char*)g.Bt + (size_t)cur.pn * tstep + (size_t)cur.pk * kslice;
    S.a_ready(cur);
    if constexpr (SP2) {
        PG8_STAGE(PG8_SB(0, 0), cB, voffB); PG8_STAGE(PG8_SB(0, 1), cB + hstep, voffB); PG8_STAGE(PG8_SA(0, 0), cA, voffA); PG8_STAGE(PG8_SA(0, 1), cA + hstep, voffA);
        if (wr == 1) PG8_BAR;
        PG8_WAIT_V(2); PG8_BAR;
        PG8_STAGE(PG8_SB(1, 0), cB + kstep, voffB); PG8_STAGE(PG8_SA(1, 0), cA + kstep, voffA); PG8_STAGE(PG8_SB(1, 1), cB + hstep + kstep, voffB);
        PG8_WAIT_V(6); PG8_BAR;
    } else {
        PG8_STAGE(PG8_SB(0, 0), cB, voffB); PG8_STAGE(PG8_SA(0, 0), cA, voffA); PG8_STAGE(PG8_SB(0, 1), cB + hstep, voffB); PG8_STAGE(PG8_SA(0, 1), cA + hstep, voffA);
        if (wr == 1) PG8_BAR;
        PG8_WAIT_V(4); PG8_BAR;
        PG8_STAGE(PG8_SB(1, 0), cB + kstep, voffB); PG8_STAGE(PG8_SA(1, 0), cA + kstep, voffA); PG8_STAGE(PG8_SB(1, 1), cB + hstep + kstep, voffB);
        PG8_WAIT_V(6); PG8_BAR;
    }
    for (;;) {
        const bool has_next = S.next(ui + 1, nxt);
        const char* nA = has_next ? (const char*)g.A + (size_t)nxt.pm * tstep + (size_t)nxt.pk * kslice : cA; const char* nB = has_next ? (const char*)g.Bt + (size_t)nxt.pn * tstep + (size_t)nxt.pk * kslice : cB;
        for (int t = 0; t < nt; t += 2) {
            const bool last = (t == nt - 2);
            const char* a1 = cA + (size_t)(t + 1) * kstep;
            const char* a2 = last ? nA : cA + (size_t)(t + 2) * kstep; const char* b2 = last ? nB : cB + (size_t)(t + 2) * kstep;
            const char* a3 = a2 + kstep; const char* b3 = b2 + kstep;
            if (last && has_next) S.a_ready(nxt);
            if constexpr (SP2) {
            PG8_LDB(B0, 0, 0); PG8_LDB(B1, 0, 1); PG8_SCHED; PG8_LDA(At, 0, 0); PG8_STAGE(PG8_SA(1, 1), a1 + hstep, voffA);
            PG8_WAIT_V(8); PG8_WAIT_L(0); PG8_BAR; PG8_MMA(0, 0, At, B0); PG8_MMA(0, 1, At, B1); PG8_BAR; PG8_SCHED;
            PG8_LDA(At, 0, 1); PG8_STAGE(PG8_SB(0, 0), b2, voffB); PG8_STAGE(PG8_SB(0, 1), b2 + hstep, voffB); PG8_STAGE(PG8_SA(0, 0), a2, voffA);
            PG8_WAIT_V(8); PG8_WAIT_L(0); PG8_BAR; PG8_MMA(1, 0, At, B0); PG8_MMA(1, 1, At, B1); PG8_BAR; PG8_SCHED;
            PG8_LDB(B0, 1, 0); PG8_LDB(B1, 1, 1); PG8_SCHED; PG8_LDA(At, 1, 0); PG8_STAGE(PG8_SA(0, 1), a2 + hstep, voffA);
            PG8_WAIT_V(8); PG8_WAIT_L(0); PG8_BAR; PG8_MMA(0, 0, At, B0); PG8_MMA(0, 1, At, B1); PG8_BAR; PG8_SCHED;
            PG8_LDA(At, 1, 1); PG8_STAGE(PG8_SB(1, 0), b3, voffB); PG8_STAGE(PG8_SB(1, 1), b3 + hstep, voffB); PG8_STAGE(PG8_SA(1, 0), a3, voffA);
            PG8_WAIT_V(8); PG8_WAIT_L(0); PG8_BAR; PG8_MMA(1, 0, At, B0); PG8_MMA(1, 1, At, B1); PG8_BAR; PG8_SCHED;
            } else {
            PG8_LDB(B0, 0, 0); PG8_SCHED; PG8_LDA(At, 0, 0); PG8_STAGE(PG8_SA(1, 1), a1 + hstep, voffA);
            PG8_WAIT_L(8); PG8_BAR; PG8_WAIT_L(0); PG8_MMA(0, 0, At, B0); PG8_BAR; PG8_SCHED;
            PG8_LDB(B1, 0, 1); PG8_STAGE(PG8_SB(0, 0), b2, voffB);
            PG8_BAR; PG8_WAIT_L(0); PG8_MMA(0, 1, At, B1); PG8_BAR;
            PG8_LDA(At, 0, 1); PG8_STAGE(PG8_SA(0, 0), a2, voffA);
            PG8_BAR; PG8_WAIT_L(0); PG8_MMA(1, 0, At, B0); PG8_BAR; PG8_SCHED;
            PG8_STAGE(PG8_SB(0, 1), b2 + hstep, voffB);
            PG8_WAIT_V(6); PG8_BAR; PG8_MMA(1, 1, At, B1); PG8_BAR;
            PG8_LDB(B0, 1, 0); PG8_SCHED; PG8_LDA(At, 1, 0); PG8_STAGE(PG8_SA(0, 1), a2 + hstep, voffA);
            PG8_WAIT_L(8); PG8_BAR; PG8_WAIT_L(0); PG8_MMA(0, 0, At, B0); PG8_BAR; PG8_SCHED;
            PG8_LDB(B1, 1, 1); PG8_STAGE(PG8_SB(1, 0), b3, voffB);
            PG8_BAR; PG8_WAIT_L(0); PG8_MMA(0, 1, At, B1); PG8_BAR;
            PG8_LDA(At, 1, 1); PG8_STAGE(PG8_SA(1, 0), a3, voffA);
            PG8_BAR; PG8_WAIT_L(0); PG8_MMA(1, 0, At, B0); PG8_BAR; PG8_SCHED;
            PG8_STAGE(PG8_SB(1, 1), b3 + hstep, voffB);
            PG8_WAIT_V(6); PG8_BAR; PG8_MMA(1, 1, At, B1); PG8_BAR;
            }
        }
        if constexpr (ALIGN_EPI) { if (wr == 0) PG8_BAR; }
        bool zero_acc = true;
        if constexpr (Epi::CHAIN) { zero_acc = E.chain(acc, cur, wr, wc, fr, fq); S.done(cur); }
        else if constexpr (!Epi::AFTER_DRAIN) { E(acc, cur, wr, wc, fr, fq); S.done(cur); }
        if (!has_next) break;
        if (zero_acc)
#pragma unroll
        for (int a = 0; a < 2; ++a)
#pragma unroll
            for (int b = 0; b < 2; ++b)
#pragma unroll
                for (int m = 0; m < 4; ++m)
#pragma unroll
                    for (int n = 0; n < 2; ++n) acc[a][b][m][n] = (f32x4){0.f, 0.f, 0.f, 0.f};
        cur = nxt; cA = nA; cB = nB; ++ui;
        if constexpr (ALIGN_EPI) { if (wr == 1) PG8_BAR; }
    }
    PG8_WAIT_V(0);
    if constexpr (!ALIGN_EPI) { if (wr == 0) PG8_BAR; }
    PG8_BAR;
    if constexpr (Epi::AFTER_DRAIN) { E.fused(acc, cur, wr, wc, fr, fq, lds, wid, lane); S.done(cur); }
#undef PG8_SA
#undef PG8_SB
#undef PG8_STAGE
#undef PG8_LDA
#undef PG8_LDB
#undef PG8_MMA
#undef PG8_WAIT_V
#undef PG8_WAIT_L
#undef PG8_BAR
#undef PG8_SCHED
}
}
namespace att {
typedef unsigned short bf16;
using bf16x8 = __attribute__((ext_vector_type(8))) short;
using s16x4  = __attribute__((ext_vector_type(4))) short;
using f32x16 = __attribute__((ext_vector_type(16))) float;
using u32x4  = __attribute__((ext_vector_type(4))) unsigned;
constexpr int NW = 8, QBLK = 32, KVBLK = 64;
constexpr float SCALE = 0.125f;
constexpr float THR = 8.f;
constexpr int LDP = 17408;
constexpr int LDO = 1024;
constexpr size_t SHM_V = KVBLK * 128 * 2, SHM_K = KVBLK * 64 * 2, SHM_ATTN = 2 * SHM_V + 2 * SHM_K + NW * 64 * 4;
#define KSWZ64(row, colB) ((row) * 128 + ((colB) ^ ((((row) >> 1) & 7) << 4)))
#define SBAR() __builtin_amdgcn_sched_barrier(0)
__device__ __forceinline__ int crow(int r, int hi) { return (r & 3) + 8 * (r >> 2) + 4 * hi; }
__device__ __forceinline__ unsigned cvtpk(float lo, float hi) { unsigned r; asm volatile("v_cvt_pk_bf16_f32 %0, %1, %2" : "=v"(r) : "v"(lo), "v"(hi)); return r; }
__device__ __forceinline__ bf16x8 ld8(const bf16* p) { return *reinterpret_cast<const bf16x8*>(p); }

typedef float f32x2a __attribute__((ext_vector_type(2)));
#define MX3(a, b, c) __builtin_fmaxf(__builtin_fmaxf((a), (b)), (c))
constexpr float THR2 = THR * 1.4426950408889634f;
__device__ __forceinline__ void partialSM(f32x16& p0, f32x16& p1, float& mref, f32x16& negm, float& alpha, bool first) {
  float a = MX3(p0[0], p0[1], p1[0]), b = MX3(p0[2], p0[3], p1[1]); a = MX3(a, p1[2], p1[3]);
#pragma unroll
  for (int r = 4; r < 16; r += 4) { a = MX3(a, p0[r], p0[r + 1]); b = MX3(b, p0[r + 2], p0[r + 3]); a = MX3(a, p1[r], p1[r + 1]); b = MX3(b, p1[r + 2], p1[r + 3]); }
  float pmax = __builtin_fmaxf(a, b);
  { auto rr = __builtin_amdgcn_permlane32_swap(__float_as_uint(pmax), __float_as_uint(pmax), false, false);
    pmax = __builtin_fmaxf(__uint_as_float(rr[0]), __uint_as_float(rr[1])); }
  alpha = 1.f;
  if (__builtin_expect(first || !__all(pmax <= THR2), 0)) {
    const float d = first ? pmax : __builtin_fmaxf(pmax, 0.f);
    mref += d; alpha = first ? 0.f : __builtin_amdgcn_exp2f(-d);
#pragma unroll
    for (int r = 0; r < 16; ++r) { p0[r] -= d; p1[r] -= d; }
#pragma unroll
    for (int r = 0; r < 16; ++r) negm[r] = -mref;
    asm volatile("" : "+v"(negm));
  }
#pragma unroll
  for (int r = 0; r < 16; ++r) { p0[r] = __builtin_amdgcn_exp2f(p0[r]); p1[r] = __builtin_amdgcn_exp2f(p1[r]); }
}
__device__ __forceinline__ void finishSM(f32x16& p0, f32x16& p1, float alpha, float& l_reg, bf16x8& pa0, bf16x8& pa1, bf16x8& pa2, bf16x8& pa3) {
  f32x2a s2 = (f32x2a){p0[0], p0[1]} + (f32x2a){p1[0], p1[1]};
#pragma unroll
  for (int r = 2; r < 16; r += 2) { s2 += (f32x2a){p0[r], p0[r + 1]}; s2 += (f32x2a){p1[r], p1[r + 1]}; }
  float ps = s2.x + s2.y;
  { auto rr = __builtin_amdgcn_permlane32_swap(__float_as_uint(ps), __float_as_uint(ps), false, false);
    ps = __uint_as_float(rr[0]) + __uint_as_float(rr[1]); }
  l_reg = l_reg * alpha + ps;
#define PK4(P, BASE, OUT) do { unsigned a0 = cvtpk(P[BASE + 0], P[BASE + 1]), a1 = cvtpk(P[BASE + 2], P[BASE + 3]);   \
    unsigned b0 = cvtpk(P[BASE + 4], P[BASE + 5]), b1 = cvtpk(P[BASE + 6], P[BASE + 7]);                              \
    auto r0 = __builtin_amdgcn_permlane32_swap(a0, b0, false, false); auto r1 = __builtin_amdgcn_permlane32_swap(a1, b1, false, false); \
    u32x4 w = {r0[0], r1[0], r0[1], r1[1]}; OUT = *reinterpret_cast<bf16x8*>(&w); } while (0)
  PK4(p0, 0, pa0); PK4(p0, 8, pa1); PK4(p1, 0, pa2); PK4(p1, 8, pa3);
#undef PK4
}
__device__ __forceinline__ void qkt(f32x16& p0, f32x16& p1, const bf16* Ks, const bf16x8* qr, const f32x16& negm, int r32, int hi) {
#pragma unroll
  for (int d0 = 0; d0 < 4; ++d0) { int cb = (d0 * 16 + hi * 8) * 2;
    bf16x8 b0 = *reinterpret_cast<const bf16x8*>((const char*)Ks + KSWZ64(r32, cb));
    bf16x8 b1 = *reinterpret_cast<const bf16x8*>((const char*)Ks + KSWZ64(32 + r32, cb));
    if (d0 == 0) { p0 = __builtin_amdgcn_mfma_f32_32x32x16_bf16(b0, qr[0], negm, 0, 0, 0); p1 = __builtin_amdgcn_mfma_f32_32x32x16_bf16(b1, qr[0], negm, 0, 0, 0); }
    else { p0 = __builtin_amdgcn_mfma_f32_32x32x16_bf16(b0, qr[d0], p0, 0, 0, 0); p1 = __builtin_amdgcn_mfma_f32_32x32x16_bf16(b1, qr[d0], p1, 0, 0, 0); } }
}
__device__ __forceinline__ int v_st(int k, int c) { const int kk = (k & ~0xC) | ((k & 4) << 1) | ((k & 8) >> 1); return ((kk >> 3) * 4 + (c >> 5)) * 512 + ((kk & 7) * 32 + (c & 31)) * 2; }
__device__ __forceinline__ int v_rd_base(int lane) { return ((lane & 3) << 3) | (((lane >> 2) & 3) << 6) | (((lane >> 4) & 1) << 5) | (((lane >> 5) & 1) << 8); }
constexpr int v_rd_off(int d0, int ks, int half) { return d0 * 512 + ks * 4096 + half * 2048; }
template <int OFF> __device__ __forceinline__ s16x4 tr_read(int vb) {
  s16x4 r; asm volatile("ds_read_b64_tr_b16 %0, %1 offset:%2" : "=&v"(r) : "v"(vb), "i"(OFF) : "memory"); return r;
}
template <int D0> __device__ __forceinline__ void pv_one(f32x16& od, int vb, bf16x8 pa0, bf16x8 pa1, bf16x8 pa2, bf16x8 pa3) {
  const s16x4 l0 = tr_read<v_rd_off(D0, 0, 0)>(vb), h0 = tr_read<v_rd_off(D0, 0, 1)>(vb), l1 = tr_read<v_rd_off(D0, 1, 0)>(vb), h1 = tr_read<v_rd_off(D0, 1, 1)>(vb);
  const s16x4 l2 = tr_read<v_rd_off(D0, 2, 0)>(vb), h2 = tr_read<v_rd_off(D0, 2, 1)>(vb), l3 = tr_read<v_rd_off(D0, 3, 0)>(vb), h3 = tr_read<v_rd_off(D0, 3, 1)>(vb);
  asm volatile("s_waitcnt lgkmcnt(0)" ::: "memory"); SBAR();
#define PK(L, H) (bf16x8){L[0], L[1], L[2], L[3], H[0], H[1], H[2], H[3]}
  od = __builtin_amdgcn_mfma_f32_32x32x16_bf16(pa0, PK(l0, h0), od, 0, 0, 0);
  od = __builtin_amdgcn_mfma_f32_32x32x16_bf16(pa1, PK(l1, h1), od, 0, 0, 0);
  od = __builtin_amdgcn_mfma_f32_32x32x16_bf16(pa2, PK(l2, h2), od, 0, 0, 0);
  od = __builtin_amdgcn_mfma_f32_32x32x16_bf16(pa3, PK(l3, h3), od, 0, 0, 0);
#undef PK
}
__device__ __forceinline__ void pv_d0(f32x16* o, int vb, bf16x8 pa0, bf16x8 pa1, bf16x8 pa2, bf16x8 pa3) {
  pv_one<0>(o[0], vb, pa0, pa1, pa2, pa3); pv_one<1>(o[1], vb, pa0, pa1, pa2, pa3); pv_one<2>(o[2], vb, pa0, pa1, pa2, pa3); pv_one<3>(o[3], vb, pa0, pa1, pa2, pa3);
}
__device__ __forceinline__ unsigned short f2bf_rne(float f) { unsigned u = __float_as_uint(f); return (unsigned short)((u + 0x7fffu + ((u >> 16) & 1u)) >> 16); }

__device__ __forceinline__ void glds16(const void* gsrc, unsigned lds_dst) { unsigned keep;
  asm volatile("s_mov_b32 %0, m0\n\ts_mov_b32 m0, %2\n\ts_nop 0\n\tglobal_load_lds_dwordx4 %1, off\n\ts_mov_b32 m0, %0" : "=&s"(keep) : "v"(gsrc), "s"(lds_dst) : "memory"); }
constexpr int LDS_K = 0, NKS = 3, LDS_V = NKS * (int)SHM_K, NVS = 4, LDS_WS = LDS_V + NVS * (int)SHM_V, ATT_LDS_BYTES = LDS_WS + NW * 64 * 4;
__device__ __forceinline__ void attn_unit(const bf16* __restrict__ proj, int qrow0, int crow0, int lrow0, int NT, int h, int p, bf16* __restrict__ Oout, char* lds) {
  int tid_ = threadIdx.x; asm volatile("" : "+v"(tid_)); const int tid = tid_, lane = tid & 63, r32 = lane & 31, hi = lane >> 5;
  const int wid = __builtin_amdgcn_readfirstlane(tid >> 6);
  const int CQ = 8192 + 128 * h + 64 * p, CK = 9216 + 128 * h + 64 * p, CV = 10240 + 128 * h;
  const unsigned lds0 = (unsigned)(uintptr_t)lds;
  asm volatile("s_waitcnt vmcnt(0)" ::: "memory");
  float* ws = (float*)(lds + LDS_WS) + wid * 64; float* li_l = ws; float* al_l = ws + 32;
  float mref = 0.f, l_reg = 0; f32x16 o[4] = {}; bf16x8 qr[4]; f32x16 negm = f32x16{}; asm volatile("" : "+v"(negm));
  const bf16* Qw = proj + (size_t)(qrow0 + wid * QBLK + r32) * LDP + CQ + hi * 8;
#pragma unroll
  for (int d0 = 0; d0 < 4; ++d0) qr[d0] = ld8(Qw + d0 * 16);
  size_t kofs, vofs[2];
  { const int row = 8 * wid + (lane >> 3), cpos = lane & 7, cc = cpos ^ ((row >> 1) & 7); kofs = (size_t)row * LDP + CK + cc * 8; }
#pragma unroll
  for (int i = 0; i < 2; ++i) { const int gidx = (2 * wid + i) * 64 + lane, st = gidx >> 5, within = gidx & 31, kk = (st >> 2) * 8 + (within >> 2), cc = (st & 3) * 32 + (within & 3) * 8;
    const int k = (kk & ~0xC) | ((kk & 4) << 1) | ((kk & 8) >> 1); vofs[i] = (size_t)k * LDP + CV + cc; }
#define TROW(jt) ((jt) < 4 ? crow0 + 64 * (jt) : lrow0 + 64 * ((jt) - 4))
#define DMA(jt, ks, vs) do { const bf16* tb_ = proj + (size_t)TROW(jt) * LDP; glds16(tb_ + kofs, lds0 + LDS_K + (ks) * (unsigned)SHM_K + wid * 1024u); \
    glds16(tb_ + vofs[0], lds0 + LDS_V + (vs) * (unsigned)SHM_V + (2 * wid) * 1024u); glds16(tb_ + vofs[1], lds0 + LDS_V + (vs) * (unsigned)SHM_V + (2 * wid + 1) * 1024u); } while (0)
#define DMA_K(jt, ks) do { const bf16* tb_ = proj + (size_t)TROW(jt) * LDP; glds16(tb_ + kofs, lds0 + LDS_K + (ks) * (unsigned)SHM_K + wid * 1024u); } while (0)
#define DMA_V(jt, vs, i) do { const bf16* tb_ = proj + (size_t)TROW(jt) * LDP; glds16(tb_ + vofs[i], lds0 + LDS_V + (vs) * (unsigned)SHM_V + (2 * wid + (i)) * 1024u); } while (0)
#define WAITBAR(n) asm volatile("s_waitcnt vmcnt(" #n ") lgkmcnt(0)\n\ts_barrier" ::: "memory")
#define RESC(a) do { if (__any((a) < 1.f)) { if (hi == 0) al_l[r32] = (a); asm volatile("s_waitcnt lgkmcnt(0)" ::: "memory"); \
    _Pragma("unroll") for (int d = 0; d < 4; ++d) _Pragma("unroll") for (int r = 0; r < 16; ++r) o[d][r] *= al_l[crow(r, hi)]; } } while (0)
  const int vbase = (int)(lds0 + LDS_V) + v_rd_base(lane);
  f32x16 pA0, pA1, pB0, pB1; float alA, alB; bf16x8 pa0, pa1, pa2, pa3;
  int ks_cur = 0, vs_prev = 0;
  DMA(0, 0, 0); DMA(1, 1, 1);
  WAITBAR(3);
  qkt(pA0, pA1, (const bf16*)(lds + LDS_K), qr, negm, r32, hi); partialSM(pA0, pA1, mref, negm, alA, true);
  DMA(2, 2, 2);
  WAITBAR(3);
  ks_cur = 1; vs_prev = 0;
#define EX4(P, B) do { P[B] = __builtin_amdgcn_exp2f(P[B]); P[B + 1] = __builtin_amdgcn_exp2f(P[B + 1]); P[B + 2] = __builtin_amdgcn_exp2f(P[B + 2]); P[B + 3] = __builtin_amdgcn_exp2f(P[B + 3]); } while (0)
#define EX2(P, B) do { P[B] = __builtin_amdgcn_exp2f(P[B]); P[B + 1] = __builtin_amdgcn_exp2f(P[B + 1]); } while (0)
#define PK4(P, BASE, OUT) do { unsigned a0 = cvtpk(P[BASE + 0], P[BASE + 1]), a1 = cvtpk(P[BASE + 2], P[BASE + 3]);   \
    unsigned b0 = cvtpk(P[BASE + 4], P[BASE + 5]), b1 = cvtpk(P[BASE + 6], P[BASE + 7]);                              \
    auto r0 = __builtin_amdgcn_permlane32_swap(a0, b0, false, false); auto r1 = __builtin_amdgcn_permlane32_swap(a1, b1, false, false); \
    u32x4 w = {r0[0], r1[0], r0[1], r1[1]}; OUT = *reinterpret_cast<bf16x8*>(&w); } while (0)
#define KFR(row, d0) (*reinterpret_cast<const bf16x8*>(kb_ + KSWZ64((row), ((d0) * 16 + hi * 8) * 2)))
#define TRR(D0, ks, half) tr_read<v_rd_off(D0, ks, half)>(vb_)
#define PKV(L, H) (bf16x8){L[0], L[1], L[2], L[3], H[0], H[1], H[2], H[3]}
#define LGKM(n) asm volatile("s_waitcnt lgkmcnt(" #n ")" ::: "memory")
#define PVMMA(D0, PA, NEXT, WAITN, G) do { WAITN; SBAR(); o[D0] = __builtin_amdgcn_mfma_f32_32x32x16_bf16(PA, PKV(l##D0, h##D0), o[D0], 0, 0, 0); NEXT; G; SBAR(); } while (0)
#define PVALL(G0, G1, G2, G3, G4, G5, G6, G7, G8, G9, G10, G11, G12, G13, G14, G15) do { \
    PVMMA(0, pa0, { l0 = TRR(0, 1, 0); h0 = TRR(0, 1, 1); }, LGKM(6), G0); \
    PVMMA(1, pa0, { l1 = TRR(1, 1, 0); h1 = TRR(1, 1, 1); }, LGKM(6), G1); \
    PVMMA(2, pa0, { l2 = TRR(2, 1, 0); h2 = TRR(2, 1, 1); }, LGKM(6), G2); \
    PVMMA(3, pa0, { l3 = TRR(3, 1, 0); h3 = TRR(3, 1, 1); }, LGKM(6), G3); \
    PVMMA(0, pa1, { l0 = TRR(0, 2, 0); h0 = TRR(0, 2, 1); }, LGKM(6), G4); \
    PVMMA(1, pa1, { l1 = TRR(1, 2, 0); h1 = TRR(1, 2, 1); }, LGKM(6), G5); \
    PVMMA(2, pa1, { l2 = TRR(2, 2, 0); h2 = TRR(2, 2, 1); }, LGKM(6), G6); \
    PVMMA(3, pa1, { l3 = TRR(3, 2, 0); h3 = TRR(3, 2, 1); }, LGKM(6), G7); \
    PVMMA(0, pa2, { l0 = TRR(0, 3, 0); h0 = TRR(0, 3, 1); }, LGKM(6), G8); \
    PVMMA(1, pa2, { l1 = TRR(1, 3, 0); h1 = TRR(1, 3, 1); }, LGKM(6), G9); \
    PVMMA(2, pa2, { l2 = TRR(2, 3, 0); h2 = TRR(2, 3, 1); }, LGKM(6), G10); \
    PVMMA(3, pa2, { l3 = TRR(3, 3, 0); h3 = TRR(3, 3, 1); }, LGKM(6), G11); \
    PVMMA(0, pa3, { }, LGKM(6), G12); \
    PVMMA(1, pa3, { }, LGKM(4), G13); \
    PVMMA(2, pa3, { }, LGKM(2), G14); \
    PVMMA(3, pa3, { }, LGKM(0), G15); } while (0)
#define FADD(a, b) ((a) + (b))
#define PIN(x) asm volatile("" : "+v"(x))
#define EX3(P, a, b, c_) do { P[a] = __builtin_amdgcn_exp2f(P[a]); P[b] = __builtin_amdgcn_exp2f(P[b]); P[c_] = __builtin_amdgcn_exp2f(P[c_]); PIN(P); } while (0)
#define PKH(P, B, RA, RB) do { const unsigned a_ = cvtpk(P[B], P[B + 1]), b_ = cvtpk(P[B + 4], P[B + 5]); auto r_ = __builtin_amdgcn_permlane32_swap(a_, b_, false, false); RA = r_[0]; RB = r_[1]; } while (0)
#define MKPA(OUT, x0, x1, y0, y1) do { u32x4 w_ = {x0, y0, x1, y1}; OUT = *reinterpret_cast<bf16x8*>(&w_); } while (0)
#define STEP(PX0, PX1, ALX, PY0, PY1, ALY, j) do { \
    const int jn_ = (j) + 2; const bool more_ = jn_ < NT; const int ksn_ = (ks_cur + 2) % 3, vsn_ = (vs_prev + 3) & 3; \
    const char* kb_ = lds + LDS_K + ks_cur * (int)SHM_K; const int vb_ = vbase + vs_prev * (int)SHM_V; \
    float sa_, sb_; \
    s16x4 l0, h0, l1, h1, l2, h2, l3, h3; \
    { bf16x8 kA = KFR(r32, 0), kB = KFR(32 + r32, 0), kC = KFR(r32, 1), kD = KFR(32 + r32, 1); unsigned x0_, x1_, y0_, y1_; SBAR(); \
      PX0 = __builtin_amdgcn_mfma_f32_32x32x16_bf16(kA, qr[0], negm, 0, 0, 0); if (more_) DMA_K(jn_, ksn_); PKH(PY0, 0, x0_, x1_); sa_ = PY0[0] + PY0[1]; sa_ += PY0[2]; SBAR(); \
      PX1 = __builtin_amdgcn_mfma_f32_32x32x16_bf16(kB, qr[0], negm, 0, 0, 0); kA = KFR(r32, 2); kB = KFR(32 + r32, 2); if (more_) DMA_V(jn_, vsn_, 0); PKH(PY0, 2, y0_, y1_); MKPA(pa0, x0_, x1_, y0_, y1_); sa_ += PY0[3]; sa_ += PY0[4]; SBAR(); \
      PX0 = __builtin_amdgcn_mfma_f32_32x32x16_bf16(kC, qr[1], PX0, 0, 0, 0); if (more_) DMA_V(jn_, vsn_, 1); PKH(PY0, 8, x0_, x1_); sa_ += PY0[5]; sa_ += PY0[6]; SBAR(); \
      PX1 = __builtin_amdgcn_mfma_f32_32x32x16_bf16(kD, qr[1], PX1, 0, 0, 0); kC = KFR(r32, 3); kD = KFR(32 + r32, 3); PKH(PY0, 10, y0_, y1_); MKPA(pa1, x0_, x1_, y0_, y1_); sa_ += PY0[7]; sa_ += PY0[8]; SBAR(); \
      PX0 = __builtin_amdgcn_mfma_f32_32x32x16_bf16(kA, qr[2], PX0, 0, 0, 0); l0 = TRR(0, 0, 0); h0 = TRR(0, 0, 1); PKH(PY1, 0, x0_, x1_); sa_ += PY0[9]; sa_ += PY0[10]; SBAR(); \
      PX1 = __builtin_amdgcn_mfma_f32_32x32x16_bf16(kB, qr[2], PX1, 0, 0, 0); l1 = TRR(1, 0, 0); h1 = TRR(1, 0, 1); PKH(PY1, 2, y0_, y1_); MKPA(pa2, x0_, x1_, y0_, y1_); sa_ += PY0[11]; sa_ += PY0[12]; SBAR(); \
      PX0 = __builtin_amdgcn_mfma_f32_32x32x16_bf16(kC, qr[3], PX0, 0, 0, 0); l2 = TRR(2, 0, 0); h2 = TRR(2, 0, 1); PKH(PY1, 8, x0_, x1_); sa_ += PY0[13]; sa_ += PY0[14]; SBAR(); \
      PX1 = __builtin_amdgcn_mfma_f32_32x32x16_bf16(kD, qr[3], PX1, 0, 0, 0); l3 = TRR(3, 0, 0); h3 = TRR(3, 0, 1); PKH(PY1, 10, y0_, y1_); MKPA(pa3, x0_, x1_, y0_, y1_); sa_ += PY0[15]; sb_ = PY1[0] + PY1[1]; SBAR(); } \
    float mxa_, mxb_, pmax_; \
    PVALL({ mxa_ = MX3(PX0[0], PX0[1], PX1[0]); mxb_ = MX3(PX0[2], PX0[3], PX1[1]); mxa_ = MX3(mxa_, PX1[2], PX1[3]); sb_ += PY1[2]; sb_ += PY1[3]; }, \
          { mxa_ = MX3(mxa_, PX0[4], PX0[5]); mxb_ = MX3(mxb_, PX0[6], PX0[7]); mxa_ = MX3(mxa_, PX1[4], PX1[5]); mxb_ = MX3(mxb_, PX1[6], PX1[7]); sb_ += PY1[4]; sb_ += PY1[5]; }, \
          { mxa_ = MX3(mxa_, PX0[8], PX0[9]); mxb_ = MX3(mxb_, PX0[10], PX0[11]); mxa_ = MX3(mxa_, PX1[8], PX1[9]); mxb_ = MX3(mxb_, PX1[10], PX1[11]); sb_ += PY1[6]; sb_ += PY1[7]; }, \
          { mxa_ = MX3(mxa_, PX0[12], PX0[13]); mxb_ = MX3(mxb_, PX0[14], PX0[15]); mxa_ = MX3(mxa_, PX1[12], PX1[13]); mxb_ = MX3(mxb_, PX1[14], PX1[15]); sb_ += PY1[8]; sb_ += PY1[9]; }, \
          { pmax_ = __builtin_fmaxf(mxa_, mxb_); auto rr_ = __builtin_amdgcn_permlane32_swap(__float_as_uint(pmax_), __float_as_uint(pmax_), false, false); pmax_ = __builtin_fmaxf(__uint_as_float(rr_[0]), __uint_as_float(rr_[1])); \
            sb_ += PY1[10]; sb_ += PY1[11]; sb_ += PY1[12]; }, \
          { sb_ += PY1[13]; sb_ += PY1[14]; sb_ += PY1[15]; { float ps_ = sa_ + sb_; auto rq_ = __builtin_amdgcn_permlane32_swap(__float_as_uint(ps_), __float_as_uint(ps_), false, false); ps_ = __uint_as_float(rq_[0]) + __uint_as_float(rq_[1]); l_reg = l_reg * ALY + ps_; } \
            ALX = 1.f; if (__builtin_expect(!__all(pmax_ <= THR2), 0)) { const float d_ = __builtin_fmaxf(pmax_, 0.f); mref += d_; ALX = __builtin_amdgcn_exp2f(-d_); \
              _Pragma("unroll") for (int r = 0; r < 16; ++r) { PX0[r] -= d_; PX1[r] -= d_; } _Pragma("unroll") for (int r = 0; r < 16; ++r) negm[r] = -mref; asm volatile("" : "+v"(negm)); } }, \
          { EX3(PX0, 0, 1, 2); }, { EX3(PX0, 3, 4, 5); }, { EX3(PX0, 6, 7, 8); }, { EX3(PX0, 9, 10, 11); }, { EX3(PX0, 12, 13, 14); }, \
          { PX0[15] = __builtin_amdgcn_exp2f(PX0[15]); PX1[0] = __builtin_amdgcn_exp2f(PX1[0]); PX1[1] = __builtin_amdgcn_exp2f(PX1[1]); PIN(PX0); PIN(PX1); }, \
          { EX3(PX1, 2, 3, 4); }, { EX3(PX1, 5, 6, 7); }, { EX3(PX1, 8, 9, 10); PX1[11] = __builtin_amdgcn_exp2f(PX1[11]); PIN(PX1); }, { EX2(PX1, 12); EX2(PX1, 14); PIN(PX1); }); \
    if (more_) WAITBAR(3); else WAITBAR(0); \
    RESC(ALX); ks_cur = (ks_cur + 1) % 3; vs_prev = (vs_prev + 1) & 3; } while (0)
  for (int j = 1; j + 1 < NT; j += 2) {
    STEP(pB0, pB1, alB, pA0, pA1, alA, j);
    STEP(pA0, pA1, alA, pB0, pB1, alB, j + 1);
  }
  STEP(pB0, pB1, alB, pA0, pA1, alA, NT - 1);
  finishSM(pB0, pB1, alB, l_reg, pa0, pa1, pa2, pa3); SBAR();
  pv_d0(o, vbase + vs_prev * (int)SHM_V, pa0, pa1, pa2, pa3);
  if (hi == 0) li_l[r32] = l_reg; asm volatile("s_waitcnt lgkmcnt(0)" ::: "memory");
  float rli[16];
#pragma unroll
  for (int r = 0; r < 16; ++r) rli[r] = __builtin_amdgcn_rcpf(li_l[crow(r, hi)]);
  bf16* Ow = Oout + (size_t)(qrow0 + wid * QBLK) * LDO + 128 * h;
#pragma unroll
  for (int r = 0; r < 16; ++r) { const int orow = crow(r, hi);
#pragma unroll
    for (int d0 = 0; d0 < 4; ++d0) Ow[(size_t)orow * LDO + d0 * 32 + r32] = f2bf_rne(o[d0][r] * rli[r]); }
  asm volatile("s_waitcnt vmcnt(0) lgkmcnt(0)\n\ts_barrier" ::: "memory");
#undef TROW
#undef DMA
#undef DMA_K
#undef DMA_V
#undef WAITBAR
#undef STEP
#undef PKH
#undef MKPA
#undef FADD
#undef EX3
#undef PIN
#undef PVALL
#undef PVMMA
#undef LGKM
#undef PKV
#undef TRR
#undef KFR
#undef PK4
#undef EX2
#undef EX4
#undef RESC
}
#undef SBAR
}

constexpr int NWAVES = 8;
#ifndef MK_N_LAUNCHES
#define MK_N_LAUNCHES 1
#endif
constexpr int D = 2048, NLAT = 16384, NCTX = 512, MTOT = NLAT + NCTX, SEQ = 8192, CTXL = 256, FF = 5632, WIN = 17408, MODW = 18432, MIXW = 1024;
constexpr int C_HQ = 0, C_HF = 1024, C_HB = 2048, C_HI = 3072, C_HG = 4096, C_CB = 5120, C_CC = 6144, C_CU = 7168, C_AQ = 8192, C_AK = 9216, C_AV = 10240, C_GA = 11264, C_GB = 13312, C_GC = 15360;
constexpr int NCHUNK = 132;
constexpr int NSEQ = 32;
constexpr float EPS = 1e-6f;
constexpr int NPL = 13;
constexpr int NPHASE = 1 + 2 * NPL + 1;

constexpr size_t MiB = 1u << 20;
constexpr size_t WS_CTL = 0, CTL_ZERO_BYTES = 65536;
constexpr size_t WS_MOD = 1 * MiB;
constexpr size_t WS_HCTX = 2 * MiB;
constexpr size_t WS_W13T = 6 * MiB;
constexpr size_t WS_W2T = WS_W13T + 88 * MiB;
constexpr size_t WS_WINT = WS_W2T + 44 * MiB;
constexpr size_t WS_WBT = WS_WINT + 68 * MiB;
constexpr size_t WS_WOT = WS_WBT + 12 * MiB;
constexpr size_t WS_XN = WS_WOT + 8 * MiB;
constexpr size_t WS_PROJ = WS_XN + 66 * MiB;
constexpr size_t WS_ST = WS_PROJ + 561 * MiB;
constexpr size_t WS_DEC = WS_ST + 132 * MiB;
constexpr size_t WS_BR = WS_DEC + 3 * MiB;
constexpr size_t WS_OP = WS_BR + 99 * MiB;
constexpr size_t WS_PART = WS_OP + 66 * MiB;
constexpr size_t WS_H16 = WS_PART + 44 * MiB;
constexpr size_t WS_QS = WS_H16 + 66 * MiB;
constexpr size_t WS_KS = WS_QS + 66 * MiB;
constexpr size_t WS_END = WS_KS + 66 * MiB;
constexpr size_t WS_EMID = WS_HCTX;
static_assert((size_t)MTOT * WIN * 2 <= 561 * MiB && (size_t)4224 * 16384 * 2 <= 132 * MiB && (size_t)MTOT * D * 4 <= 132 * MiB && (size_t)3 * MTOT * MIXW * 2 <= 99 * MiB, "d_ws map");
constexpr int CW_BAR = 4096;

constexpr int RING_OFF = 0, RING_BYTES = 131072;
constexpr int LDSCTL_OFF = RING_BYTES, MISC_OFF = LDSCTL_OFF + 320;
constexpr int LDS_BYTES = 147456;

#define GAS __attribute__((address_space(1)))
#define LAS __attribute__((address_space(3)))
typedef unsigned short bf16;
typedef unsigned v4u __attribute__((ext_vector_type(4)));
typedef unsigned v2u __attribute__((ext_vector_type(2)));
typedef float f32x4 __attribute__((ext_vector_type(4)));
typedef short bf16x8 __attribute__((ext_vector_type(8)));
typedef GAS unsigned gu32;
#define RLX_AGENT __ATOMIC_RELAXED, __HIP_MEMORY_SCOPE_AGENT
#define LDS_WAIT() asm volatile("s_waitcnt lgkmcnt(0)" ::: "memory")
#define VM_WAIT() asm volatile("s_waitcnt vmcnt(0)" ::: "memory")
typedef __bf16 hwbf2 __attribute__((ext_vector_type(2)));
typedef float hwf2 __attribute__((ext_vector_type(2)));
__device__ __forceinline__ unsigned pk2(float lo, float hi) { const hwf2 v = {lo, hi}; return __builtin_bit_cast(unsigned, __builtin_convertvector(v, hwbf2)); }
__device__ __forceinline__ unsigned f2bf(float f) { return pk2(f, f) & 0xffffu; }
__device__ __forceinline__ float bflo(unsigned w) { return __uint_as_float(w << 16); }
__device__ __forceinline__ float bfhi(unsigned w) { return __uint_as_float(w & 0xffff0000u); }
__device__ __forceinline__ float silu_f(float x) { return x * __builtin_amdgcn_rcpf(1.0f + __builtin_amdgcn_exp2f(-1.4426950408889634f * x)); }
__device__ __forceinline__ float sigm_f(float x) { return __builtin_amdgcn_rcpf(1.0f + __builtin_amdgcn_exp2f(-1.4426950408889634f * x)); }

#define XB_TMO      128
#define XB_XCNT(j)  (256  + 64 * (j))
#define XB_XSUB(j)  (1280 + 64 * (j))
#define XB_XGEN(j)  (2304 + 64 * (j))
#define XB_TOP      3328
#define XB_TOPGEN   3392
#define XCD_BAR_WORDS 3456
#define XB_SPIN_CAP (1u << 18)

__device__ __forceinline__ unsigned xb_ld(unsigned* p)              { return __hip_atomic_load(p, __ATOMIC_RELAXED, __HIP_MEMORY_SCOPE_AGENT); }
__device__ __forceinline__ unsigned xb_add(unsigned* p, unsigned v) { return __hip_atomic_fetch_add(p, v, __ATOMIC_RELAXED, __HIP_MEMORY_SCOPE_AGENT); }
__device__ __forceinline__ unsigned xb_xcc_id() { return (unsigned)__builtin_amdgcn_s_getreg((3 << 11) | 20) & 0xFu; }
#define XB_SPIN(cond, bar) do { unsigned _sp = 0; while (cond) { __builtin_amdgcn_s_sleep(1); \
    if ((++_sp & 255u) == 0u) { if (xb_ld(&(bar)[XB_TMO])) break; if (_sp > XB_SPIN_CAP) { atomicAdd(&(bar)[XB_TMO], 1u); break; } } } } while (0)

struct XcdBarrier {
    unsigned* bar; unsigned x;
    volatile LAS unsigned* st;
};

__device__ __forceinline__ XcdBarrier xcd_barrier_post(unsigned* bar, volatile LAS unsigned* st) {
    XcdBarrier b; b.bar = bar; b.x = xb_xcc_id(); b.st = st;
    if (threadIdx.x == 0) (void)xb_add(&bar[XB_XCNT(b.x)], 1u);
    return b;
}
__device__ __forceinline__ void xcd_barrier_complete(unsigned* bar, unsigned x, unsigned& nloc, unsigned& nx) {
    const unsigned G = gridDim.x * gridDim.y * gridDim.z;
    unsigned sum, cnt, mine, sp = 0u;
    for (;;) {
        sum = 0u; cnt = 0u; mine = 0u;
#pragma unroll
        for (unsigned j = 0; j < 16; ++j) { const unsigned c = xb_ld(&bar[XB_XCNT(j)]); sum += c; cnt += (c > 0u) ? 1u : 0u; mine = (j == x) ? c : mine; }
        if (sum == G) break;
        __builtin_amdgcn_s_sleep(1);
        if ((++sp & 255u) == 0u) { if (xb_ld(&bar[XB_TMO])) break; if (sp > XB_SPIN_CAP) { atomicAdd(&bar[XB_TMO], 1u); break; } }
    }
    nloc = mine > 0u ? mine : 1u; nx = cnt > 0u ? cnt : 1u;
}

__device__ __forceinline__ void xcd_barrier(const XcdBarrier& b) {
    asm volatile("s_waitcnt vmcnt(0)" ::: "memory");
    __syncthreads();
    if (threadIdx.x == 0) {
        unsigned* bar = b.bar;
        __builtin_amdgcn_s_waitcnt(0);
        unsigned nloc = b.st[0], nx = b.st[1];
        if (nloc == 0u) { xcd_barrier_complete(bar, b.x, nloc, nx); b.st[0] = nloc; b.st[1] = nx; }
        const unsigned old = xb_add(&bar[XB_XSUB(b.x)], 1u);
        const unsigned gen = old / nloc;
        if (old + 1u == (gen + 1u) * nloc) {
            __builtin_amdgcn_fence(__ATOMIC_RELEASE, "agent");
            asm volatile("s_waitcnt vmcnt(0)" ::: "memory");
            const unsigned og = xb_add(&bar[XB_TOP], 1u);
            const unsigned tg = og / nx;
            if (og + 1u == (tg + 1u) * nx) xb_add(&bar[XB_TOPGEN], 1u);
            else XB_SPIN(xb_ld(&bar[XB_TOPGEN]) == tg, bar);
            __builtin_amdgcn_fence(__ATOMIC_ACQUIRE, "agent");
            xb_add(&bar[XB_XGEN(b.x)], 1u);
            asm volatile("s_waitcnt vmcnt(0)" ::: "memory");
        } else {
            XB_SPIN(xb_ld(&bar[XB_XGEN(b.x)]) == gen, bar);
            __builtin_amdgcn_fence(__ATOMIC_ACQUIRE, "agent");
            asm volatile("s_waitcnt vmcnt(0)" ::: "memory");
        }
    }
    __syncthreads();
}

struct Frame {
    LAS unsigned char* lds;
    volatile LAS unsigned* MISC;
    gu32* ctl;
    unsigned char* ws;
    float* out;
    int tid, lane, wave;
    int vcu, G, bx;
};
__device__ __forceinline__ void launder(Frame& P) {
    int t = P.tid; asm volatile("" : "+v"(t)); P.tid = t; P.lane = t & 63; P.wave = __builtin_amdgcn_readfirstlane(t >> 6);
    unsigned long long w = (unsigned long long)P.ws, o = (unsigned long long)P.out; int g = P.G, v = P.vcu, x = P.bx;
    asm volatile("" : "+s"(w), "+s"(o), "+s"(g), "+s"(v), "+s"(x));
    P.ws = (unsigned char*)w; P.out = (float*)o; P.G = g; P.vcu = v; P.bx = x;
}
__device__ __forceinline__ const float* in_ptr(int k) {
    auto kp = (const float* const __attribute__((address_space(4)))*)__builtin_amdgcn_kernarg_segment_ptr();
    int kk = k; asm volatile("" : "+s"(kk));
    return kp[kk];
}
#define IP_X in_ptr(0)
#define IP_C in_ptr(1)
#define IP_CTX in_ptr(2)
#define IP_CCTX in_ptr(3)
#define IP_WADA in_ptr(4)
#define IP_BADA in_ptr(5)
#define IP_NORMW in_ptr(6)
#define IP_W13 in_ptr(7)
#define IP_W2 in_ptr(8)
#define IP_WIN in_ptr(9)
#define IP_HLB in_ptr(10)
#define IP_HNW in_ptr(11)
#define IP_CONVW in_ptr(12)
#define IP_LAM in_ptr(13)
#define IP_DANW in_ptr(14)
#define IP_WBR in_ptr(15)
#define IP_WOUT in_ptr(16)
#define IP_FNW in_ptr(17)
#define W_HCTX ((float*)(F.ws + WS_HCTX))
#define W_MOD ((float*)(F.ws + WS_MOD))
#define W_W13T ((bf16*)(F.ws + WS_W13T))
#define W_W2T ((bf16*)(F.ws + WS_W2T))
#define W_WINT ((bf16*)(F.ws + WS_WINT))
#define W_WBT ((bf16*)(F.ws + WS_WBT))
#define W_WOT ((bf16*)(F.ws + WS_WOT))
#define W_XN ((bf16*)(F.ws + WS_XN))
#define W_PROJ ((bf16*)(F.ws + WS_PROJ))
#define W_HID ((bf16*)(F.ws + WS_PROJ))
#define W_ST ((bf16*)(F.ws + WS_ST))
#define W_BR ((bf16*)(F.ws + WS_BR))
#define W_OP ((bf16*)(F.ws + WS_OP))
#define W_Y32 ((float*)(F.ws + WS_ST))
#define W_DEC ((float*)(F.ws + WS_DEC))
#define W_PART ((float*)(F.ws + WS_PART))
#define W_H16 ((bf16*)(F.ws + WS_H16))
#define W_QS ((bf16*)(F.ws + WS_QS))
#define W_KS ((bf16*)(F.ws + WS_KS))
#define W_EMID ((float*)(F.ws + WS_EMID))

__device__ __forceinline__ float wave_sum(float v) {
#pragma unroll
    for (int o = 1; o < 64; o <<= 1) v += __shfl_xor(v, o);
    return v;
}

__device__ __forceinline__ void p_ada(Frame& F) {
    LAS float* sc = (LAS float*)(F.lds + RING_OFF);
    LAS float* red = sc + 3 * D;
    const float* cvec = IP_C; const float* ccv = IP_CCTX; const float* wada = IP_WADA; const float* bada = IP_BADA; float* modp = W_MOD;
    for (int i = F.tid; i < 3 * D; i += NWAVES * 64) { const int g = i / D, k = i - g * D; const float v = (g < 2) ? cvec[g * D + k] : ccv[k]; sc[i] = silu_f(v); }
    __syncthreads();
    const int rr = F.lane >> 3, cg = F.lane & 7;
    for (int unit = F.bx; unit < 2 * (MODW / 32); unit += F.G) {
        const int layer = unit / (MODW / 32), cb = unit - layer * (MODW / 32), col = cb * 32 + 4 * cg;
        const float* W = wada + (size_t)layer * D * MODW + col;
        const int k0 = F.wave * 256 + rr; f32x4 a0 = {0.f, 0.f, 0.f, 0.f}, a1 = a0, a2 = a0;
#pragma unroll 1
        for (int kb = 0; kb < 256; kb += 128) {
            f32x4 wv[16];
#pragma unroll
            for (int i = 0; i < 16; ++i) wv[i] = *(const GAS f32x4*)(W + (size_t)(k0 + kb + 8 * i) * MODW);
#pragma unroll
            for (int i = 0; i < 16; ++i) { const int k = k0 + kb + 8 * i; a0 = a0 + wv[i] * sc[k]; a1 = a1 + wv[i] * sc[D + k]; a2 = a2 + wv[i] * sc[2 * D + k]; }
        }
#pragma unroll
        for (int j = 0; j < 4; ++j) {
#pragma unroll
            for (int o = 8; o < 64; o <<= 1) { a0[j] += __shfl_xor(a0[j], o); a1[j] += __shfl_xor(a1[j], o); a2[j] += __shfl_xor(a2[j], o); } }
        if (rr == 0) { *(LAS f32x4*)(red + (F.wave * 3 + 0) * 32 + 4 * cg) = a0; *(LAS f32x4*)(red + (F.wave * 3 + 1) * 32 + 4 * cg) = a1; *(LAS f32x4*)(red + (F.wave * 3 + 2) * 32 + 4 * cg) = a2; }
        __syncthreads();
        if (F.tid < 96) { const int g = F.tid >> 5, c = F.tid & 31; float t = 0.f;
#pragma unroll
            for (int w = 0; w < 8; ++w) t += red[(w * 3 + g) * 32 + c];
            modp[(size_t)(layer * 3 + g) * MODW + cb * 32 + c] = t + bada[(size_t)layer * MODW + cb * 32 + c]; }
        __syncthreads();
    }
}

struct CvtItem { const float* W; bf16* WT; int K, N, k0, n0, drow0; };
__device__ __forceinline__ void cvt_issue(const CvtItem& I, f32x4 (&t)[8], int lane) {
    const int rr = lane >> 3, cg = lane & 7;
#pragma unroll
    for (int i = 0; i < 8; ++i) t[i] = *(const GAS f32x4*)(I.W + (size_t)(I.k0 + 8 * i + rr) * I.N + I.n0 + 4 * cg);
}
__device__ __forceinline__ void cvt_finish(const CvtItem& I, const f32x4 (&t)[8], LAS float* scr, int lane) {
    { const int rr = lane >> 3, cg = lane & 7;
#pragma unroll
      for (int i = 0; i < 8; ++i) { LAS float* d = scr + (8 * i + rr) * 33 + 4 * cg; d[0] = t[i][0]; d[1] = t[i][1]; d[2] = t[i][2]; d[3] = t[i][3]; } }
    LDS_WAIT(); asm volatile("" ::: "memory");
    const int c = lane & 7;
#pragma unroll
    for (int j = 0; j < 4; ++j) { const int n = (lane >> 3) + 8 * j; const LAS float* s = scr + (8 * c) * 33 + n;
        v4u o; o.x = pk2(s[0 * 33], s[1 * 33]); o.y = pk2(s[2 * 33], s[3 * 33]); o.z = pk2(s[4 * 33], s[5 * 33]); o.w = pk2(s[6 * 33], s[7 * 33]);
        *(GAS v4u*)(I.WT + (size_t)(I.drow0 + n) * I.K + I.k0 + 8 * c) = o; }
    LDS_WAIT(); asm volatile("" ::: "memory");
}
__device__ __forceinline__ void p_convert(Frame& F, int layer) {
    LAS float* scr = (LAS float*)(F.lds + RING_OFF + F.wave * 16384);
    const int gw = F.vcu * NWAVES + F.wave, NGW = F.G * NWAVES;
    constexpr int I13 = (D / 64) * (2 * FF / 32), I2 = (FF / 64) * (D / 32), IIN = (D / 64) * (WIN / 32), IBR = (MIXW / 64) * (D / 32), IOUT = (D / 64) * (D / 32);
    constexpr int NITEMS = 2 * I13 + 2 * I2 + IIN + 3 * IBR + IOUT;
    const float* pw13 = IP_W13; const float* pw2 = IP_W2; const float* pwin = IP_WIN; const float* pwbr = IP_WBR; const float* pwout = IP_WOUT;
    auto decode = [&](int it) -> CvtItem {
        int r = it;
        if (r < 2 * I13) { const int f = r / I13; r -= f * I13; const int nblk = 2 * FF / 32, kb = r / nblk, nb = r - kb * nblk; const int n0 = 32 * nb;
            const int half = n0 >= FF ? 1 : 0, nn = n0 - half * FF; const int drow0 = 256 * (nn >> 7) + 128 * half + (nn & 127);
            return CvtItem{pw13 + (size_t)(layer * 2 + f) * D * 2 * FF, W_W13T + (size_t)f * 2 * FF * D, D, 2 * FF, 64 * kb, n0, drow0}; }
        r -= 2 * I13;
        if (r < 2 * I2) { const int f = r / I2; r -= f * I2; const int nblk = D / 32, kb = r / nblk, nb = r - kb * nblk;
            return CvtItem{pw2 + (size_t)(layer * 2 + f) * FF * D, W_W2T + (size_t)f * D * FF, FF, D, 64 * kb, 32 * nb, 32 * nb}; }
        r -= 2 * I2;
        if (r < IIN) { const int nblk = WIN / 32, kb = r / nblk, nb = r - kb * nblk;
            return CvtItem{pwin + (size_t)layer * D * WIN, W_WINT, D, WIN, 64 * kb, 32 * nb, 32 * nb}; }
        r -= IIN;
        if (r < 3 * IBR) { const int f = r / IBR; r -= f * IBR; const int nblk = D / 32, kb = r / nblk, nb = r - kb * nblk;
            return CvtItem{pwbr + (size_t)(layer * 3 + f) * MIXW * D, W_WBT + (size_t)f * D * MIXW, MIXW, D, 64 * kb, 32 * nb, 32 * nb}; }
        r -= 3 * IBR;
        { const int nblk = D / 32, kb = r / nblk, nb = r - kb * nblk;
            return CvtItem{pwout + (size_t)layer * D * D, W_WOT, D, D, 64 * kb, 32 * nb, 32 * nb}; }
    };
    int it = gw;
    if (it < NITEMS) {
        CvtItem cur = decode(it); f32x4 t[8]; cvt_issue(cur, t, F.lane);
#pragma unroll 1
        for (;;) {
            const int nit = it + NGW; const bool has = nit < NITEMS;
            CvtItem nxt = cur; f32x4 u[8];
            if (has) { nxt = decode(nit); cvt_issue(nxt, u, F.lane); }
            cvt_finish(cur, t, scr, F.lane);
            if (!has) break;
            cur = nxt; it = nit;
#pragma unroll
            for (int i = 0; i < 8; ++i) t[i] = u[i];
        }
    }
    __syncthreads();
}

__device__ __forceinline__ void load_row(f32x4* v, const float* src32, const bf16* src16, int lane) {
    if (src32) { const GAS f32x4* xr = (const GAS f32x4*)src32 + lane;
#pragma unroll
        for (int j = 0; j < 8; ++j) v[j] = xr[64 * j]; }
    else { const GAS v2u* xr = (const GAS v2u*)src16 + lane;
#pragma unroll
        for (int j = 0; j < 8; ++j) { const v2u w = xr[64 * j]; v[j] = (f32x4){bflo(w.x), bfhi(w.x), bflo(w.y), bfhi(w.y)}; } }
}
__device__ __forceinline__ void p_norm(Frame& F, const float* lat32, const float* ctx32, const float* nw, const float* modl, int which, int nrows, int npart) {
    const int gw = F.vcu * NWAVES + F.wave, NGW = F.G * NWAVES;
    for (int row0 = gw; row0 < nrows; row0 += 2 * NGW) {
        const int row1 = row0 + NGW; const bool has1 = row1 < nrows;
        f32x4 v[2][8];
#pragma unroll
        for (int k = 0; k < 2; ++k) { const int row = k ? row1 : row0;
            if (k == 0 || has1) { const float* s32 = row < NLAT ? lat32 : ctx32; if (s32) s32 += (size_t)(row < NLAT ? row : row - NLAT) * D;
                load_row(v[k], s32, W_H16 + (size_t)row * D, F.lane); } }
#pragma unroll
        for (int k = 0; k < 2; ++k) { const int row = k ? row1 : row0;
            if (k == 1 && !has1) break;
            const int g = row < SEQ ? 0 : (row < NLAT ? 1 : 2);
            const float* shift = modl + (size_t)g * MODW + (3 * which) * D; const float* scale = shift + D;
            if (row >= NLAT && npart > 0) {
                for (int p = 0; p < npart; ++p) { const GAS f32x4* pr = (const GAS f32x4*)(W_PART + ((size_t)p * 512 + (row - NLAT)) * D) + F.lane;
#pragma unroll
                    for (int j = 0; j < 8; ++j) v[k][j] = v[k][j] + pr[64 * j]; }
                GAS v2u* hw = (GAS v2u*)(W_H16 + (size_t)row * D) + F.lane;
#pragma unroll
                for (int j = 0; j < 8; ++j) { v2u w; w.x = pk2(v[k][j].x, v[k][j].y); w.y = pk2(v[k][j].z, v[k][j].w); hw[64 * j] = w;
                    v[k][j] = (f32x4){bflo(w.x), bfhi(w.x), bflo(w.y), bfhi(w.y)}; }
            }
            float s = 0.f;
#pragma unroll
            for (int j = 0; j < 8; ++j) s += (v[k][j].x * v[k][j].x + v[k][j].y * v[k][j].y) + (v[k][j].z * v[k][j].z + v[k][j].w * v[k][j].w);
            const float rstd = __builtin_amdgcn_rsqf(wave_sum(s) * (1.f / D) + EPS);
            GAS v2u* o8 = (GAS v2u*)(W_XN + (size_t)row * D) + F.lane;
#pragma unroll
            for (int j = 0; j < 8; ++j) { const int c = 4 * (F.lane + 64 * j);
                const f32x4 wv = *(const f32x4*)(nw + c), sc = *(const f32x4*)(scale + c), sh = *(const f32x4*)(shift + c);
                const f32x4 y = (v[k][j] * rstd) * wv * (sc + 1.0f) + sh;
                v2u w; w.x = pk2(y.x, y.y); w.y = pk2(y.z, y.w); o8[64 * j] = w; }
        }
    }
}
__device__ __forceinline__ void p_final(Frame& F) {
    const int gw = F.vcu * NWAVES + F.wave, NGW = F.G * NWAVES; const float* fnw = IP_FNW;
    for (int row = gw; row < NLAT; row += NGW) {
        f32x4 v[8]; float s = 0.f; load_row(v, nullptr, W_H16 + (size_t)row * D, F.lane);
#pragma unroll
        for (int j = 0; j < 8; ++j) s += (v[j].x * v[j].x + v[j].y * v[j].y) + (v[j].z * v[j].z + v[j].w * v[j].w);
        const float rstd = __builtin_amdgcn_rsqf(wave_sum(s) * (1.f / D) + EPS);
        GAS f32x4* xr = (GAS f32x4*)(F.out + (size_t)row * D) + F.lane;
#pragma unroll
        for (int j = 0; j < 8; ++j) { const int c = 4 * (F.lane + 64 * j); const f32x4 wv = *(const f32x4*)(fnw + c); xr[64 * j] = (v[j] * rstd) * wv; }
    }
}

constexpr float QSCALE = 0.125f * 1.4426950408889634f;
__device__ __forceinline__ void p_rope(Frame& F, int layer) {
    const int gw = F.vcu * NWAVES + F.wave, NGW = F.G * NWAVES;
    const int nrows = layer == 0 ? MTOT : NLAT;
    for (int row = gw; row < nrows; row += NGW) {
        const int t = row & (SEQ - 1), prow = t >> 6, pcol = t & 63;
        bf16* base = W_PROJ + (size_t)row * WIN + C_AQ;
        if (row >= NLAT) {
#pragma unroll
            for (int s = 0; s < 2; ++s) { bf16* pa = base + 8 * (F.lane + 64 * s); const v4u xa = *(const v4u*)pa; v4u wa;
                wa.x = pk2(bflo(xa.x) * QSCALE, bfhi(xa.x) * QSCALE); wa.y = pk2(bflo(xa.y) * QSCALE, bfhi(xa.y) * QSCALE); wa.z = pk2(bflo(xa.z) * QSCALE, bfhi(xa.z) * QSCALE); wa.w = pk2(bflo(xa.w) * QSCALE, bfhi(xa.w) * QSCALE);
                *(v4u*)pa = wa; }
            continue;
        }
#pragma unroll
        for (int s = 0; s < 2; ++s) {
            const int item = F.lane + 64 * s, grp = item >> 1, half = item & 1;
            bf16* pa = base + grp * 32 + 8 * half; bf16* pb = pa + 16;
            const v4u xa = *(const v4u*)pa, xb = *(const v4u*)pb;
            const float pos = (float)((grp & 1) ? pcol : prow);
            const float osc = grp < 32 ? QSCALE : 1.0f;
            float a[8], b[8];
            a[0] = bflo(xa.x); a[1] = bfhi(xa.x); a[2] = bflo(xa.y); a[3] = bfhi(xa.y); a[4] = bflo(xa.z); a[5] = bfhi(xa.z); a[6] = bflo(xa.w); a[7] = bfhi(xa.w);
            b[0] = bflo(xb.x); b[1] = bfhi(xb.x); b[2] = bflo(xb.y); b[3] = bfhi(xb.y); b[4] = bflo(xb.z); b[5] = bfhi(xb.z); b[6] = bflo(xb.w); b[7] = bfhi(xb.w);
            float oa[8], ob[8];
#pragma unroll
            for (int e = 0; e < 8; ++e) { const int d = 8 * half + e;
                const float invf = exp2f(-(float)d * (13.287712379549449f / 16.0f));
                const float rev = pos * invf * 0.15915494309189535f;
                const float fr = rev - floorf(rev);
                const float sn = __builtin_amdgcn_sinf(fr) * osc, cs = __builtin_amdgcn_cosf(fr) * osc;
                oa[e] = a[e] * cs - b[e] * sn; ob[e] = b[e] * cs + a[e] * sn; }
            v4u wa, wb;
            wa.x = pk2(oa[0], oa[1]); wa.y = pk2(oa[2], oa[3]); wa.z = pk2(oa[4], oa[5]); wa.w = pk2(oa[6], oa[7]);
            wb.x = pk2(ob[0], ob[1]); wb.y = pk2(ob[2], ob[3]); wb.z = pk2(ob[4], ob[5]); wb.w = pk2(ob[6], ob[7]);
            *(v4u*)pa = wa; *(v4u*)pb = wb;
        }
    }
}

constexpr float LOG2E_F = 1.4426950408889634f, HG_CLAMP2 = 80.f * 1.4426950408889634f;
__device__ __forceinline__ void hg_gate(float z, float lb, float& l2f, float& kv) {
    const float e = __builtin_amdgcn_exp2f(-fabsf(z) * LOG2E_F), r = __builtin_amdgcn_rcpf(1.0f + e), er = e * r;
    const bool pos = z >= 0.f, haslb = lb > 0.f;
    const float sig = pos ? r : er, nsig = pos ? er : r, omlb = 1.0f - lb;
    kv = omlb * nsig;
    const float lg = __builtin_amdgcn_logf(haslb ? lb + omlb * sig : 1.0f + e);
    l2f = haslb ? lg : fminf(z, 0.f) * LOG2E_F - lg;
}
__device__ __forceinline__ int chunk_row(int b, int c) { return c < 4 ? NLAT + CTXL * b + 64 * c : SEQ * b + 64 * (c - 4); }
__device__ __forceinline__ void unpack16(const v4u a, const v4u b, float* o) {
    o[0] = bflo(a.x); o[1] = bfhi(a.x); o[2] = bflo(a.y); o[3] = bfhi(a.y); o[4] = bflo(a.z); o[5] = bfhi(a.z); o[6] = bflo(a.w); o[7] = bfhi(a.w);
    o[8] = bflo(b.x); o[9] = bfhi(b.x); o[10] = bflo(b.y); o[11] = bfhi(b.y); o[12] = bflo(b.z); o[13] = bfhi(b.z); o[14] = bflo(b.w); o[15] = bfhi(b.w);
}
__device__ __forceinline__ float scan_dpp(float x) {
    x += __builtin_bit_cast(float, __builtin_amdgcn_update_dpp(0, __builtin_bit_cast(int, x), 0x111, 0xf, 0xf, true));
    x += __builtin_bit_cast(float, __builtin_amdgcn_update_dpp(0, __builtin_bit_cast(int, x), 0x112, 0xf, 0xf, true));
    x += __builtin_bit_cast(float, __builtin_amdgcn_update_dpp(0, __builtin_bit_cast(int, x), 0x114, 0xf, 0xf, true));
    x += __builtin_bit_cast(float, __builtin_amdgcn_update_dpp(0, __builtin_bit_cast(int, x), 0x118, 0xf, 0xf, true));
    x += __builtin_bit_cast(float, __builtin_amdgcn_update_dpp(0, __builtin_bit_cast(int, x), 0x142, 0xa, 0xf, true));
    x += __builtin_bit_cast(float, __builtin_amdgcn_update_dpp(0, __builtin_bit_cast(int, x), 0x143, 0xc, 0xf, true));
    return x;
}
__device__ __forceinline__ void scan16(float* cum, int lane) {
    (void)lane;
#pragma unroll
    for (int e = 0; e < 16; ++e) cum[e] = scan_dpp(cum[e]);
}
__device__ __forceinline__ bf16x8 ldfrag(const LAS unsigned char* base, int row, int stride, int kbyte) { return *(const LAS bf16x8*)(base + row * stride + kbyte); }

__device__ __forceinline__ void fill_lb(Frame& F, LAS float* lbs, int layer) {
    const float* hlb = IP_HLB;
    for (int i = F.tid; i < 2048; i += NWAVES * 64) { const int dir = i >> 10, ch = i & 1023; float lb = 0.f;
        if (layer) lb = sigm_f(hlb[(dir * 2 + 1) * 1024 + ch] - hlb[(dir * 2 + 0) * 1024 + ch]);
        lbs[i] = lb; }
    __syncthreads();
}
constexpr int H_KT = 0, H_VT = 18432, H_ESC = 36864, H_SET = 37888, H_LB = 2 * H_SET;
__device__ __forceinline__ void p_h1(Frame& F, int layer, int nrep = 1) {
    LAS unsigned char* L = F.lds + RING_OFF;
    const int lane = F.lane, w = F.wave, fr = lane & 15, fq = lane >> 4;
    LAS float* lbs = (LAS float*)(L + H_LB); fill_lb(F, lbs, layer);
    int pbuf = 0;
    v4u nz0, nz1, nv0, nv1, nq0, nq1;
    auto unit_rowp = [&](int uu_) -> const bf16* { const int u_ = uu_ % (NSEQ * NCHUNK); const int s_ = u_ / NCHUNK, c_ = u_ - s_ * NCHUNK, b_ = s_ >> 4, dir_ = (s_ >> 3) & 1, h_ = s_ & 7;
        return W_PROJ + (size_t)(chunk_row(b_, c_) + (dir_ ? 63 - lane : lane)) * WIN + 128 * h_ + 16 * w; };
#define H1_REQ(uu_) do { const bf16* rp = unit_rowp(uu_); const int s_ = ((uu_) % (NSEQ * NCHUNK)) / NCHUNK, dir_ = (s_ >> 3) & 1; const int zc = dir_ ? C_HB : C_HF; \
        nz0 = *(const v4u*)(rp + zc); nz1 = *(const v4u*)(rp + zc + 8); nv0 = *(const v4u*)(rp + C_HI); nv1 = *(const v4u*)(rp + C_HI + 8); nq0 = *(const v4u*)(rp + C_HQ); nq1 = *(const v4u*)(rp + C_HQ + 8); } while (0)
    if (F.bx < NSEQ * NCHUNK * nrep) H1_REQ(F.bx);
    for (int uu = F.bx; uu < NSEQ * NCHUNK * nrep; uu += F.G) {
        const int u = uu % (NSEQ * NCHUNK);
        const int s = u / NCHUNK, dir = (s >> 3) & 1;
        const int tok = dir ? 63 - lane : lane;
        LAS unsigned char* Ls = L + pbuf * H_SET; pbuf ^= 1;
        LAS bf16* KT = (LAS bf16*)(Ls + H_KT); LAS bf16* VT = (LAS bf16*)(Ls + H_VT); LAS float* esc = (LAS float*)(Ls + H_ESC);
        const v4u z0 = nz0, z1 = nz1, v0 = nv0, v1 = nv1, q0 = nq0, q1 = nq1;
        if (uu + F.G < NSEQ * NCHUNK * nrep) H1_REQ(uu + F.G);
        float z[16], cum[16], kv[16], q[16]; unpack16(z0, z1, z); unpack16(q0, q1, q);
#pragma unroll
        for (int e = 0; e < 16; ++e) hg_gate(z[e], lbs[dir * 1024 + 128 * (s & 7) + 16 * w + e], cum[e], kv[e]);
        scan16(cum, lane);
        const unsigned vw[8] = {v0.x, v0.y, v0.z, v0.w, v1.x, v1.y, v1.z, v1.w};
        unsigned kp[8], qp[8];
        float mcm = 0.f, mce = 0.f;
#pragma unroll
        for (int i = 0; i < 8; ++i) { float ksv[2], qsv[2];
#pragma unroll
            for (int t = 0; t < 2; ++t) { const int e = 2 * i + t;
                const float cmid = __builtin_bit_cast(float, __builtin_amdgcn_readlane(__builtin_bit_cast(int, cum[e]), 31)), cend = __builtin_bit_cast(float, __builtin_amdgcn_readlane(__builtin_bit_cast(int, cum[e]), 63));
                const float dlt = cmid - cum[e];
                ksv[t] = kv[e] * __builtin_amdgcn_exp2f(fminf(dlt, HG_CLAMP2)); qsv[t] = q[e] * __builtin_amdgcn_exp2f(fminf(-dlt, HG_CLAMP2));
                mcm = lane == e ? cmid : mcm; mce = lane == e ? cend : mce; }
            kp[i] = pk2(ksv[0], ksv[1]); qp[i] = pk2(qsv[0], qsv[1]);
            KT[(16 * w + 2 * i) * 72 + tok] = (bf16)(kp[i] & 0xffffu); KT[(16 * w + 2 * i + 1) * 72 + tok] = (bf16)(kp[i] >> 16);
            VT[(16 * w + 2 * i) * 72 + tok] = (bf16)(vw[i] & 0xffffu); VT[(16 * w + 2 * i + 1) * 72 + tok] = (bf16)(vw[i] >> 16); }
        if (lane < 16) { esc[16 * w + lane] = __builtin_amdgcn_exp2f(mce - mcm); W_DEC[(size_t)u * 128 + 16 * w + lane] = __builtin_amdgcn_exp2f(mce); W_EMID[(size_t)u * 128 + 16 * w + lane] = __builtin_amdgcn_exp2f(mcm); }
        { bf16* kd = W_KS + ((size_t)u * 64 + tok) * 128 + 16 * w; bf16* qd = W_QS + ((size_t)u * 64 + tok) * 128 + 16 * w;
          *(v4u*)kd = (v4u){kp[0], kp[1], kp[2], kp[3]}; *(v4u*)(kd + 8) = (v4u){kp[4], kp[5], kp[6], kp[7]};
          *(v4u*)qd = (v4u){qp[0], qp[1], qp[2], qp[3]}; *(v4u*)(qd + 8) = (v4u){qp[4], qp[5], qp[6], qp[7]}; }
        __syncthreads();
        f32x4 acc[8];
#pragma unroll
        for (int nb = 0; nb < 8; ++nb) acc[nb] = (f32x4){0.f, 0.f, 0.f, 0.f};
#pragma unroll
        for (int ks = 0; ks < 2; ++ks) { const bf16x8 a = ldfrag((const LAS unsigned char*)KT, 16 * w + fr, 144, (32 * ks + 8 * fq) * 2);
#pragma unroll
            for (int nb = 0; nb < 8; ++nb) { const bf16x8 bb = ldfrag((const LAS unsigned char*)VT, 16 * nb + fr, 144, (32 * ks + 8 * fq) * 2);
                acc[nb] = __builtin_amdgcn_mfma_f32_16x16x32_bf16(a, bb, acc[nb], 0, 0, 0); } }
        const f32x4 e4 = *(const LAS f32x4*)(esc + 16 * w + 4 * fq);
        bf16* dst = W_ST + (size_t)u * 16384 + 16 * w + 4 * fq;
#pragma unroll
        for (int nb = 0; nb < 8; ++nb) { const f32x4 val = acc[nb] * e4; v2u o; o.x = pk2(val[0], val[1]); o.y = pk2(val[2], val[3]); *(v2u*)(dst + (size_t)(16 * nb + fr) * 128) = o; }
    }
#undef H1_REQ
    __syncthreads();
}

__device__ __forceinline__ void p_h2(Frame& F) {
    for (int unit = F.bx; unit < NSEQ * 8; unit += F.G) {
        const int s = unit >> 3, slice = unit & 7, dir = (s >> 3) & 1;
        const int e0 = slice * 2048 + 4 * F.tid, dk0 = e0 & 127;
        float S[4] = {0.f, 0.f, 0.f, 0.f};
        for (int st = 0; st < NCHUNK; st += 4) {
            v2u uu[4]; f32x4 dd[4], em[4]; bf16* pp[4];
#pragma unroll
            for (int i = 0; i < 4; ++i) { const int step = st + i; const int c = dir == 0 ? step : (step < 4 ? 3 - step : 135 - step); const size_t u = (size_t)s * NCHUNK + c;
                pp[i] = W_ST + u * 16384 + e0; uu[i] = *(const v2u*)pp[i]; dd[i] = *(const f32x4*)(W_DEC + u * 128 + dk0); em[i] = *(const f32x4*)(W_EMID + u * 128 + dk0); }
#pragma unroll
            for (int i = 0; i < 4; ++i) { v2u o; o.x = pk2(S[0] * em[i][0], S[1] * em[i][1]); o.y = pk2(S[2] * em[i][2], S[3] * em[i][3]); *(v2u*)pp[i] = o;
                S[0] = dd[i][0] * S[0] + bflo(uu[i].x); S[1] = dd[i][1] * S[1] + bfhi(uu[i].x); S[2] = dd[i][2] * S[2] + bflo(uu[i].y); S[3] = dd[i][3] * S[3] + bfhi(uu[i].y); }
        }
    }
}

constexpr int H3_QK = 0, H3_QKSET = 34816, H3_VT = 69632, H3_P = 88064, H3_SS = 97280;
__device__ __forceinline__ void p_h3(Frame& F, int layer) {
    LAS unsigned char* L = F.lds + RING_OFF;
    LAS bf16* VT = (LAS bf16*)(L + H3_VT); LAS bf16* Ps = (LAS bf16*)(L + H3_P); LAS float* ssq = (LAS float*)(L + H3_SS);
    const int lane = F.lane, w = F.wave, fr = lane & 15, fq = lane >> 4;
    const float* hnw = IP_HNW;
    const int c_lo = layer ? 4 : 0, ncpb = NCHUNK - c_lo;
    const int nunits = 16 * ncpb;
    v4u nq[2], nk[2], ns[4], nv0, nv1;
    auto h1unit = [&](int u_, int dir_) -> size_t { const int bh_ = u_ / ncpb, c_ = c_lo + (u_ - bh_ * ncpb), b_ = bh_ >> 3, h_ = bh_ & 7; return ((size_t)((b_ * 2 + dir_) * 8 + h_)) * NCHUNK + c_; };
#define H3_REQ(u_, dir_) do { const size_t us_ = h1unit(u_, dir_); const bf16* qp_ = W_QS + us_ * 8192 + 8 * F.tid; const bf16* kp_ = W_KS + us_ * 8192 + 8 * F.tid; \
        nq[0] = *(const v4u*)qp_; nq[1] = *(const v4u*)(qp_ + 4096); nk[0] = *(const v4u*)kp_; nk[1] = *(const v4u*)(kp_ + 4096); \
        const bf16* sp_ = W_ST + us_ * 16384 + (16 * w + fr) * 128 + 8 * fq; \
        ns[0] = *(const v4u*)sp_; ns[1] = *(const v4u*)(sp_ + 32); ns[2] = *(const v4u*)(sp_ + 64); ns[3] = *(const v4u*)(sp_ + 96); } while (0)
#define H3_REQV(u_) do { const int bh_ = (u_) / ncpb, c_ = c_lo + ((u_) - bh_ * ncpb), b_ = bh_ >> 3, h_ = bh_ & 7; \
        const bf16* vp_ = W_PROJ + (size_t)(chunk_row(b_, c_) + lane) * WIN + C_HI + 128 * h_ + 16 * w; nv0 = *(const v4u*)vp_; nv1 = *(const v4u*)(vp_ + 8); } while (0)
    if (F.bx < nunits) { H3_REQ(F.bx, 0); H3_REQV(F.bx); }
    int pbuf = 0;
    for (int u = F.bx; u < nunits; u += F.G) {
        const int bh = u / ncpb, c = c_lo + (u - bh * ncpb), b = bh >> 3, h = bh & 7;
        const int rb = chunk_row(b, c), ch0 = 128 * h + 16 * w;
        f32x4 acc[4];
#pragma unroll
        for (int tb = 0; tb < 4; ++tb) acc[tb] = (f32x4){0.f, 0.f, 0.f, 0.f};
        v2u gv[4];
#pragma unroll 1
        for (int dir = 0; dir < 2; ++dir) {
            LAS bf16* Qs = (LAS bf16*)(L + H3_QK + pbuf * H3_QKSET); LAS bf16* Ks = Qs + 64 * 136; pbuf ^= 1;
            const v4u sv0 = ns[0], sv1 = ns[1], sv2 = ns[2], sv3 = ns[3];
#pragma unroll
            for (int j = 0; j < 2; ++j) { const int pc = F.tid + 512 * j; *(LAS v4u*)(Qs + (pc >> 4) * 136 + 8 * (pc & 15)) = nq[j]; *(LAS v4u*)(Ks + (pc >> 4) * 136 + 8 * (pc & 15)) = nk[j]; }
            if (dir == 0) {
                const unsigned ww[8] = {nv0.x, nv0.y, nv0.z, nv0.w, nv1.x, nv1.y, nv1.z, nv1.w};
#pragma unroll
                for (int e = 0; e < 8; ++e) { VT[(16 * w + 2 * e) * 72 + lane] = (bf16)(ww[e] & 0xffffu); VT[(16 * w + 2 * e + 1) * 72 + lane] = (bf16)(ww[e] >> 16); }
            } else {
#pragma unroll
                for (int tb = 0; tb < 4; ++tb) gv[tb] = *(const v2u*)(W_PROJ + (size_t)(rb + 16 * tb + fr) * WIN + C_HG + ch0 + 4 * fq);
            }
            __syncthreads();
            { const int nu = dir ? u + F.G : u, nd = dir ^ 1;
              if (nu < nunits) { H3_REQ(nu, nd); if (dir) H3_REQV(nu); } }
#pragma unroll
            for (int bi = 0; bi < 2; ++bi) { const int blk = 2 * w + bi, I = blk >> 2, J = blk & 3;
                f32x4 pacc = (f32x4){0.f, 0.f, 0.f, 0.f};
                const bool need = dir == 0 ? (J <= I) : (J >= I);
                if (need) {
#pragma unroll
                    for (int ks4 = 0; ks4 < 4; ++ks4) { const bf16x8 a = ldfrag((const LAS unsigned char*)Ks, 16 * J + fr, 272, (32 * ks4 + 8 * fq) * 2), bb = ldfrag((const LAS unsigned char*)Qs, 16 * I + fr, 272, (32 * ks4 + 8 * fq) * 2);
                        pacc = __builtin_amdgcn_mfma_f32_16x16x32_bf16(a, bb, pacc, 0, 0, 0); }
                    if (I == J) {
#pragma unroll
                        for (int r = 0; r < 4; ++r) { const int jj = 4 * fq + r; const bool keep = dir == 0 ? (jj <= fr) : (jj >= fr); if (!keep) pacc[r] = 0.f; } }
                }
                v2u o; o.x = pk2(pacc[0], pacc[1]); o.y = pk2(pacc[2], pacc[3]);
                *(LAS v2u*)(Ps + (16 * I + fr) * 72 + 16 * J + 4 * fq) = o; }
            __syncthreads();
#pragma unroll
            for (int ks2 = 0; ks2 < 2; ++ks2) { const bf16x8 a = ldfrag((const LAS unsigned char*)VT, 16 * w + fr, 144, (32 * ks2 + 8 * fq) * 2);
#pragma unroll
                for (int tb = 0; tb < 4; ++tb) { const bf16x8 bb = ldfrag((const LAS unsigned char*)Ps, 16 * tb + fr, 144, (32 * ks2 + 8 * fq) * 2);
                    acc[tb] = __builtin_amdgcn_mfma_f32_16x16x32_bf16(a, bb, acc[tb], 0, 0, 0); } }
#pragma unroll
            for (int ks4 = 0; ks4 < 4; ++ks4) { const v4u sraw = ks4 == 0 ? sv0 : ks4 == 1 ? sv1 : ks4 == 2 ? sv2 : sv3; const bf16x8 a = __builtin_bit_cast(bf16x8, sraw);
#pragma unroll
                for (int tb = 0; tb < 4; ++tb) { const bf16x8 bb = ldfrag((const LAS unsigned char*)Qs, 16 * tb + fr, 272, (32 * ks4 + 8 * fq) * 2);
                    acc[tb] = __builtin_amdgcn_mfma_f32_16x16x32_bf16(a, bb, acc[tb], 0, 0, 0); } }
        }
#pragma unroll
        for (int tb = 0; tb < 4; ++tb) { float p = (acc[tb][0] * acc[tb][0] + acc[tb][1] * acc[tb][1]) + (acc[tb][2] * acc[tb][2] + acc[tb][3] * acc[tb][3]);
            p += __shfl_xor(p, 16); p += __shfl_xor(p, 32);
            if (fq == 0) ssq[w * 64 + 16 * tb + fr] = p; }
        __syncthreads();
        const f32x4 nwv = *(const f32x4*)(hnw + layer * 128 + 16 * w + 4 * fq);
#pragma unroll
        for (int tb = 0; tb < 4; ++tb) { const int tk = 16 * tb + fr; float tot = 0.f;
#pragma unroll
            for (int ww = 0; ww < 8; ++ww) tot += ssq[ww * 64 + tk];
            const float rstd = __builtin_amdgcn_rsqf(tot * (1.f / 128.f) + EPS);
            const size_t row = (size_t)(rb + tk);
            const float y0 = acc[tb][0] * rstd * nwv[0] * silu_f(bflo(gv[tb].x)), y1 = acc[tb][1] * rstd * nwv[1] * silu_f(bfhi(gv[tb].x));
            const float y2 = acc[tb][2] * rstd * nwv[2] * silu_f(bflo(gv[tb].y)), y3 = acc[tb][3] * rstd * nwv[3] * silu_f(bfhi(gv[tb].y));
            v2u o; o.x = pk2(y0, y1); o.y = pk2(y2, y3);
            *(v2u*)(W_BR + row * MIXW + ch0 + 4 * fq) = o; }
    }
#undef H3_REQ
#undef H3_REQV
    __syncthreads();
}

__device__ __forceinline__ void p_pm(Frame& F, int layer, int nrows) {
    const int gw = F.vcu * NWAVES + F.wave, NGW = F.G * NWAVES, lane = F.lane;
    const float lam_init = 0.8f - 0.6f * expf(-0.3f * (float)layer);
    float lam;
    { const float* lp = IP_LAM + layer * 256; const float s1 = wave_sum(lp[lane] * lp[64 + lane]), s2 = wave_sum(lp[128 + lane] * lp[192 + lane]); lam = expf(s1) - expf(s2) + lam_init; }
    const float* cw = IP_CONVW + (size_t)layer * 3 * MIXW; const float* danw = IP_DANW;
    bf16* B1 = W_BR + (size_t)MTOT * MIXW; bf16* B2 = W_BR + (size_t)2 * MTOT * MIXW;
    const bf16* O0 = W_OP; const bf16* O1 = W_OP + (size_t)MTOT * MIXW;
    for (int row = gw; row < nrows; row += NGW) {
        int pos, len; if (row < NLAT) { pos = row & (SEQ - 1); len = SEQ; } else { pos = (row - NLAT) & (CTXL - 1); len = CTXL; }
        const bool hasp = pos > 0, hasn = pos < len - 1;
        const bf16* pr = W_PROJ + (size_t)row * WIN;
#pragma unroll
        for (int s = 0; s < 2; ++s) {
            const int c0 = 512 * s + 8 * lane;
            float cbv[8], pm[8], pc[8], pn[8];
            { const v4u a = *(const v4u*)(pr + C_CB + c0); cbv[0] = bflo(a.x); cbv[1] = bfhi(a.x); cbv[2] = bflo(a.y); cbv[3] = bfhi(a.y); cbv[4] = bflo(a.z); cbv[5] = bfhi(a.z); cbv[6] = bflo(a.w); cbv[7] = bfhi(a.w); }
#define LDPROD(dst, rp) do { const v4u a_ = *(const v4u*)((rp) + C_CC + c0), b_ = *(const v4u*)((rp) + C_CU + c0); \
            dst[0] = bflo(a_.x) * bflo(b_.x); dst[1] = bfhi(a_.x) * bfhi(b_.x); dst[2] = bflo(a_.y) * bflo(b_.y); dst[3] = bfhi(a_.y) * bfhi(b_.y); \
            dst[4] = bflo(a_.z) * bflo(b_.z); dst[5] = bfhi(a_.z) * bfhi(b_.z); dst[6] = bflo(a_.w) * bflo(b_.w); dst[7] = bfhi(a_.w) * bfhi(b_.w); } while (0)
            LDPROD(pc, pr);
            if (hasp) { LDPROD(pm, pr - WIN); } else {
#pragma unroll
                for (int e = 0; e < 8; ++e) pm[e] = 0.f; }
            if (hasn) { LDPROD(pn, pr + WIN); } else {
#pragma unroll
                for (int e = 0; e < 8; ++e) pn[e] = 0.f; }
#undef LDPROD
            float yb[8];
#pragma unroll
            for (int e = 0; e < 8; ++e) yb[e] = cbv[e] * (cw[c0 + e] * pm[e] + cw[MIXW + c0 + e] * pc[e] + cw[2 * MIXW + c0 + e] * pn[e]);
            { v4u o; o.x = pk2(yb[0], yb[1]); o.y = pk2(yb[2], yb[3]); o.z = pk2(yb[4], yb[5]); o.w = pk2(yb[6], yb[7]); *(v4u*)(B1 + (size_t)row * MIXW + c0) = o; }
            float dd[8];
            { const v4u a = *(const v4u*)(O0 + (size_t)row * MIXW + c0), b2 = *(const v4u*)(O1 + (size_t)row * MIXW + c0);
              dd[0] = bflo(a.x) - lam * bflo(b2.x); dd[1] = bfhi(a.x) - lam * bfhi(b2.x); dd[2] = bflo(a.y) - lam * bflo(b2.y); dd[3] = bfhi(a.y) - lam * bfhi(b2.y);
              dd[4] = bflo(a.z) - lam * bflo(b2.z); dd[5] = bfhi(a.z) - lam * bfhi(b2.z); dd[6] = bflo(a.w) - lam * bflo(b2.w); dd[7] = bfhi(a.w) - lam * bfhi(b2.w); }
            float ss = 0.f;
#pragma unroll
            for (int e = 0; e < 8; ++e) ss += dd[e] * dd[e];
            ss += __shfl_xor(ss, 1); ss += __shfl_xor(ss, 2); ss += __shfl_xor(ss, 4); ss += __shfl_xor(ss, 8);
            const float rstd = __builtin_amdgcn_rsqf(ss * (1.f / 128.f) + EPS) * (1.0f - lam_init);
            const float* dn = danw + layer * 128 + ((8 * lane) & 127);
            float yc[8];
#pragma unroll
            for (int e = 0; e < 8; ++e) yc[e] = dd[e] * rstd * dn[e];
            { v4u o; o.x = pk2(yc[0], yc[1]); o.y = pk2(yc[2], yc[3]); o.z = pk2(yc[4], yc[5]); o.w = pk2(yc[6], yc[7]); *(v4u*)(B2 + (size_t)row * MIXW + c0) = o; }
        }
    }
}

__device__ __forceinline__ void p_attn(Frame& F, int layer, char* ldsg) {
    const int nunits = 1024 + (layer == 0 ? 32 : 0);
    for (int id = F.vcu; id < nunits; id += F.G) {
        if (id < 1024) { const int qb = id & 31, p = (id >> 5) & 1, h = (id >> 6) & 7, b = id >> 9;
            att::attn_unit(W_PROJ, SEQ * b + 256 * qb, NLAT + CTXL * b, SEQ * b, NCHUNK, h, p, W_OP + (size_t)p * MTOT * MIXW, ldsg); }
        else { const int j = id - 1024, p = j & 1, h = (j >> 1) & 7, b = j >> 4;
            att::attn_unit(W_PROJ, NLAT + CTXL * b, NLAT + CTXL * b, SEQ * b, 4, h, p, W_OP + (size_t)p * MTOT * MIXW, ldsg); }
    }
}

struct Args { const float* in[18]; float* out; unsigned char* ws; int ph_lo, ph_hi, li, pad; };
__global__ void __launch_bounds__(NWAVES * 64, 2) mk_fwd(Args args) {
    extern __shared__ __attribute__((aligned(16))) unsigned char lds[];
    Frame F;
    F.lds = (LAS unsigned char*)lds;
    F.MISC = (volatile LAS unsigned*)(F.lds + MISC_OFF);
    F.tid = threadIdx.x; F.lane = F.tid & 63; F.wave = __builtin_amdgcn_readfirstlane(F.tid >> 6);
    F.G = gridDim.x; F.bx = blockIdx.x; { const int bx = blockIdx.x; F.vcu = (F.G % 8 == 0) ? (bx % 8) * (F.G / 8) + bx / 8 : bx; }
    F.ws = args.ws; F.out = args.out;
    F.ctl = (gu32*)(F.ws + WS_CTL);
    for (int u = F.tid; u < (LDS_BYTES - LDSCTL_OFF) / 4; u += NWAVES * 64) ((LAS unsigned*)(F.lds + LDSCTL_OFF))[u] = 0u;
    __syncthreads();
    XcdBarrier bar; bar.bar = (unsigned*)(F.ctl + CW_BAR) + args.li * XCD_BAR_WORDS; bar.x = 0; bar.st = nullptr;
    if (MK_N_LAUNCHES == 1) bar = xcd_barrier_post((unsigned*)(F.ctl + CW_BAR), F.MISC + 8);
    const int lo = args.ph_lo, hi = args.ph_hi;
#ifndef PHMASK
#define PHMASK 0x7fff
#endif
#define PON(b) (((PHMASK) >> (b)) & 1)
#define IN(k) (lo <= (k) && (k) < hi)
#ifndef PROBE_PH
#define PROBE_PH -1
#define PROBE_REP 0
#endif
#define PHASE(cond, id) if (cond) _Pragma("unroll 1") for (int rep_ = 0, nrep_ = ((id) == PROBE_PH ? 1 + PROBE_REP : 1); rep_ < nrep_; ++rep_) { Frame P_ = F; launder(P_); { Frame& F = P_; (void)F;
#define POUT(p, scr) ((rep_ < nrep_ - 1) ? (scr) : (p))
#define PHASE_END } }
#if defined(PROBE_TMASK)
    unsigned long long t_prev = __builtin_amdgcn_s_memrealtime(), t_acc = 0ull;
#define TSTAMP(id) do { const unsigned long long now_ = __builtin_amdgcn_s_memrealtime(); if (((PROBE_TMASK) >> (id)) & 1) t_acc += now_ - t_prev; t_prev = now_; } while (0)
#else
#define TSTAMP(id) do { } while (0)
#endif
#define SEAM(k) do { if (IN(k) && IN((k) + 1)) xcd_barrier(bar); } while (0)

    PHASE(PON(13) && IN(0), 13) p_ada(F); p_convert(F, 0); PHASE_END
    SEAM(0); TSTAMP(13);
    if (PROBE_PH == 200) { for (int q_ = 0; q_ < PROBE_REP; ++q_) xcd_barrier(bar); }

#pragma unroll 1
    for (int l = 0; l < 2; ++l) {
        const int pb = 1 + l * NPL;
        const float* modl = W_MOD + (size_t)l * 3 * MODW;
        const int Mm = (l == 1) ? NLAT : MTOT;
        const float* hl = (l == 0) ? IP_X : (const float*)nullptr; const float* hc = (l == 0) ? IP_CTX : (const float*)nullptr;
        PHASE(PON(0) && IN(pb + 0), 0) if (l == 1) p_convert(F, 1); p_norm(F, hl, hc, IP_NORMW + (size_t)(l * 3 + 0) * D, modl, 0, MTOT, l == 1 ? 11 : 0);  PHASE_END
        SEAM(pb + 0); TSTAMP(0);
        PHASE(PON(1) && IN(pb + 1), 1) pg8::Gemm g{W_XN, W_W13T, MTOT, 2 * FF, D}; pg8::StaticOrder S; S.init(MTOT, 2 * FF, F.G, F.bx);
            pg8::EpiSwiglu E{W_HID, FF}; pg8::gemm_phase<pg8::EpiSwiglu, pg8::StaticOrder, true, true>(F.lds + RING_OFF, g, S, E);  PHASE_END
        SEAM(pb + 1); TSTAMP(1);
        PHASE(PON(2) && IN(pb + 2), 2)
            { pg8::Gemm g{W_HID, W_W2T, NLAT, D, FF}; pg8::StaticOrder S; S.init(NLAT, D, F.G, F.bx, WGM_N8);
              pg8::EpiResid E{hl, W_H16, POUT(W_H16, (bf16*)W_Y32), modl + 2 * D, 0.5f, 0.f}; pg8::gemm_phase<pg8::EpiResid, pg8::StaticOrder, true, true>(F.lds + RING_OFF, g, S, E); }
            { pg8::Gemm g{W_HID + (size_t)NLAT * FF, W_W2T, NCTX, D, 512, FF}; pg8::SplitKOrder S; S.init(NCTX, D, 11, F.G, F.bx);
              pg8::EpiPartial E{W_PART, modl + 2 * MODW + 2 * D, 0.5f}; pg8::gemm_phase<pg8::EpiPartial, pg8::SplitKOrder, true, true>(F.lds + RING_OFF, g, S, E); }
         PHASE_END
        SEAM(pb + 2); TSTAMP(2);
        PHASE(PON(3) && IN(pb + 3), 3) p_norm(F, nullptr, hc, IP_NORMW + (size_t)(l * 3 + 1) * D, modl, 1, MTOT, 11); PHASE_END
        SEAM(pb + 3); TSTAMP(3);
        PHASE(PON(4) && IN(pb + 4), 4) pg8::Gemm g{W_XN, W_WINT, MTOT, WIN, D}; pg8::StaticOrder S; S.init(MTOT, WIN, F.G, F.bx);
            pg8::EpiStoreBf16 E{W_PROJ, WIN, C_AQ / 256, C_AV / 256, QSCALE, C_GA / 256}; pg8::gemm_phase<pg8::EpiStoreBf16, pg8::StaticOrder, true, true>(F.lds + RING_OFF, g, S, E); if (PROBE_PH == 104) { for (int q_ = 0; q_ < PROBE_REP; ++q_) p_h2(F); } PHASE_END
        SEAM(pb + 4); TSTAMP(4);
        PHASE(PON(5) && IN(pb + 5), 5) p_h1(F, l, (PROBE_PH == 105) ? 1 + PROBE_REP : 1);  PHASE_END
        SEAM(pb + 5); TSTAMP(5);
        PHASE(PON(6) && IN(pb + 6), 6) p_attn(F, l, (char*)lds + RING_OFF); if (rep_ == 0) p_h2(F);  PHASE_END
        SEAM(pb + 6); TSTAMP(6);
        PHASE(PON(7) && IN(pb + 7), 7) p_h3(F, l); p_pm(F, l, Mm);  PHASE_END
        SEAM(pb + 7); TSTAMP(7);
#if defined(PROBE_IDLE)
        { const unsigned long long t0_ = __builtin_amdgcn_s_memrealtime(); while (__builtin_amdgcn_s_memrealtime() - t0_ < (unsigned long long)(PROBE_IDLE)) __builtin_amdgcn_s_sleep(64); }
#endif
        PHASE(PON(8) && IN(pb + 8), 8)
            { pg8::Gemm g{W_BR, W_WBT, Mm, D, MIXW}; pg8::MergeOrder S; S.init(Mm, F.G, F.bx);
              pg8::EpiMergeChain E{W_PROJ + C_GA, WIN, W_XN}; pg8::gemm_phase<pg8::EpiMergeChain, pg8::MergeOrder, true, true>(F.lds + RING_OFF, g, S, E); }
         PHASE_END
        SEAM(pb + 8); TSTAMP(8);
        PHASE(PON(9) && IN(pb + 9), 9)
            { pg8::Gemm g{W_XN, W_WOT, NLAT, D, D}; pg8::StaticOrder S; S.init(NLAT, D, F.G, F.bx, WGM_N8);
              pg8::EpiResid E{nullptr, W_H16, POUT(W_H16, (bf16*)W_Y32), modl + 5 * D, 1.0f, 0.f}; pg8::gemm_phase<pg8::EpiResid, pg8::StaticOrder, true, true>(F.lds + RING_OFF, g, S, E); }
            if (l == 0) { pg8::Gemm g{W_XN + (size_t)NLAT * D, W_WOT, NCTX, D, 512, D}; pg8::SplitKOrder S; S.init(NCTX, D, 4, F.G, F.bx);
              pg8::EpiPartial E{W_PART, modl + 2 * MODW + 5 * D, 1.0f}; pg8::gemm_phase<pg8::EpiPartial, pg8::SplitKOrder, true, true>(F.lds + RING_OFF, g, S, E); }
         PHASE_END
        SEAM(pb + 9); TSTAMP(9);
        PHASE(PON(10) && IN(pb + 10), 10) p_norm(F, nullptr, nullptr, IP_NORMW + (size_t)(l * 3 + 2) * D, modl, 2, Mm, 4); PHASE_END
        SEAM(pb + 10); TSTAMP(10);
        PHASE(PON(11) && IN(pb + 11), 11) pg8::Gemm g{W_XN, W_W13T + (size_t)2 * FF * D, Mm, 2 * FF, D}; pg8::StaticOrder S; S.init(Mm, 2 * FF, F.G, F.bx);
            pg8::EpiSwiglu E{W_HID, FF}; pg8::gemm_phase<pg8::EpiSwiglu, pg8::StaticOrder, true, true>(F.lds + RING_OFF, g, S, E);  PHASE_END
        SEAM(pb + 11); TSTAMP(11);
        PHASE(PON(12) && IN(pb + 12), 12)
            { pg8::Gemm g{W_HID, W_W2T + (size_t)D * FF, NLAT, D, FF}; pg8::StaticOrder S; S.init(NLAT, D, F.G, F.bx, WGM_N8);
              pg8::EpiResid E{nullptr, W_H16, POUT(W_H16, (bf16*)W_Y32), modl + 8 * D, 0.5f, 0.f}; pg8::gemm_phase<pg8::EpiResid, pg8::StaticOrder, true, true>(F.lds + RING_OFF, g, S, E); }
            if (l == 0) { pg8::Gemm g{W_HID + (size_t)NLAT * FF, W_W2T + (size_t)D * FF, NCTX, D, 512, FF}; pg8::SplitKOrder S; S.init(NCTX, D, 11, F.G, F.bx);
              pg8::EpiPartial E{W_PART, modl + 2 * MODW + 8 * D, 0.5f}; pg8::gemm_phase<pg8::EpiPartial, pg8::SplitKOrder, true, true>(F.lds + RING_OFF, g, S, E); }
         PHASE_END
        SEAM(pb + 12); TSTAMP(12);
    }
    PHASE(PON(14) && IN(NPHASE - 1), 14) p_final(F); PHASE_END
#if defined(PROBE_TMASK)
    TSTAMP(14);
    if (blockIdx.x == 0) { const unsigned long long t0_ = __builtin_amdgcn_s_memrealtime(); while (__builtin_amdgcn_s_memrealtime() - t0_ < (unsigned long long)(PROBE_TMUL) * t_acc) __builtin_amdgcn_s_sleep(32); }
#endif

#undef IN
#undef SEAM
}

extern "C" void kernel_launch(void* const* d_in, const int* in_sizes, int n_in, void* d_out, int out_size, void* d_ws, size_t ws_size, hipStream_t stream) {
    static int grid = 0;
    if (grid == 0) {
        if (n_in != 18 || in_sizes[0] != NLAT * D || out_size != NLAT * D || ws_size < WS_END) { fprintf(stderr, "kernel_launch: shape/workspace mismatch (n_in %d, in0 %d, out %d, ws %zu, need %zu)\n", n_in, n_in > 0 ? in_sizes[0] : -1, out_size, ws_size, (size_t)WS_END); grid = -1; return; }
        int dev = 0, cus = 0, per_cu = 0;
        if (hipGetDevice(&dev) != hipSuccess || hipDeviceGetAttribute(&cus, hipDeviceAttributeMultiprocessorCount, dev) != hipSuccess) { grid = -1; return; }
        if (hipFuncSetAttribute((const void*)mk_fwd, hipFuncAttributeMaxDynamicSharedMemorySize, LDS_BYTES) != hipSuccess) { fprintf(stderr, "kernel_launch: hipFuncSetAttribute failed\n"); grid = -1; return; }
        if (hipOccupancyMaxActiveBlocksPerMultiprocessor(&per_cu, (const void*)mk_fwd, NWAVES * 64, LDS_BYTES) != hipSuccess || per_cu < 1) fprintf(stderr, "kernel_launch: occupancy query reports %d\n", per_cu);
        (void)hipGetLastError();
        grid = cus;
    }
    if (grid < 0) return;
    if (hipMemsetAsync((char*)d_ws + WS_CTL, 0, CTL_ZERO_BYTES, stream) != hipSuccess) return;
    Args a{};
    for (int i = 0; i < 18; ++i) a.in[i] = (const float*)d_in[i];
    a.out = (float*)d_out; a.ws = (unsigned char*)d_ws;
#if MK_N_LAUNCHES == 1
    a.ph_lo = 0; a.ph_hi = NPHASE; a.li = 0;
    hipLaunchKernelGGL(mk_fwd, dim3(grid), dim3(NWAVES * 64), LDS_BYTES, stream, a);
#else
    for (int ph = 0; ph < NPHASE; ++ph) { a.ph_lo = ph; a.ph_hi = ph + 1; a.li = 0; hipLaunchKernelGGL(mk_fwd, dim3(grid), dim3(NWAVES * 64), LDS_BYTES, stream, a); }
#endif
    const hipError_t le = hipPeekAtLastError();
    if (le != hipSuccess) fprintf(stderr, "kernel_launch: launch failed: %s\n", hipGetErrorName(le));
}
```

```cpp
#include <hip/hip_runtime.h>
#include <cstdio>
#include <cstdint>
#ifndef WGM_N8
#define WGM_N8 4
#endif
namespace pg8 {
#define PG8_LAS __attribute__((address_space(3)))
typedef unsigned short bf16_t;
typedef short bf16x8 __attribute__((ext_vector_type(8)));
typedef float f32x4 __attribute__((ext_vector_type(4)));
typedef unsigned u32x4 __attribute__((ext_vector_type(4)));
constexpr int BM = 256, BK = 64, HALF = 128, HTB = HALF * BK * 2  , STAGE_BYTES = 8 * HTB, NXCD = 8, WGM = 4;

__host__ __device__ __forceinline__ int lds_byte(int r, int c) { const int st = (r >> 4) * 2 + (c >> 5), rr = r & 15, cc = c & 31, ob = rr * 64 + cc * 2; return st * 1024 + (ob ^ (((ob >> 9) & 1) << 5)); }
__host__ __device__ __forceinline__ void stage_rc(int b, int& R, int& C) { const int st = b / 1024, sb = b % 1024, swz = sb ^ (((sb >> 9) & 1) << 5); R = (st >> 1) * 16 + swz / 64; C = (st & 1) * 32 + (swz % 64) / 2; }
__host__ __device__ __forceinline__ int perm32(int rho) { const int n = rho >> 4, i = rho & 15; return 8 * (i >> 2) + 4 * n + (i & 3); }

struct Unit { int pm, pn, pk; };
struct Gemm { const bf16_t* A; const bf16_t* Bt; int M, N, K; int ld; };

struct StaticOrder {
    int nM, nN, nwg, G, c, wgm;
    __host__ __device__ void init(int M, int N, int G_, int c_, int wgm_ = WGM) { nM = M / BM; nN = N / BM; nwg = nM * nN; G = G_; c = c_; wgm = wgm_; }
    __host__ __device__ bool next(int i, Unit& u) const {
        const long L = (long)i * G + c; if (L >= nwg) return false;
        int wgid = (int)L; { const int q = nwg / NXCD, r = nwg % NXCD, xcd = wgid % NXCD, off = wgid / NXCD; wgid = (xcd < r ? xcd * (q + 1) : r * (q + 1) + (xcd - r) * q) + off; }
        const int nig = wgm * nN, gid = wgid / nig, fm = gid * wgm, gsz = (nM - fm) < wgm ? (nM - fm) : wgm;
        u.pm = fm + ((wgid % nig) % gsz); u.pn = (wgid % nig) / gsz; u.pk = 0; return true;
    }
    __device__ __forceinline__ void a_ready(const Unit&) const {}
    __device__ __forceinline__ void done(const Unit&) const {}
};

typedef __bf16 cvbf2 __attribute__((ext_vector_type(2)));
typedef float cvf2 __attribute__((ext_vector_type(2)));
__device__ __forceinline__ unsigned cvt_pk_bf16(float lo, float hi) { const cvf2 v = {lo, hi}; return __builtin_bit_cast(unsigned, __builtin_convertvector(v, cvbf2)); }
__device__ __forceinline__ float silu_f(float x) { return x * __builtin_amdgcn_rcpf(1.0f + __builtin_amdgcn_exp2f(-1.4426950408889634f * x)); }
__device__ __forceinline__ float sigm_f(float x) { return __builtin_amdgcn_rcpf(1.0f + __builtin_amdgcn_exp2f(-1.4426950408889634f * x)); }
__device__ __forceinline__ float bfbits2f(unsigned short b) { return __uint_as_float(((unsigned)b) << 16); }
typedef unsigned u32x2 __attribute__((ext_vector_type(2)));
constexpr int MODW = 18432;
constexpr int NLAT = 16384;
constexpr int DM = 2048;

struct EpiStoreBf16 {
    static constexpr bool PERM = true, AFTER_DRAIN = false, CHAIN = false;
    bf16_t* O; int ldc; int rope_lo, rope_hi; float qscale; int gate_lo;
    __device__ __forceinline__ void operator()(const f32x4 (&acc)[2][2][4][2], const Unit& u, int wr, int wc, int fr, int fq) const {
        const int row0 = u.pm * BM + wr * 64 + fr; const int col0 = u.pn * BM + wc * 32 + 8 * fq;
        if (u.pn >= rope_lo && u.pn < rope_hi) {
            const bool isq = u.pn < (rope_lo + rope_hi) / 2, lat = u.pm < 64;
            const float osc = isq ? qscale : 1.0f, sgn = fq < 2 ? -1.0f : 1.0f;
            float invf[8];
#pragma unroll
            for (int e = 0; e < 8; ++e) invf[e] = exp2f(-(float)(8 * (fq & 1) + e) * (13.287712379549449f / 16.0f)) * 0.15915494309189535f;
#pragma unroll
            for (int ai = 0; ai < 2; ++ai)
#pragma unroll
                for (int m = 0; m < 4; ++m) { const int r = row0 + ai * HALF + m * 16; bf16_t* rowp = O + (size_t)r * ldc + col0;
                    const int t = r & 8191; const float pos = (float)((wc & 1) ? (t & 63) : (t >> 6));
                    float cs[8], sn[8];
#pragma unroll
                    for (int e = 0; e < 8; ++e) { const float rev = pos * invf[e], frc = rev - floorf(rev); cs[e] = lat ? __builtin_amdgcn_cosf(frc) * osc : osc; sn[e] = lat ? __builtin_amdgcn_sinf(frc) * osc * sgn : 0.f; }
#pragma unroll
                    for (int bj = 0; bj < 2; ++bj) { const f32x4 v0 = acc[ai][bj][m][0], v1 = acc[ai][bj][m][1];
                        float mine[8] = {v0[0], v0[1], v0[2], v0[3], v1[0], v1[1], v1[2], v1[3]}, outv[8];
#pragma unroll
                        for (int e = 0; e < 8; ++e) { const float other = __shfl_xor(mine[e], 32); outv[e] = mine[e] * cs[e] + other * sn[e]; }
                        u32x4 w; w.x = cvt_pk_bf16(outv[0], outv[1]); w.y = cvt_pk_bf16(outv[2], outv[3]); w.z = cvt_pk_bf16(outv[4], outv[5]); w.w = cvt_pk_bf16(outv[6], outv[7]);
                        *(u32x4*)(rowp + bj * HALF) = w; } }
            return;
        }
        const bool isg = u.pn >= gate_lo;
#pragma unroll
        for (int ai = 0; ai < 2; ++ai)
#pragma unroll
            for (int m = 0; m < 4; ++m) { bf16_t* rowp = O + (size_t)(row0 + ai * HALF + m * 16) * ldc + col0;
#pragma unroll
                for (int bj = 0; bj < 2; ++bj) { f32x4 v0 = acc[ai][bj][m][0], v1 = acc[ai][bj][m][1];
                    if (isg) {
#pragma unroll
                        for (int i = 0; i < 4; ++i) { v0[i] = sigm_f(v0[i]); v1[i] = sigm_f(v1[i]); } }
                    u32x4 w; w.x = cvt_pk_bf16(v0[0], v0[1]); w.y = cvt_pk_bf16(v0[2], v0[3]); w.z = cvt_pk_bf16(v1[0], v1[1]); w.w = cvt_pk_bf16(v1[2], v1[3]);
                    *(u32x4*)(rowp + bj * HALF) = w; } }
    }
};
struct EpiSwiglu {
    static constexpr bool PERM = true, AFTER_DRAIN = false, CHAIN = false;
    bf16_t* O; int ldc;
    __device__ __forceinline__ void operator()(const f32x4 (&acc)[2][2][4][2], const Unit& u, int wr, int wc, int fr, int fq) const {
        const int row0 = u.pm * BM + wr * 64 + fr; const int col0 = u.pn * HALF + wc * 32 + 8 * fq;
#pragma unroll
        for (int ai = 0; ai < 2; ++ai)
#pragma unroll
            for (int m = 0; m < 4; ++m) { bf16_t* rowp = O + (size_t)(row0 + ai * HALF + m * 16) * ldc + col0;
                const f32x4 g0 = acc[ai][0][m][0], g1 = acc[ai][0][m][1], u0 = acc[ai][1][m][0], u1 = acc[ai][1][m][1];
                float r[8];
#pragma unroll
                for (int i = 0; i < 4; ++i) { r[i] = silu_f(g0[i]) * u0[i]; r[4 + i] = silu_f(g1[i]) * u1[i]; }
                u32x4 w; w.x = cvt_pk_bf16(r[0], r[1]); w.y = cvt_pk_bf16(r[2], r[3]); w.z = cvt_pk_bf16(r[4], r[5]); w.w = cvt_pk_bf16(r[6], r[7]);
                *(u32x4*)rowp = w; }
    }
};
struct EpiResid {
    static constexpr bool PERM = true, AFTER_DRAIN = false, CHAIN = false;
    const float* base32; const bf16_t* base16; bf16_t* out; const float* coef; float mul, pad_;
    __device__ __forceinline__ void operator()(const f32x4 (&acc)[2][2][4][2], const Unit& u, int wr, int wc, int fr, int fq) const {
        const int g = u.pm < 32 ? 0 : 1;
        const int col0 = u.pn * BM + wc * 32 + 8 * fq;
        f32x4 cf[2][2];
#pragma unroll
        for (int bj = 0; bj < 2; ++bj)
#pragma unroll
            for (int n = 0; n < 2; ++n) cf[bj][n] = *(const f32x4*)(coef + (size_t)g * MODW + col0 + bj * HALF + 4 * n) * mul;
#pragma unroll
        for (int ai = 0; ai < 2; ++ai)
#pragma unroll
            for (int mp = 0; mp < 2; ++mp) {
                f32x4 pre[2][2][2];
                if (base32) {
#pragma unroll
                    for (int mm = 0; mm < 2; ++mm) { const int m = 2 * mp + mm; const size_t off = (size_t)(u.pm * BM + ai * HALF + wr * 64 + m * 16 + fr) * DM + col0;
#pragma unroll
                        for (int bj = 0; bj < 2; ++bj)
#pragma unroll
                            for (int n = 0; n < 2; ++n) pre[mm][bj][n] = *(const f32x4*)(base32 + off + bj * HALF + 4 * n); }
                } else {
                    u32x4 raw[2][2];
#pragma unroll
                    for (int mm = 0; mm < 2; ++mm) { const int m = 2 * mp + mm; const size_t off = (size_t)(u.pm * BM + ai * HALF + wr * 64 + m * 16 + fr) * DM + col0;
#pragma unroll
                        for (int bj = 0; bj < 2; ++bj) raw[mm][bj] = *(const u32x4*)(base16 + off + bj * HALF); }
#pragma unroll
                    for (int mm = 0; mm < 2; ++mm)
#pragma unroll
                        for (int bj = 0; bj < 2; ++bj) { const u32x4 w = raw[mm][bj];
                            pre[mm][bj][0] = (f32x4){__uint_as_float(w.x << 16), __uint_as_float(w.x & 0xffff0000u), __uint_as_float(w.y << 16), __uint_as_float(w.y & 0xffff0000u)};
                            pre[mm][bj][1] = (f32x4){__uint_as_float(w.z << 16), __uint_as_float(w.z & 0xffff0000u), __uint_as_float(w.w << 16), __uint_as_float(w.w & 0xffff0000u)}; }
                }
                asm volatile("" ::: "memory");
#pragma unroll
                for (int mm = 0; mm < 2; ++mm) { const int m = 2 * mp + mm; const size_t off = (size_t)(u.pm * BM + ai * HALF + wr * 64 + m * 16 + fr) * DM + col0;
#pragma unroll
                    for (int bj = 0; bj < 2; ++bj) { const f32x4 v0 = pre[mm][bj][0] + cf[bj][0] * acc[ai][bj][m][0], v1 = pre[mm][bj][1] + cf[bj][1] * acc[ai][bj][m][1];
                        u32x4 w; w.x = cvt_pk_bf16(v0[0], v0[1]); w.y = cvt_pk_bf16(v0[2], v0[3]); w.z = cvt_pk_bf16(v1[0], v1[1]); w.w = cvt_pk_bf16(v1[2], v1[3]);
                        *(u32x4*)(out + off + bj * HALF) = w; } }
                asm volatile("" ::: "memory");
            }
    }
};
struct EpiMergeChain {
    static constexpr bool PERM = true, AFTER_DRAIN = false, CHAIN = true;
    const bf16_t* gate; int ldg; bf16_t* ybf;
    __device__ __forceinline__ bool chain(f32x4 (&acc)[2][2][4][2], const Unit& u, int wr, int wc, int fr, int fq) const {
        const int br = u.pn >> 3, pn = u.pn & 7, pm = u.pm - 66 * br;
        const int row0 = pm * BM + wr * 64 + fr, col0 = pn * BM + wc * 32 + 8 * fq;
        const bf16_t* g0 = gate + (size_t)br * 2048 + col0;
#pragma unroll
        for (int ai = 0; ai < 2; ++ai)
#pragma unroll
            for (int m = 0; m < 4; ++m) { const size_t r = (size_t)(row0 + ai * HALF + m * 16);
#pragma unroll
                for (int bj = 0; bj < 2; ++bj) {
                    const u32x4 ga = *(const u32x4*)(g0 + r * ldg + bj * HALF);
                    float sa[8] = {__uint_as_float(ga.x << 16), __uint_as_float(ga.x & 0xffff0000u), __uint_as_float(ga.y << 16), __uint_as_float(ga.y & 0xffff0000u),
                                   __uint_as_float(ga.z << 16), __uint_as_float(ga.z & 0xffff0000u), __uint_as_float(ga.w << 16), __uint_as_float(ga.w & 0xffff0000u)};
                    if (br < 2) {
                        const u32x4 gb = *(const u32x4*)(g0 + 2048 + r * ldg + bj * HALF);
                        const float sb[8] = {__uint_as_float(gb.x << 16), __uint_as_float(gb.x & 0xffff0000u), __uint_as_float(gb.y << 16), __uint_as_float(gb.y & 0xffff0000u),
                                             __uint_as_float(gb.z << 16), __uint_as_float(gb.z & 0xffff0000u), __uint_as_float(gb.w << 16), __uint_as_float(gb.w & 0xffff0000u)};
#pragma unroll
                        for (int i = 0; i < 8; ++i) sa[i] *= __builtin_amdgcn_rcpf(sb[i]);
                        acc[ai][bj][m][0] = acc[ai][bj][m][0] * (f32x4){sa[0], sa[1], sa[2], sa[3]}; acc[ai][bj][m][1] = acc[ai][bj][m][1] * (f32x4){sa[4], sa[5], sa[6], sa[7]};
                    } else {
                        const f32x4 v0 = acc[ai][bj][m][0] * (f32x4){sa[0], sa[1], sa[2], sa[3]}, v1 = acc[ai][bj][m][1] * (f32x4){sa[4], sa[5], sa[6], sa[7]};
                        u32x4 w; w.x = cvt_pk_bf16(v0[0], v0[1]); w.y = cvt_pk_bf16(v0[2], v0[3]); w.z = cvt_pk_bf16(v1[0], v1[1]); w.w = cvt_pk_bf16(v1[2], v1[3]);
                        *(u32x4*)(ybf + r * DM + col0 + bj * HALF) = w; } }
                if (m & 1) asm volatile("" ::: "memory"); }
        return br == 2;
    }
};
struct MergeOrder {
    StaticOrder base;
    __host__ __device__ void init(int M, int G_, int c_) { base.init(M, 8 * BM, G_, c_, WGM_N8); }
    __host__ __device__ bool next(int i, Unit& u) const { const int t = i / 3, br = i - 3 * t; if (!base.next(t, u)) return false; u.pm += 66 * br; u.pn += 8 * br; return true; }
    __device__ __forceinline__ void a_ready(const Unit&) const {}
    __device__ __forceinline__ void done(const Unit&) const {}
};
struct SplitKOrder {
    int nM, nN, nK, G, c;
    __host__ __device__ void init(int M, int N, int nK_, int G_, int c_) { nM = M / BM; nN = N / BM; nK = nK_; G = G_; c = c_; }
    __host__ __device__ bool next(int i, Unit& u) const { const int L = i * G + c; if (L >= nM * nN * nK) return false; u.pk = L % nK; const int t = L / nK; u.pm = t % nM; u.pn = t / nM; return true; }
    __device__ __forceinline__ void a_ready(const Unit&) const {}
    __device__ __forceinline__ void done(const Unit&) const {}
};
struct EpiPartial {
    static constexpr bool PERM = false, AFTER_DRAIN = false, CHAIN = false;
    float* part; const float* coef; float mul;
    __device__ __forceinline__ void operator()(const f32x4 (&acc)[2][2][4][2], const Unit& u, int wr, int wc, int fr, int fq) const {
        const int col0 = u.pn * BM + wc * 32 + 4 * fq;
        f32x4 cf[2][2];
#pragma unroll
        for (int bj = 0; bj < 2; ++bj)
#pragma unroll
            for (int n = 0; n < 2; ++n) cf[bj][n] = *(const f32x4*)(coef + col0 + bj * HALF + n * 16) * mul;
#pragma unroll
        for (int ai = 0; ai < 2; ++ai)
#pragma unroll
            for (int m = 0; m < 4; ++m) { const int r = u.pm * BM + ai * HALF + wr * 64 + m * 16 + fr; const size_t off = ((size_t)u.pk * 512 + r) * DM + col0;
#pragma unroll
                for (int bj = 0; bj < 2; ++bj)
#pragma unroll
                    for (int n = 0; n < 2; ++n) *(f32x4*)(part + off + bj * HALF + n * 16) = cf[bj][n] * acc[ai][bj][m][n]; }
    }
};

template <class Epi, class Sched, bool ALIGN_EPI = false, bool SP2 = false>
__device__ __forceinline__ void gemm_phase(PG8_LAS unsigned char* lds, const Gemm g, const Sched& S, const Epi& E) {
    int tid_ = threadIdx.x; asm volatile("" : "+v"(tid_)); const int tid = tid_, wid = __builtin_amdgcn_readfirstlane(tid >> 6), lane = tid & 63, wr = wid >> 2, wc = wid & 3, fr = lane & 15, fq = lane >> 4;
    const int K = g.K, nt = K / BK, LD = g.ld ? g.ld : g.K;
    unsigned voffA[2], voffB[2];
#pragma unroll
    for (int i = 0; i < 2; ++i) { int R, C; stage_rc(tid * 16 + i * 8192, R, C); const int Rb = Epi::PERM ? ((R & ~31) + perm32(R & 31)) : R;
        voffA[i] = (unsigned)(R * LD + C) * 2u; voffB[i] = (unsigned)(Rb * LD + C) * 2u; }
    const size_t kstep = (size_t)(BK * 2);
    const size_t hstep = (size_t)HALF * LD * 2;
    const size_t tstep = 2 * hstep;
    const unsigned ldsw = (unsigned)wid * 1024u;
    const int aoff = lds_byte(wr * 64 + fr, fq * 8), boff = lds_byte(wc * 32 + fr, fq * 8);
#define PG8_SA(b, h) (((b) * 2 + (h)) * HTB)
#define PG8_SB(b, h) ((4 + (b) * 2 + (h)) * HTB)
#define PG8_STAGE(bufoff, gbase, voff) do { _Pragma("unroll") for (int _i = 0; _i < 2; ++_i) \
        __builtin_amdgcn_global_load_lds((const unsigned*)((const char*)(gbase) + (voff)[_i]), (PG8_LAS unsigned*)(lds + (bufoff) + ldsw + _i * 8192), 16, 0, 0); } while (0)
#define PG8_LDA(dst, b, h) do { _Pragma("unroll") for (int m = 0; m < 4; ++m) _Pragma("unroll") for (int k = 0; k < 2; ++k) dst[m][k] = *(const PG8_LAS bf16x8*)(lds + PG8_SA(b, h) + aoff + m * 2048 + k * 1024); } while (0)
#define PG8_LDB(dst, b, h) do { _Pragma("unroll") for (int n = 0; n < 2; ++n) _Pragma("unroll") for (int k = 0; k < 2; ++k) dst[n][k] = *(const PG8_LAS bf16x8*)(lds + PG8_SB(b, h) + boff + n * 2048 + k * 1024); } while (0)
#define PG8_MMA(ai, bj, At, Bt) do { __builtin_amdgcn_s_setprio(1); _Pragma("unroll") for (int m = 0; m < 4; ++m) _Pragma("unroll") for (int n = 0; n < 2; ++n) _Pragma("unroll") for (int k = 0; k < 2; ++k) \
        acc[ai][bj][m][n] = __builtin_amdgcn_mfma_f32_16x16x32_bf16(Bt[n][k], At[m][k], acc[ai][bj][m][n], 0, 0, 0); __builtin_amdgcn_s_setprio(0); } while (0)
#define PG8_WAIT_V(n) asm volatile("s_waitcnt vmcnt(" #n ")" ::: "memory")
#define PG8_WAIT_L(n) asm volatile("s_waitcnt lgkmcnt(" #n ")" ::: "memory")
#define PG8_BAR __builtin_amdgcn_s_barrier()
#define PG8_SCHED __builtin_amdgcn_sched_barrier(0)
    Unit cur, nxt; int ui = 0;
    if (!S.next(0, cur)) return;
    f32x4 acc[2][2][4][2];
#pragma unroll
    for (int a = 0; a < 2; ++a)
#pragma unroll
        for (int b = 0; b < 2; ++b)
#pragma unroll
            for (int m = 0; m < 4; ++m)
#pragma unroll
                for (int n = 0; n < 2; ++n) acc[a][b][m][n] = (f32x4){0.f, 0.f, 0.f, 0.f};
    bf16x8 At[4][2], B0[2][2], B1[2][2];
    const size_t kslice = (size_t)K * 2;
    const char* cA = (const char*)g.A + (size_t)cur.pm * tstep + (size_t)cur.pk * kslice; const char* cB = (const char*)g.Bt + (size_t)cur.pn * tstep + (size_t)cur.pk * kslice;
    S.a_ready(cur);
    if constexpr (SP2) {
        PG8_STAGE(PG8_SB(0, 0), cB, voffB); PG8_STAGE(PG8_SB(0, 1), cB + hstep, voffB); PG8_STAGE(PG8_SA(0, 0), cA, voffA); PG8_STAGE(PG8_SA(0, 1), cA + hstep, voffA);
        if (wr == 1) PG8_BAR;
        PG8_WAIT_V(2); PG8_BAR;
        PG8_STAGE(PG8_SB(1, 0), cB + kstep, voffB); PG8_STAGE(PG8_SA(1, 0), cA + kstep, voffA); PG8_STAGE(PG8_SB(1, 1), cB + hstep + kstep, voffB);
        PG8_WAIT_V(6); PG8_BAR;
    } else {
        PG8_STAGE(PG8_SB(0, 0), cB, voffB); PG8_STAGE(PG8_SA(0, 0), cA, voffA); PG8_STAGE(PG8_SB(0, 1), cB + hstep, voffB); PG8_STAGE(PG8_SA(0, 1), cA + hstep, voffA);
        if (wr == 1) PG8_BAR;
        PG8_WAIT_V(4); PG8_BAR;
        PG8_STAGE(PG8_SB(1, 0), cB + kstep, voffB); PG8_STAGE(PG8_SA(1, 0), cA + kstep, voffA); PG8_STAGE(PG8_SB(1, 1), cB + hstep + kstep, voffB);
        PG8_WAIT_V(6); PG8_BAR;
    }
    for (;;) {
        const bool has_next = S.next(ui + 1, nxt);
        const char* nA = has_next ? (const char*)g.A + (size_t)nxt.pm * tstep + (size_t)nxt.pk * kslice : cA; const char* nB = has_next ? (const char*)g.Bt + (size_t)nxt.pn * tstep + (size_t)nxt.pk * kslice : cB;
        for (int t = 0; t < nt; t += 2) {
            const bool last = (t == nt - 2);
            const char* a1 = cA + (size_t)(t + 1) * kstep;
            const char* a2 = last ? nA : cA + (size_t)(t + 2) * kstep; const char* b2 = last ? nB : cB + (size_t)(t + 2) * kstep;
            const char* a3 = a2 + kstep; const char* b3 = b2 + kstep;
            if (last && has_next) S.a_ready(nxt);
            if constexpr (SP2) {
            PG8_LDB(B0, 0, 0); PG8_LDB(B1, 0, 1); PG8_SCHED; PG8_LDA(At, 0, 0); PG8_STAGE(PG8_SA(1, 1), a1 + hstep, voffA);
            PG8_WAIT_V(8); PG8_WAIT_L(0); PG8_BAR; PG8_MMA(0, 0, At, B0); PG8_MMA(0, 1, At, B1); PG8_BAR; PG8_SCHED;
            PG8_LDA(At, 0, 1); PG8_STAGE(PG8_SB(0, 0), b2, voffB); PG8_STAGE(PG8_SB(0, 1), b2 + hstep, voffB); PG8_STAGE(PG8_SA(0, 0), a2, voffA);
            PG8_WAIT_V(8); PG8_WAIT_L(0); PG8_BAR; PG8_MMA(1, 0, At, B0); PG8_MMA(1, 1, At, B1); PG8_BAR; PG8_SCHED;
            PG8_LDB(B0, 1, 0); PG8_LDB(B1, 1, 1); PG8_SCHED; PG8_LDA(At, 1, 0); PG8_STAGE(PG8_SA(0, 1), a2 + hstep, voffA);
            PG8_WAIT_V(8); PG8_WAIT_L(0); PG8_BAR; PG8_MMA(0, 0, At, B0); PG8_MMA(0, 1, At, B1); PG8_BAR; PG8_SCHED;
            PG8_LDA(At, 1, 1); PG8_STAGE(PG8_SB(1, 0), b3, voffB); PG8_STAGE(PG8_SB(1, 1), b3 + hstep, voffB); PG8_STAGE(PG8_SA(1, 0), a3, voffA);
            PG8_WAIT_V(8); PG8_WAIT_L(0); PG8_BAR; PG8_MMA(1, 0, At, B0); PG8_MMA(1, 1, At, B1); PG8_BAR; PG8_SCHED;
            } else {
            PG8_LDB(B0, 0, 0); PG8_SCHED; PG8_LDA(At, 0, 0); PG8_STAGE(PG8_SA(1, 1), a1 + hstep, voffA);
            PG8_WAIT_L(8); PG8_BAR; PG8_WAIT_L(0); PG8_MMA(0, 0, At, B0); PG8_BAR; PG8_SCHED;
            PG8_LDB(B1, 0, 1); PG8_STAGE(PG8_SB(0, 0), b2, voffB);
            PG8_BAR; PG8_WAIT_L(0); PG8_MMA(0, 1, At, B1); PG8_BAR;
            PG8_LDA(At, 0, 1); PG8_STAGE(PG8_SA(0, 0), a2, voffA);
            PG8_BAR; PG8_WAIT_L(0); PG8_MMA(1, 0, At, B0); PG8_BAR; PG8_SCHED;
            PG8_STAGE(PG8_SB(0, 1), b2 + hstep, voffB);
            PG8_WAIT_V(6); PG8_BAR; PG8_MMA(1, 1, At, B1); PG8_BAR;
            PG8_LDB(B0, 1, 0); PG8_SCHED; PG8_LDA(At, 1, 0); PG8_STAGE(PG8_SA(0, 1), a2 + hstep, voffA);
            PG8_WAIT_L(8); PG8_BAR; PG8_WAIT_L(0); PG8_MMA(0, 0, At, B0); PG8_BAR; PG8_SCHED;
            PG8_LDB(B1, 1, 1); PG8_STAGE(PG8_SB(1, 0), b3, voffB);
            PG8_BAR; PG8_WAIT_L(0); PG8_MMA(0, 1, At, B1); PG8_BAR;
            PG8_LDA(At, 1, 1); PG8_STAGE(PG8_SA(1, 0), a3, voffA);
            PG8_BAR; PG8_WAIT_L(0); PG8_MMA(1, 0, At, B0); PG8_BAR; PG8_SCHED;
            PG8_STAGE(PG8_SB(1, 1), b3 + hstep, voffB);
            PG8_WAIT_V(6); PG8_BAR; PG8_MMA(1, 1, At, B1); PG8_BAR;
            }
        }
        if constexpr (ALIGN_EPI) { if (wr == 0) PG8_BAR; }
        bool zero_acc = true;
        if constexpr (Epi::CHAIN) { zero_acc = E.chain(acc, cur, wr, wc, fr, fq); S.done(cur); }
        else if constexpr (!Epi::AFTER_DRAIN) { E(acc, cur, wr, wc, fr, fq); S.done(cur); }
        if (!has_next) break;
        if (zero_acc)
#pragma unroll
        for (int a = 0; a < 2; ++a)
#pragma unroll
            for (int b = 0; b < 2; ++b)
#pragma unroll
                for (int m = 0; m < 4; ++m)
#pragma unroll
                    for (int n = 0; n < 2; ++n) acc[a][b][m][n] = (f32x4){0.f, 0.f, 0.f, 0.f};
        cur = nxt; cA = nA; cB = nB; ++ui;
        if constexpr (ALIGN_EPI) { if (wr == 1) PG8_BAR; }
    }
    PG8_WAIT_V(0);
    if constexpr (!ALIGN_EPI) { if (wr == 0) PG8_BAR; }
    PG8_BAR;
    if constexpr (Epi::AFTER_DRAIN) { E.fused(acc, cur, wr, wc, fr, fq, lds, wid, lane); S.done(cur); }
#undef PG8_SA
#undef PG8_SB
#undef PG8_STAGE
#undef PG8_LDA
#undef PG8_LDB
#undef PG8_MMA
#undef PG8_WAIT_V
#undef PG8_WAIT_L
#undef PG8_BAR
#undef PG8_SCHED
}
}
namespace att {
typedef unsigned short bf16;
using bf16x8 = __attribute__((ext_vector_type(8))) short;
using s16x4  = __attribute__((ext_vector_type(4))) short;
using f32x16 = __attribute__((ext_vector_type(16))) float;
using u32x4  = __attribute__((ext_vector_type(4))) unsigned;
constexpr int NW = 8, QBLK = 32, KVBLK = 64;
constexpr float SCALE = 0.125f;
constexpr float THR = 8.f;
constexpr int LDP = 17408;
constexpr int LDO = 1024;
constexpr size_t SHM_V = KVBLK * 128 * 2, SHM_K = KVBLK * 64 * 2, SHM_ATTN = 2 * SHM_V + 2 * SHM_K + NW * 64 * 4;
#define KSWZ64(row, colB) ((row) * 128 + ((colB) ^ ((((row) >> 1) & 7) << 4)))
#define SBAR() __builtin_amdgcn_sched_barrier(0)
__device__ __forceinline__ int crow(int r, int hi) { return (r & 3) + 8 * (r >> 2) + 4 * hi; }
__device__ __forceinline__ unsigned cvtpk(float lo, float hi) { unsigned r; asm volatile("v_cvt_pk_bf16_f32 %0, %1, %2" : "=v"(r) : "v"(lo), "v"(hi)); return r; }
typedef __bf16 atbf2 __attribute__((ext_vector_type(2)));
typedef float atf2 __attribute__((ext_vector_type(2)));
__device__ __forceinline__ unsigned pk2bf(float lo, float hi) { const atf2 v = {lo, hi}; return __builtin_bit_cast(unsigned, __builtin_convertvector(v, atbf2)); }
__device__ __forceinline__ bf16x8 ld8(const bf16* p) { return *reinterpret_cast<const bf16x8*>(p); }

typedef float f32x2a __attribute__((ext_vector_type(2)));
#define MX3(a, b, c) __builtin_fmaxf(__builtin_fmaxf((a), (b)), (c))
constexpr float THR2 = THR * 1.4426950408889634f;
__device__ __forceinline__ void partialSM(f32x16& p0, f32x16& p1, float& mref, f32x16& negm, float& alpha, bool first) {
  float a = MX3(p0[0], p0[1], p1[0]), b = MX3(p0[2], p0[3], p1[1]); a = MX3(a, p1[2], p1[3]);
#pragma unroll
  for (int r = 4; r < 16; r += 4) { a = MX3(a, p0[r], p0[r + 1]); b = MX3(b, p0[r + 2], p0[r + 3]); a = MX3(a, p1[r], p1[r + 1]); b = MX3(b, p1[r + 2], p1[r + 3]); }
  float pmax = __builtin_fmaxf(a, b);
  { auto rr = __builtin_amdgcn_permlane32_swap(__float_as_uint(pmax), __float_as_uint(pmax), false, false);
    pmax = __builtin_fmaxf(__uint_as_float(rr[0]), __uint_as_float(rr[1])); }
  alpha = 1.f;
  if (__builtin_expect(first || !__all(pmax <= THR2), 0)) {
    const float d = first ? pmax : __builtin_fmaxf(pmax, 0.f);
    mref += d; alpha = first ? 0.f : __builtin_amdgcn_exp2f(-d);
#pragma unroll
    for (int r = 0; r < 16; ++r) { p0[r] -= d; p1[r] -= d; }
#pragma unroll
    for (int r = 0; r < 16; ++r) negm[r] = -mref;
    asm volatile("" : "+v"(negm));
  }
#pragma unroll
  for (int r = 0; r < 16; ++r) { p0[r] = __builtin_amdgcn_exp2f(p0[r]); p1[r] = __builtin_amdgcn_exp2f(p1[r]); }
}
__device__ __forceinline__ void finishSM(f32x16& p0, f32x16& p1, float alpha, float& l_reg, bf16x8& pa0, bf16x8& pa1, bf16x8& pa2, bf16x8& pa3) {
  f32x2a s2 = (f32x2a){p0[0], p0[1]} + (f32x2a){p1[0], p1[1]};
#pragma unroll
  for (int r = 2; r < 16; r += 2) { s2 += (f32x2a){p0[r], p0[r + 1]}; s2 += (f32x2a){p1[r], p1[r + 1]}; }
  float ps = s2.x + s2.y;
  { auto rr = __builtin_amdgcn_permlane32_swap(__float_as_uint(ps), __float_as_uint(ps), false, false);
    ps = __uint_as_float(rr[0]) + __uint_as_float(rr[1]); }
  l_reg = l_reg * alpha + ps;
#define PK4(P, BASE, OUT) do { unsigned a0 = cvtpk(P[BASE + 0], P[BASE + 1]), a1 = cvtpk(P[BASE + 2], P[BASE + 3]);   \
    unsigned b0 = cvtpk(P[BASE + 4], P[BASE + 5]), b1 = cvtpk(P[BASE + 6], P[BASE + 7]);                              \
    auto r0 = __builtin_amdgcn_permlane32_swap(a0, b0, false, false); auto r1 = __builtin_amdgcn_permlane32_swap(a1, b1, false, false); \
    u32x4 w = {r0[0], r1[0], r0[1], r1[1]}; OUT = *reinterpret_cast<bf16x8*>(&w); } while (0)
  PK4(p0, 0, pa0); PK4(p0, 8, pa1); PK4(p1, 0, pa2); PK4(p1, 8, pa3);
#undef PK4
}
__device__ __forceinline__ void qkt(f32x16& p0, f32x16& p1, const bf16* Ks, const bf16x8* qr, const f32x16& negm, int r32, int hi) {
#pragma unroll
  for (int d0 = 0; d0 < 4; ++d0) { int cb = (d0 * 16 + hi * 8) * 2;
    bf16x8 b0 = *reinterpret_cast<const bf16x8*>((const char*)Ks + KSWZ64(r32, cb));
    bf16x8 b1 = *reinterpret_cast<const bf16x8*>((const char*)Ks + KSWZ64(32 + r32, cb));
    if (d0 == 0) { p0 = __builtin_amdgcn_mfma_f32_32x32x16_bf16(b0, qr[0], negm, 0, 0, 0); p1 = __builtin_amdgcn_mfma_f32_32x32x16_bf16(b1, qr[0], negm, 0, 0, 0); }
    else { p0 = __builtin_amdgcn_mfma_f32_32x32x16_bf16(b0, qr[d0], p0, 0, 0, 0); p1 = __builtin_amdgcn_mfma_f32_32x32x16_bf16(b1, qr[d0], p1, 0, 0, 0); } }
}
__device__ __forceinline__ int v_st(int k, int c) { const int kk = (k & ~0xC) | ((k & 4) << 1) | ((k & 8) >> 1); return ((kk >> 3) * 4 + (c >> 5)) * 512 + ((kk & 7) * 32 + (c & 31)) * 2; }
__device__ __forceinline__ int v_rd_base(int lane) { return ((lane & 3) << 3) | (((lane >> 2) & 3) << 6) | (((lane >> 4) & 1) << 5) | (((lane >> 5) & 1) << 8); }
constexpr int v_rd_off(int d0, int ks, int half) { return d0 * 512 + ks * 4096 + half * 2048; }
template <int OFF> __device__ __forceinline__ s16x4 tr_read(int vb) {
  s16x4 r; asm volatile("ds_read_b64_tr_b16 %0, %1 offset:%2" : "=&v"(r) : "v"(vb), "i"(OFF) : "memory"); return r;
}
template <int D0> __device__ __forceinline__ void pv_one(f32x16& od, int vb, bf16x8 pa0, bf16x8 pa1, bf16x8 pa2, bf16x8 pa3) {
  const s16x4 l0 = tr_read<v_rd_off(D0, 0, 0)>(vb), h0 = tr_read<v_rd_off(D0, 0, 1)>(vb), l1 = tr_read<v_rd_off(D0, 1, 0)>(vb), h1 = tr_read<v_rd_off(D0, 1, 1)>(vb);
  const s16x4 l2 = tr_read<v_rd_off(D0, 2, 0)>(vb), h2 = tr_read<v_rd_off(D0, 2, 1)>(vb), l3 = tr_read<v_rd_off(D0, 3, 0)>(vb), h3 = tr_read<v_rd_off(D0, 3, 1)>(vb);
  asm volatile("s_waitcnt lgkmcnt(0)" ::: "memory"); SBAR();
#define PK(L, H) (bf16x8){L[0], L[1], L[2], L[3], H[0], H[1], H[2], H[3]}
  od = __builtin_amdgcn_mfma_f32_32x32x16_bf16(pa0, PK(l0, h0), od, 0, 0, 0);
  od = __builtin_amdgcn_mfma_f32_32x32x16_bf16(pa1, PK(l1, h1), od, 0, 0, 0);
  od = __builtin_amdgcn_mfma_f32_32x32x16_bf16(pa2, PK(l2, h2), od, 0, 0, 0);
  od = __builtin_amdgcn_mfma_f32_32x32x16_bf16(pa3, PK(l3, h3), od, 0, 0, 0);
#undef PK
}
__device__ __forceinline__ void pv_d0(f32x16* o, int vb, bf16x8 pa0, bf16x8 pa1, bf16x8 pa2, bf16x8 pa3) {
  pv_one<0>(o[0], vb, pa0, pa1, pa2, pa3); pv_one<1>(o[1], vb, pa0, pa1, pa2, pa3); pv_one<2>(o[2], vb, pa0, pa1, pa2, pa3); pv_one<3>(o[3], vb, pa0, pa1, pa2, pa3);
}
__device__ __forceinline__ unsigned short f2bf_rne(float f) { unsigned u = __float_as_uint(f); return (unsigned short)((u + 0x7fffu + ((u >> 16) & 1u)) >> 16); }

__device__ __forceinline__ void glds16(const void* gsrc, unsigned lds_dst) { unsigned keep;
  asm volatile("s_mov_b32 %0, m0\n\ts_mov_b32 m0, %2\n\ts_nop 0\n\tglobal_load_lds_dwordx4 %1, off\n\ts_mov_b32 m0, %0" : "=&s"(keep) : "v"(gsrc), "s"(lds_dst) : "memory"); }
constexpr int LDS_K = 0, NKS = 3, LDS_V = NKS * (int)SHM_K, NVS = 4, LDS_WS = LDS_V + NVS * (int)SHM_V, ATT_LDS_BYTES = LDS_WS + NW * 64 * 4;
__device__ __forceinline__ void attn_unit(const bf16* __restrict__ proj, int qrow0, int crow0, int lrow0, int NT, int h, int p, unsigned* __restrict__ hold, float lam, float onemli, const float* __restrict__ nw128, bf16* __restrict__ Bout, char* lds) {
  int tid_ = threadIdx.x; asm volatile("" : "+v"(tid_)); const int tid = tid_, lane = tid & 63, r32 = lane & 31, hi = lane >> 5;
  const int wid = __builtin_amdgcn_readfirstlane(tid >> 6);
  const int CQ = 8192 + 128 * h + 64 * p, CK = 9216 + 128 * h + 64 * p, CV = 10240 + 128 * h;
  const unsigned lds0 = (unsigned)(uintptr_t)lds;
  asm volatile("s_waitcnt vmcnt(0)" ::: "memory");
  float* ws = (float*)(lds + LDS_WS) + wid * 64; float* li_l = ws; float* al_l = ws + 32;
  float mref = 0.f, l_reg = 0; f32x16 o[4] = {}; bf16x8 qr[4]; f32x16 negm = f32x16{}; asm volatile("" : "+v"(negm));
  const bf16* Qw = proj + (size_t)(qrow0 + wid * QBLK + r32) * LDP + CQ + hi * 8;
#pragma unroll
  for (int d0 = 0; d0 < 4; ++d0) qr[d0] = ld8(Qw + d0 * 16);
  size_t kofs, vofs[2];
  { const int row = 8 * wid + (lane >> 3), cpos = lane & 7, cc = cpos ^ ((row >> 1) & 7); kofs = (size_t)row * LDP + CK + cc * 8; }
#pragma unroll
  for (int i = 0; i < 2; ++i) { const int gidx = (2 * wid + i) * 64 + lane, st = gidx >> 5, within = gidx & 31, kk = (st >> 2) * 8 + (within >> 2), cc = (st & 3) * 32 + (within & 3) * 8;
    const int k = (kk & ~0xC) | ((kk & 4) << 1) | ((kk & 8) >> 1); vofs[i] = (size_t)k * LDP + CV + cc; }
#define TROW(jt) ((jt) < 4 ? crow0 + 64 * (jt) : lrow0 + 64 * ((jt) - 4))
#define DMA(jt, ks, vs) do { const bf16* tb_ = proj + (size_t)TROW(jt) * LDP; glds16(tb_ + kofs, lds0 + LDS_K + (ks) * (unsigned)SHM_K + wid * 1024u); \
    glds16(tb_ + vofs[0], lds0 + LDS_V + (vs) * (unsigned)SHM_V + (2 * wid) * 1024u); glds16(tb_ + vofs[1], lds0 + LDS_V + (vs) * (unsigned)SHM_V + (2 * wid + 1) * 1024u); } while (0)
#define DMA_K(jt, ks) do { const bf16* tb_ = proj + (size_t)TROW(jt) * LDP; glds16(tb_ + kofs, lds0 + LDS_K + (ks) * (unsigned)SHM_K + wid * 1024u); } while (0)
#define DMA_V(jt, vs, i) do { const bf16* tb_ = proj + (size_t)TROW(jt) * LDP; glds16(tb_ + vofs[i], lds0 + LDS_V + (vs) * (unsigned)SHM_V + (2 * wid + (i)) * 1024u); } while (0)
#define WAITBAR(n) asm volatile("s_waitcnt vmcnt(" #n ") lgkmcnt(0)\n\ts_barrier" ::: "memory")
#define RESC(a) do { if (__any((a) < 1.f)) { if (hi == 0) al_l[r32] = (a); asm volatile("s_waitcnt lgkmcnt(0)" ::: "memory"); \
    _Pragma("unroll") for (int d = 0; d < 4; ++d) _Pragma("unroll") for (int r = 0; r < 16; ++r) o[d][r] *= al_l[crow(r, hi)]; } } while (0)
  const int vbase = (int)(lds0 + LDS_V) + v_rd_base(lane);
  f32x16 pA0, pA1, pB0, pB1; float alA, alB; bf16x8 pa0, pa1, pa2, pa3;
  int ks_cur = 0, vs_prev = 0;
  DMA(0, 0, 0); DMA(1, 1, 1);
  WAITBAR(3);
  qkt(pA0, pA1, (const bf16*)(lds + LDS_K), qr, negm, r32, hi); partialSM(pA0, pA1, mref, negm, alA, true);
  DMA(2, 2, 2);
  WAITBAR(3);
  ks_cur = 1; vs_prev = 0;
#define EX4(P, B) do { P[B] = __builtin_amdgcn_exp2f(P[B]); P[B + 1] = __builtin_amdgcn_exp2f(P[B + 1]); P[B + 2] = __builtin_amdgcn_exp2f(P[B + 2]); P[B + 3] = __builtin_amdgcn_exp2f(P[B + 3]); } while (0)
#define EX2(P, B) do { P[B] = __builtin_amdgcn_exp2f(P[B]); P[B + 1] = __builtin_amdgcn_exp2f(P[B + 1]); } while (0)
#define PK4(P, BASE, OUT) do { unsigned a0 = cvtpk(P[BASE + 0], P[BASE + 1]), a1 = cvtpk(P[BASE + 2], P[BASE + 3]);   \
    unsigned b0 = cvtpk(P[BASE + 4], P[BASE + 5]), b1 = cvtpk(P[BASE + 6], P[BASE + 7]);                              \
    auto r0 = __builtin_amdgcn_permlane32_swap(a0, b0, false, false); auto r1 = __builtin_amdgcn_permlane32_swap(a1, b1, false, false); \
    u32x4 w = {r0[0], r1[0], r0[1], r1[1]}; OUT = *reinterpret_cast<bf16x8*>(&w); } while (0)
#define KFR(row, d0) (*reinterpret_cast<const bf16x8*>(kb_ + KSWZ64((row), ((d0) * 16 + hi * 8) * 2)))
#define TRR(D0, ks, half) tr_read<v_rd_off(D0, ks, half)>(vb_)
#define PKV(L, H) (bf16x8){L[0], L[1], L[2], L[3], H[0], H[1], H[2], H[3]}
#define LGKM(n) asm volatile("s_waitcnt lgkmcnt(" #n ")" ::: "memory")
#define PVMMA(D0, PA, NEXT, WAITN, G) do { WAITN; SBAR(); o[D0] = __builtin_amdgcn_mfma_f32_32x32x16_bf16(PA, PKV(l##D0, h##D0), o[D0], 0, 0, 0); NEXT; G; SBAR(); } while (0)
#define PVALL(G0, G1, G2, G3, G4, G5, G6, G7, G8, G9, G10, G11, G12, G13, G14, G15) do { \
    PVMMA(0, pa0, { l0 = TRR(0, 1, 0); h0 = TRR(0, 1, 1); }, LGKM(6), G0); \
    PVMMA(1, pa0, { l1 = TRR(1, 1, 0); h1 = TRR(1, 1, 1); }, LGKM(6), G1); \
    PVMMA(2, pa0, { l2 = TRR(2, 1, 0); h2 = TRR(2, 1, 1); }, LGKM(6), G2); \
    PVMMA(3, pa0, { l3 = TRR(3, 1, 0); h3 = TRR(3, 1, 1); }, LGKM(6), G3); \
    PVMMA(0, pa1, { l0 = TRR(0, 2, 0); h0 = TRR(0, 2, 1); }, LGKM(6), G4); \
    PVMMA(1, pa1, { l1 = TRR(1, 2, 0); h1 = TRR(1, 2, 1); }, LGKM(6), G5); \
    PVMMA(2, pa1, { l2 = TRR(2, 2, 0); h2 = TRR(2, 2, 1); }, LGKM(6), G6); \
    PVMMA(3, pa1, { l3 = TRR(3, 2, 0); h3 = TRR(3, 2, 1); }, LGKM(6), G7); \
    PVMMA(0, pa2, { l0 = TRR(0, 3, 0); h0 = TRR(0, 3, 1); }, LGKM(6), G8); \
    PVMMA(1, pa2, { l1 = TRR(1, 3, 0); h1 = TRR(1, 3, 1); }, LGKM(6), G9); \
    PVMMA(2, pa2, { l2 = TRR(2, 3, 0); h2 = TRR(2, 3, 1); }, LGKM(6), G10); \
    PVMMA(3, pa2, { l3 = TRR(3, 3, 0); h3 = TRR(3, 3, 1); }, LGKM(6), G11); \
    PVMMA(0, pa3, { }, LGKM(6), G12); \
    PVMMA(1, pa3, { }, LGKM(4), G13); \
    PVMMA(2, pa3, { }, LGKM(2), G14); \
    PVMMA(3, pa3, { }, LGKM(0), G15); } while (0)
#define FADD(a, b) ((a) + (b))
#define PIN(x) asm volatile("" : "+v"(x))
#define EX3(P, a, b, c_) do { P[a] = __builtin_amdgcn_exp2f(P[a]); P[b] = __builtin_amdgcn_exp2f(P[b]); P[c_] = __builtin_amdgcn_exp2f(P[c_]); PIN(P); } while (0)
#define PKH(P, B, RA, RB) do { const unsigned a_ = cvtpk(P[B], P[B + 1]), b_ = cvtpk(P[B + 4], P[B + 5]); auto r_ = __builtin_amdgcn_permlane32_swap(a_, b_, false, false); RA = r_[0]; RB = r_[1]; } while (0)
#define MKPA(OUT, x0, x1, y0, y1) do { u32x4 w_ = {x0, y0, x1, y1}; OUT = *reinterpret_cast<bf16x8*>(&w_); } while (0)
#define STEP(PX0, PX1, ALX, PY0, PY1, ALY, j) do { \
    const int jn_ = (j) + 2; const bool more_ = jn_ < NT; const int ksn_ = (ks_cur + 2) % 3, vsn_ = (vs_prev + 3) & 3; \
    const char* kb_ = lds + LDS_K + ks_cur * (int)SHM_K; const int vb_ = vbase + vs_prev * (int)SHM_V; \
    float sa_, sb_; \
    s16x4 l0, h0, l1, h1, l2, h2, l3, h3; \
    { bf16x8 kA = KFR(r32, 0), kB = KFR(32 + r32, 0), kC = KFR(r32, 1), kD = KFR(32 + r32, 1); unsigned x0_, x1_, y0_, y1_; SBAR(); \
      PX0 = __builtin_amdgcn_mfma_f32_32x32x16_bf16(kA, qr[0], negm, 0, 0, 0); if (more_) DMA_K(jn_, ksn_); PKH(PY0, 0, x0_, x1_); sa_ = PY0[0] + PY0[1]; sa_ += PY0[2]; SBAR(); \
      PX1 = __builtin_amdgcn_mfma_f32_32x32x16_bf16(kB, qr[0], negm, 0, 0, 0); kA = KFR(r32, 2); kB = KFR(32 + r32, 2); if (more_) DMA_V(jn_, vsn_, 0); PKH(PY0, 2, y0_, y1_); MKPA(pa0, x0_, x1_, y0_, y1_); sa_ += PY0[3]; sa_ += PY0[4]; SBAR(); \
      PX0 = __builtin_amdgcn_mfma_f32_32x32x16_bf16(kC, qr[1], PX0, 0, 0, 0); if (more_) DMA_V(jn_, vsn_, 1); PKH(PY0, 8, x0_, x1_); sa_ += PY0[5]; sa_ += PY0[6]; SBAR(); \
      PX1 = __builtin_amdgcn_mfma_f32_32x32x16_bf16(kD, qr[1], PX1, 0, 0, 0); kC = KFR(r32, 3); kD = KFR(32 + r32, 3); PKH(PY0, 10, y0_, y1_); MKPA(pa1, x0_, x1_, y0_, y1_); sa_ += PY0[7]; sa_ += PY0[8]; SBAR(); \
      PX0 = __builtin_amdgcn_mfma_f32_32x32x16_bf16(kA, qr[2], PX0, 0, 0, 0); l0 = TRR(0, 0, 0); h0 = TRR(0, 0, 1); PKH(PY1, 0, x0_, x1_); sa_ += PY0[9]; sa_ += PY0[10]; SBAR(); \
      PX1 = __builtin_amdgcn_mfma_f32_32x32x16_bf16(kB, qr[2], PX1, 0, 0, 0); l1 = TRR(1, 0, 0); h1 = TRR(1, 0, 1); PKH(PY1, 2, y0_, y1_); MKPA(pa2, x0_, x1_, y0_, y1_); sa_ += PY0[11]; sa_ += PY0[12]; SBAR(); \
      PX0 = __builtin_amdgcn_mfma_f32_32x32x16_bf16(kC, qr[3], PX0, 0, 0, 0); l2 = TRR(2, 0, 0); h2 = TRR(2, 0, 1); PKH(PY1, 8, x0_, x1_); sa_ += PY0[13]; sa_ += PY0[14]; SBAR(); \
      PX1 = __builtin_amdgcn_mfma_f32_32x32x16_bf16(kD, qr[3], PX1, 0, 0, 0); l3 = TRR(3, 0, 0); h3 = TRR(3, 0, 1); PKH(PY1, 10, y0_, y1_); MKPA(pa3, x0_, x1_, y0_, y1_); sa_ += PY0[15]; sb_ = PY1[0] + PY1[1]; SBAR(); } \
    float mxa_, mxb_, pmax_; \
    PVALL({ mxa_ = MX3(PX0[0], PX0[1], PX1[0]); mxb_ = MX3(PX0[2], PX0[3], PX1[1]); mxa_ = MX3(mxa_, PX1[2], PX1[3]); sb_ += PY1[2]; sb_ += PY1[3]; }, \
          { mxa_ = MX3(mxa_, PX0[4], PX0[5]); mxb_ = MX3(mxb_, PX0[6], PX0[7]); mxa_ = MX3(mxa_, PX1[4], PX1[5]); mxb_ = MX3(mxb_, PX1[6], PX1[7]); sb_ += PY1[4]; sb_ += PY1[5]; }, \
          { mxa_ = MX3(mxa_, PX0[8], PX0[9]); mxb_ = MX3(mxb_, PX0[10], PX0[11]); mxa_ = MX3(mxa_, PX1[8], PX1[9]); mxb_ = MX3(mxb_, PX1[10], PX1[11]); sb_ += PY1[6]; sb_ += PY1[7]; }, \
          { mxa_ = MX3(mxa_, PX0[12], PX0[13]); mxb_ = MX3(mxb_, PX0[14], PX0[15]); mxa_ = MX3(mxa_, PX1[12], PX1[13]); mxb_ = MX3(mxb_, PX1[14], PX1[15]); sb_ += PY1[8]; sb_ += PY1[9]; }, \
          { pmax_ = __builtin_fmaxf(mxa_, mxb_); auto rr_ = __builtin_amdgcn_permlane32_swap(__float_as_uint(pmax_), __float_as_uint(pmax_), false, false); pmax_ = __builtin_fmaxf(__uint_as_float(rr_[0]), __uint_as_float(rr_[1])); \
            sb_ += PY1[10]; sb_ += PY1[11]; sb_ += PY1[12]; }, \
          { sb_ += PY1[13]; sb_ += PY1[14]; sb_ += PY1[15]; { float ps_ = sa_ + sb_; auto rq_ = __builtin_amdgcn_permlane32_swap(__float_as_uint(ps_), __float_as_uint(ps_), false, false); ps_ = __uint_as_float(rq_[0]) + __uint_as_float(rq_[1]); l_reg = l_reg * ALY + ps_; } \
            ALX = 1.f; if (__builtin_expect(!__all(pmax_ <= THR2), 0)) { const float d_ = __builtin_fmaxf(pmax_, 0.f); mref += d_; ALX = __builtin_amdgcn_exp2f(-d_); \
              _Pragma("unroll") for (int r = 0; r < 16; ++r) { PX0[r] -= d_; PX1[r] -= d_; } _Pragma("unroll") for (int r = 0; r < 16; ++r) negm[r] = -mref; asm volatile("" : "+v"(negm)); } }, \
          { EX3(PX0, 0, 1, 2); }, { EX3(PX0, 3, 4, 5); }, { EX3(PX0, 6, 7, 8); }, { EX3(PX0, 9, 10, 11); }, { EX3(PX0, 12, 13, 14); }, \
          { PX0[15] = __builtin_amdgcn_exp2f(PX0[15]); PX1[0] = __builtin_amdgcn_exp2f(PX1[0]); PX1[1] = __builtin_amdgcn_exp2f(PX1[1]); PIN(PX0); PIN(PX1); }, \
          { EX3(PX1, 2, 3, 4); }, { EX3(PX1, 5, 6, 7); }, { EX3(PX1, 8, 9, 10); PX1[11] = __builtin_amdgcn_exp2f(PX1[11]); PIN(PX1); }, { EX2(PX1, 12); EX2(PX1, 14); PIN(PX1); }); \
    if (more_) WAITBAR(3); else WAITBAR(0); \
    RESC(ALX); ks_cur = (ks_cur + 1) % 3; vs_prev = (vs_prev + 1) & 3; } while (0)
  for (int j = 1; j + 1 < NT; j += 2) {
    STEP(pB0, pB1, alB, pA0, pA1, alA, j);
    STEP(pA0, pA1, alA, pB0, pB1, alB, j + 1);
  }
  STEP(pB0, pB1, alB, pA0, pA1, alA, NT - 1);
  finishSM(pB0, pB1, alB, l_reg, pa0, pa1, pa2, pa3); SBAR();
  pv_d0(o, vbase + vs_prev * (int)SHM_V, pa0, pa1, pa2, pa3);
  if (hi == 0) li_l[r32] = l_reg; asm volatile("s_waitcnt lgkmcnt(0)" ::: "memory");
  float rli[16];
#pragma unroll
  for (int r = 0; r < 16; ++r) rli[r] = __builtin_amdgcn_rcpf(li_l[crow(r, hi)]);
  if (p == 0) {
#pragma unroll
    for (int d0 = 0; d0 < 4; ++d0) { u32x4 a, b;
#pragma unroll
      for (int q = 0; q < 4; ++q) { a[q] = pk2bf(o[d0][2 * q] * rli[2 * q], o[d0][2 * q + 1] * rli[2 * q + 1]); b[q] = pk2bf(o[d0][8 + 2 * q] * rli[8 + 2 * q], o[d0][9 + 2 * q] * rli[9 + 2 * q]); }
      *reinterpret_cast<u32x4*>(hold + d0 * 8) = a; *reinterpret_cast<u32x4*>(hold + d0 * 8 + 4) = b; }
  } else {
    unsigned held[32];
#pragma unroll
    for (int q = 0; q < 8; ++q) { const u32x4 t = *reinterpret_cast<const u32x4*>(hold + 4 * q); held[4 * q] = t[0]; held[4 * q + 1] = t[1]; held[4 * q + 2] = t[2]; held[4 * q + 3] = t[3]; }
    float ss[16];
#pragma unroll
    for (int r = 0; r < 16; ++r) { ss[r] = 0.f;
#pragma unroll
      for (int d0 = 0; d0 < 4; ++d0) { const unsigned hw = held[d0 * 8 + (r >> 1)]; const float o0 = __uint_as_float((r & 1) ? (hw & 0xffff0000u) : (hw << 16));
        const float x = o0 - lam * (o[d0][r] * rli[r]); o[d0][r] = x; ss[r] += x * x; } }
#pragma unroll
    for (int r = 0; r < 16; ++r) {
#pragma unroll
      for (int m = 1; m < 32; m <<= 1) ss[r] += __shfl_xor(ss[r], m); }
    float dn[4];
#pragma unroll
    for (int d0 = 0; d0 < 4; ++d0) dn[d0] = nw128[d0 * 32 + r32] * onemli;
    bf16* Ow = Bout + (size_t)(qrow0 + wid * QBLK) * LDO + 128 * h;
#pragma unroll
    for (int r = 0; r < 16; ++r) { const int orow = crow(r, hi); const float rstd = __builtin_amdgcn_rsqf(ss[r] * (1.f / 128.f) + 1e-6f);
#pragma unroll
      for (int d0 = 0; d0 < 4; ++d0) Ow[(size_t)orow * LDO + d0 * 32 + r32] = (bf16)(pk2bf(o[d0][r] * rstd * dn[d0], 0.f) & 0xffffu); }
  }
  asm volatile("s_waitcnt vmcnt(0) lgkmcnt(0)\n\ts_barrier" ::: "memory");
#undef TROW
#undef DMA
#undef DMA_K
#undef DMA_V
#undef WAITBAR
#undef STEP
#undef PKH
#undef MKPA
#undef FADD
#undef EX3
#undef PIN
#undef PVALL
#undef PVMMA
#undef LGKM
#undef PKV
#undef TRR
#undef KFR
#undef PK4
#undef EX2
#undef EX4
#undef RESC
}
#undef SBAR
}

constexpr int NWAVES = 8;
#ifndef MK_N_LAUNCHES
#define MK_N_LAUNCHES 1
#endif
constexpr int D = 2048, NLAT = 16384, NCTX = 512, MTOT = NLAT + NCTX, SEQ = 8192, CTXL = 256, FF = 5632, WIN = 17408, MODW = 18432, MIXW = 1024;
constexpr int C_HQ = 0, C_HF = 1024, C_HB = 2048, C_HI = 3072, C_HG = 4096, C_CB = 5120, C_CC = 6144, C_CU = 7168, C_AQ = 8192, C_AK = 9216, C_AV = 10240, C_GA = 11264, C_GB = 13312, C_GC = 15360;
constexpr int NCHUNK = 132;
constexpr int NSEQ = 32;
constexpr float EPS = 1e-6f;
constexpr int NPL = 13;
constexpr int NPHASE = 1 + 2 * NPL + 1;

constexpr size_t MiB = 1u << 20;
constexpr size_t WS_CTL = 0, CTL_ZERO_BYTES = 65536;
constexpr size_t WS_MOD = 1 * MiB;
constexpr size_t WS_HCTX = 2 * MiB;
constexpr size_t WS_W13T = 6 * MiB;
constexpr size_t WS_W2T = WS_W13T + 88 * MiB;
constexpr size_t WS_WINT = WS_W2T + 44 * MiB;
constexpr size_t WS_WBT = WS_WINT + 68 * MiB;
constexpr size_t WS_WOT = WS_WBT + 12 * MiB;
constexpr size_t WS_XN = WS_WOT + 8 * MiB;
constexpr size_t WS_PROJ = WS_XN + 66 * MiB;
constexpr size_t WS_ST = WS_PROJ + 561 * MiB;
constexpr size_t WS_DEC = WS_ST + 132 * MiB;
constexpr size_t WS_BR = WS_DEC + 3 * MiB;
constexpr size_t WS_OP = WS_BR + 99 * MiB;
constexpr size_t WS_PART = WS_OP + 66 * MiB;
constexpr size_t WS_H16 = WS_PART + 44 * MiB;
constexpr size_t WS_QS = WS_H16 + 66 * MiB;
constexpr size_t WS_KS = WS_QS + 66 * MiB;
constexpr size_t WS_END = WS_KS + 66 * MiB;
constexpr size_t WS_EMID = WS_HCTX;
static_assert((size_t)MTOT * WIN * 2 <= 561 * MiB && (size_t)4224 * 16384 * 2 <= 132 * MiB && (size_t)MTOT * D * 4 <= 132 * MiB && (size_t)3 * MTOT * MIXW * 2 <= 99 * MiB, "d_ws map");
constexpr int CW_BAR = 4096;

constexpr int RING_OFF = 0, RING_BYTES = 131072;
constexpr int LDSCTL_OFF = RING_BYTES, MISC_OFF = LDSCTL_OFF + 320;
constexpr int LDS_BYTES = 147456;

#define GAS __attribute__((address_space(1)))
#define LAS __attribute__((address_space(3)))
typedef unsigned short bf16;
typedef unsigned v4u __attribute__((ext_vector_type(4)));
typedef unsigned v2u __attribute__((ext_vector_type(2)));
typedef float f32x4 __attribute__((ext_vector_type(4)));
typedef short bf16x8 __attribute__((ext_vector_type(8)));
typedef GAS unsigned gu32;
#define RLX_AGENT __ATOMIC_RELAXED, __HIP_MEMORY_SCOPE_AGENT
#define LDS_WAIT() asm volatile("s_waitcnt lgkmcnt(0)" ::: "memory")
#define VM_WAIT() asm volatile("s_waitcnt vmcnt(0)" ::: "memory")
typedef __bf16 hwbf2 __attribute__((ext_vector_type(2)));
typedef float hwf2 __attribute__((ext_vector_type(2)));
__device__ __forceinline__ unsigned pk2(float lo, float hi) { const hwf2 v = {lo, hi}; return __builtin_bit_cast(unsigned, __builtin_convertvector(v, hwbf2)); }
__device__ __forceinline__ unsigned f2bf(float f) { return pk2(f, f) & 0xffffu; }
__device__ __forceinline__ float bflo(unsigned w) { return __uint_as_float(w << 16); }
__device__ __forceinline__ float bfhi(unsigned w) { return __uint_as_float(w & 0xffff0000u); }
__device__ __forceinline__ float silu_f(float x) { return x * __builtin_amdgcn_rcpf(1.0f + __builtin_amdgcn_exp2f(-1.4426950408889634f * x)); }
__device__ __forceinline__ float sigm_f(float x) { return __builtin_amdgcn_rcpf(1.0f + __builtin_amdgcn_exp2f(-1.4426950408889634f * x)); }

#define XB_TMO      128
#define XB_XCNT(j)  (256  + 64 * (j))
#define XB_XSUB(j)  (1280 + 64 * (j))
#define XB_XGEN(j)  (2304 + 64 * (j))
#define XB_TOP      3328
#define XB_TOPGEN   3392
#define XCD_BAR_WORDS 3456
#define XB_SPIN_CAP (1u << 18)

__device__ __forceinline__ unsigned xb_ld(unsigned* p)              { return __hip_atomic_load(p, __ATOMIC_RELAXED, __HIP_MEMORY_SCOPE_AGENT); }
__device__ __forceinline__ unsigned xb_add(unsigned* p, unsigned v) { return __hip_atomic_fetch_add(p, v, __ATOMIC_RELAXED, __HIP_MEMORY_SCOPE_AGENT); }
__device__ __forceinline__ unsigned xb_xcc_id() { return (unsigned)__builtin_amdgcn_s_getreg((3 << 11) | 20) & 0xFu; }
#define XB_SPIN(cond, bar) do { unsigned _sp = 0; while (cond) { __builtin_amdgcn_s_sleep(1); \
    if ((++_sp & 255u) == 0u) { if (xb_ld(&(bar)[XB_TMO])) break; if (_sp > XB_SPIN_CAP) { atomicAdd(&(bar)[XB_TMO], 1u); break; } } } } while (0)

struct XcdBarrier {
    unsigned* bar; unsigned x;
    volatile LAS unsigned* st;
};

__device__ __forceinline__ XcdBarrier xcd_barrier_post(unsigned* bar, volatile LAS unsigned* st) {
    XcdBarrier b; b.bar = bar; b.x = xb_xcc_id(); b.st = st;
    if (threadIdx.x == 0) (void)xb_add(&bar[XB_XCNT(b.x)], 1u);
    return b;
}
__device__ __forceinline__ void xcd_barrier_complete(unsigned* bar, unsigned x, unsigned& nloc, unsigned& nx) {
    const unsigned G = gridDim.x * gridDim.y * gridDim.z;
    unsigned sum, cnt, mine, sp = 0u;
    for (;;) {
        sum = 0u; cnt = 0u; mine = 0u;
#pragma unroll
        for (unsigned j = 0; j < 16; ++j) { const unsigned c = xb_ld(&bar[XB_XCNT(j)]); sum += c; cnt += (c > 0u) ? 1u : 0u; mine = (j == x) ? c : mine; }
        if (sum == G) break;
        __builtin_amdgcn_s_sleep(1);
        if ((++sp & 255u) == 0u) { if (xb_ld(&bar[XB_TMO])) break; if (sp > XB_SPIN_CAP) { atomicAdd(&bar[XB_TMO], 1u); break; } }
    }
    nloc = mine > 0u ? mine : 1u; nx = cnt > 0u ? cnt : 1u;
}

__device__ __forceinline__ void xcd_barrier(const XcdBarrier& b) {
    asm volatile("s_waitcnt vmcnt(0)" ::: "memory");
    __syncthreads();
    if (threadIdx.x == 0) {
        unsigned* bar = b.bar;
        __builtin_amdgcn_s_waitcnt(0);
        unsigned nloc = b.st[0], nx = b.st[1];
        if (nloc == 0u) { xcd_barrier_complete(bar, b.x, nloc, nx); b.st[0] = nloc; b.st[1] = nx; }
        const unsigned old = xb_add(&bar[XB_XSUB(b.x)], 1u);
        const unsigned gen = old / nloc;
        if (old + 1u == (gen + 1u) * nloc) {
            __builtin_amdgcn_fence(__ATOMIC_RELEASE, "agent");
            asm volatile("s_waitcnt vmcnt(0)" ::: "memory");
            const unsigned og = xb_add(&bar[XB_TOP], 1u);
            const unsigned tg = og / nx;
            if (og + 1u == (tg + 1u) * nx) xb_add(&bar[XB_TOPGEN], 1u);
            else XB_SPIN(xb_ld(&bar[XB_TOPGEN]) == tg, bar);
            __builtin_amdgcn_fence(__ATOMIC_ACQUIRE, "agent");
            xb_add(&bar[XB_XGEN(b.x)], 1u);
            asm volatile("s_waitcnt vmcnt(0)" ::: "memory");
        } else {
            XB_SPIN(xb_ld(&bar[XB_XGEN(b.x)]) == gen, bar);
            __builtin_amdgcn_fence(__ATOMIC_ACQUIRE, "agent");
            asm volatile("s_waitcnt vmcnt(0)" ::: "memory");
        }
    }
    __syncthreads();
}

struct Frame {
    LAS unsigned char* lds;
    volatile LAS unsigned* MISC;
    gu32* ctl;
    unsigned char* ws;
    float* out;
    int tid, lane, wave;
    int vcu, G, bx;
};
__device__ __forceinline__ void launder(Frame& P) {
    int t = P.tid; asm volatile("" : "+v"(t)); P.tid = t; P.lane = t & 63; P.wave = __builtin_amdgcn_readfirstlane(t >> 6);
    unsigned long long w = (unsigned long long)P.ws, o = (unsigned long long)P.out; int g = P.G, v = P.vcu, x = P.bx;
    asm volatile("" : "+s"(w), "+s"(o), "+s"(g), "+s"(v), "+s"(x));
    P.ws = (unsigned char*)w; P.out = (float*)o; P.G = g; P.vcu = v; P.bx = x;
}
__device__ __forceinline__ const float* in_ptr(int k) {
    auto kp = (const float* const __attribute__((address_space(4)))*)__builtin_amdgcn_kernarg_segment_ptr();
    int kk = k; asm volatile("" : "+s"(kk));
    return kp[kk];
}
#define IP_X in_ptr(0)
#define IP_C in_ptr(1)
#define IP_CTX in_ptr(2)
#define IP_CCTX in_ptr(3)
#define IP_WADA in_ptr(4)
#define IP_BADA in_ptr(5)
#define IP_NORMW in_ptr(6)
#define IP_W13 in_ptr(7)
#define IP_W2 in_ptr(8)
#define IP_WIN in_ptr(9)
#define IP_HLB in_ptr(10)
#define IP_HNW in_ptr(11)
#define IP_CONVW in_ptr(12)
#define IP_LAM in_ptr(13)
#define IP_DANW in_ptr(14)
#define IP_WBR in_ptr(15)
#define IP_WOUT in_ptr(16)
#define IP_FNW in_ptr(17)
#define W_HCTX ((float*)(F.ws + WS_HCTX))
#define W_MOD ((float*)(F.ws + WS_MOD))
#define W_W13T ((bf16*)(F.ws + WS_W13T))
#define W_W2T ((bf16*)(F.ws + WS_W2T))
#define W_WINT ((bf16*)(F.ws + WS_WINT))
#define W_WBT ((bf16*)(F.ws + WS_WBT))
#define W_WOT ((bf16*)(F.ws + WS_WOT))
#define W_XN ((bf16*)(F.ws + WS_XN))
#define W_PROJ ((bf16*)(F.ws + WS_PROJ))
#define W_HID ((bf16*)(F.ws + WS_PROJ))
#define W_ST ((bf16*)(F.ws + WS_ST))
#define W_BR ((bf16*)(F.ws + WS_BR))
#define W_OP ((bf16*)(F.ws + WS_OP))
#define W_Y32 ((float*)(F.ws + WS_ST))
#define W_DEC ((float*)(F.ws + WS_DEC))
#define W_PART ((float*)(F.ws + WS_PART))
#define W_H16 ((bf16*)(F.ws + WS_H16))
#define W_QS ((bf16*)(F.ws + WS_QS))
#define W_KS ((bf16*)(F.ws + WS_KS))
#define W_EMID ((float*)(F.ws + WS_EMID))

__device__ __forceinline__ float wave_sum(float v) {
#pragma unroll
    for (int o = 1; o < 64; o <<= 1) v += __shfl_xor(v, o);
    return v;
}

__device__ __forceinline__ void p_ada(Frame& F) {
    LAS float* sc = (LAS float*)(F.lds + RING_OFF);
    LAS float* red = sc + 3 * D;
    const float* cvec = IP_C; const float* ccv = IP_CCTX; const float* wada = IP_WADA; const float* bada = IP_BADA; float* modp = W_MOD;
    for (int i = F.tid; i < 3 * D; i += NWAVES * 64) { const int g = i / D, k = i - g * D; const float v = (g < 2) ? cvec[g * D + k] : ccv[k]; sc[i] = silu_f(v); }
    __syncthreads();
    const int rr = F.lane >> 3, cg = F.lane & 7;
    for (int unit = F.bx; unit < 2 * (MODW / 32); unit += F.G) {
        const int layer = unit / (MODW / 32), cb = unit - layer * (MODW / 32), col = cb * 32 + 4 * cg;
        const float* W = wada + (size_t)layer * D * MODW + col;
        const int k0 = F.wave * 256 + rr; f32x4 a0 = {0.f, 0.f, 0.f, 0.f}, a1 = a0, a2 = a0;
#pragma unroll 1
        for (int kb = 0; kb < 256; kb += 128) {
            f32x4 wv[16];
#pragma unroll
            for (int i = 0; i < 16; ++i) wv[i] = *(const GAS f32x4*)(W + (size_t)(k0 + kb + 8 * i) * MODW);
#pragma unroll
            for (int i = 0; i < 16; ++i) { const int k = k0 + kb + 8 * i; a0 = a0 + wv[i] * sc[k]; a1 = a1 + wv[i] * sc[D + k]; a2 = a2 + wv[i] * sc[2 * D + k]; }
        }
#pragma unroll
        for (int j = 0; j < 4; ++j) {
#pragma unroll
            for (int o = 8; o < 64; o <<= 1) { a0[j] += __shfl_xor(a0[j], o); a1[j] += __shfl_xor(a1[j], o); a2[j] += __shfl_xor(a2[j], o); } }
        if (rr == 0) { *(LAS f32x4*)(red + (F.wave * 3 + 0) * 32 + 4 * cg) = a0; *(LAS f32x4*)(red + (F.wave * 3 + 1) * 32 + 4 * cg) = a1; *(LAS f32x4*)(red + (F.wave * 3 + 2) * 32 + 4 * cg) = a2; }
        __syncthreads();
        if (F.tid < 96) { const int g = F.tid >> 5, c = F.tid & 31; float t = 0.f;
#pragma unroll
            for (int w = 0; w < 8; ++w) t += red[(w * 3 + g) * 32 + c];
            modp[(size_t)(layer * 3 + g) * MODW + cb * 32 + c] = t + bada[(size_t)layer * MODW + cb * 32 + c]; }
        __syncthreads();
    }
}

struct CvtItem { const float* W; bf16* WT; int K, N, k0, n0, drow0; };
__device__ __forceinline__ void cvt_issue(const CvtItem& I, f32x4 (&t)[8], int lane) {
    const int rr = lane >> 3, cg = lane & 7;
#pragma unroll
    for (int i = 0; i < 8; ++i) t[i] = *(const GAS f32x4*)(I.W + (size_t)(I.k0 + 8 * i + rr) * I.N + I.n0 + 4 * cg);
}
__device__ __forceinline__ void cvt_finish(const CvtItem& I, const f32x4 (&t)[8], LAS float* scr, int lane) {
    { const int rr = lane >> 3, cg = lane & 7;
#pragma unroll
      for (int i = 0; i < 8; ++i) { LAS float* d = scr + (8 * i + rr) * 33 + 4 * cg; d[0] = t[i][0]; d[1] = t[i][1]; d[2] = t[i][2]; d[3] = t[i][3]; } }
    LDS_WAIT(); asm volatile("" ::: "memory");
    const int c = lane & 7;
#pragma unroll
    for (int j = 0; j < 4; ++j) { const int n = (lane >> 3) + 8 * j; const LAS float* s = scr + (8 * c) * 33 + n;
        v4u o; o.x = pk2(s[0 * 33], s[1 * 33]); o.y = pk2(s[2 * 33], s[3 * 33]); o.z = pk2(s[4 * 33], s[5 * 33]); o.w = pk2(s[6 * 33], s[7 * 33]);
        *(GAS v4u*)(I.WT + (size_t)(I.drow0 + n) * I.K + I.k0 + 8 * c) = o; }
    LDS_WAIT(); asm volatile("" ::: "memory");
}
__device__ __forceinline__ void p_convert(Frame& F, int layer) {
    LAS float* scr = (LAS float*)(F.lds + RING_OFF + F.wave * 16384);
    const int gw = F.vcu * NWAVES + F.wave, NGW = F.G * NWAVES;
    constexpr int I13 = (D / 64) * (2 * FF / 32), I2 = (FF / 64) * (D / 32), IIN = (D / 64) * (WIN / 32), IBR = (MIXW / 64) * (D / 32), IOUT = (D / 64) * (D / 32);
    constexpr int NITEMS = 2 * I13 + 2 * I2 + IIN + 3 * IBR + IOUT;
    const float* pw13 = IP_W13; const float* pw2 = IP_W2; const float* pwin = IP_WIN; const float* pwbr = IP_WBR; const float* pwout = IP_WOUT;
    auto decode = [&](int it) -> CvtItem {
        int r = it;
        if (r < 2 * I13) { const int f = r / I13; r -= f * I13; const int nblk = 2 * FF / 32, kb = r / nblk, nb = r - kb * nblk; const int n0 = 32 * nb;
            const int half = n0 >= FF ? 1 : 0, nn = n0 - half * FF; const int drow0 = 256 * (nn >> 7) + 128 * half + (nn & 127);
            return CvtItem{pw13 + (size_t)(layer * 2 + f) * D * 2 * FF, W_W13T + (size_t)f * 2 * FF * D, D, 2 * FF, 64 * kb, n0, drow0}; }
        r -= 2 * I13;
        if (r < 2 * I2) { const int f = r / I2; r -= f * I2; const int nblk = D / 32, kb = r / nblk, nb = r - kb * nblk;
            return CvtItem{pw2 + (size_t)(layer * 2 + f) * FF * D, W_W2T + (size_t)f * D * FF, FF, D, 64 * kb, 32 * nb, 32 * nb}; }
        r -= 2 * I2;
        if (r < IIN) { const int nblk = WIN / 32, kb = r / nblk, nb = r - kb * nblk;
            return CvtItem{pwin + (size_t)layer * D * WIN, W_WINT, D, WIN, 64 * kb, 32 * nb, 32 * nb}; }
        r -= IIN;
        if (r < 3 * IBR) { const int f = r / IBR; r -= f * IBR; const int nblk = D / 32, kb = r / nblk, nb = r - kb * nblk;
            return CvtItem{pwbr + (size_t)(layer * 3 + f) * MIXW * D, W_WBT + (size_t)f * D * MIXW, MIXW, D, 64 * kb, 32 * nb, 32 * nb}; }
        r -= 3 * IBR;
        { const int nblk = D / 32, kb = r / nblk, nb = r - kb * nblk;
            return CvtItem{pwout + (size_t)layer * D * D, W_WOT, D, D, 64 * kb, 32 * nb, 32 * nb}; }
    };
    int it = gw;
    if (it < NITEMS) {
        CvtItem cur = decode(it); f32x4 t[8]; cvt_issue(cur, t, F.lane);
#pragma unroll 1
        for (;;) {
            const int nit = it + NGW; const bool has = nit < NITEMS;
            CvtItem nxt = cur; f32x4 u[8];
            if (has) { nxt = decode(nit); cvt_issue(nxt, u, F.lane); }
            cvt_finish(cur, t, scr, F.lane);
            if (!has) break;
            cur = nxt; it = nit;
#pragma unroll
            for (int i = 0; i < 8; ++i) t[i] = u[i];
        }
    }
    __syncthreads();
}

__device__ __forceinline__ void load_row(f32x4* v, const float* src32, const bf16* src16, int lane) {
    if (src32) { const GAS f32x4* xr = (const GAS f32x4*)src32 + lane;
#pragma unroll
        for (int j = 0; j < 8; ++j) v[j] = xr[64 * j]; }
    else { const GAS v2u* xr = (const GAS v2u*)src16 + lane;
#pragma unroll
        for (int j = 0; j < 8; ++j) { const v2u w = xr[64 * j]; v[j] = (f32x4){bflo(w.x), bfhi(w.x), bflo(w.y), bfhi(w.y)}; } }
}
__device__ __forceinline__ void p_norm(Frame& F, const float* lat32, const float* ctx32, const float* nw, const float* modl, int which, int nrows, int npart) {
    const int gw = F.vcu * NWAVES + F.wave, NGW = F.G * NWAVES;
    for (int row0 = gw; row0 < nrows; row0 += 2 * NGW) {
        const int row1 = row0 + NGW; const bool has1 = row1 < nrows;
        f32x4 v[2][8];
#pragma unroll
        for (int k = 0; k < 2; ++k) { const int row = k ? row1 : row0;
            if (k == 0 || has1) { const float* s32 = row < NLAT ? lat32 : ctx32; if (s32) s32 += (size_t)(row < NLAT ? row : row - NLAT) * D;
                load_row(v[k], s32, W_H16 + (size_t)row * D, F.lane); } }
#pragma unroll
        for (int k = 0; k < 2; ++k) { const int row = k ? row1 : row0;
            if (k == 1 && !has1) break;
            const int g = row < SEQ ? 0 : (row < NLAT ? 1 : 2);
            const float* shift = modl + (size_t)g * MODW + (3 * which) * D; const float* scale = shift + D;
            if (row >= NLAT && npart > 0) {
                for (int p = 0; p < npart; ++p) { const GAS f32x4* pr = (const GAS f32x4*)(W_PART + ((size_t)p * 512 + (row - NLAT)) * D) + F.lane;
#pragma unroll
                    for (int j = 0; j < 8; ++j) v[k][j] = v[k][j] + pr[64 * j]; }
                GAS v2u* hw = (GAS v2u*)(W_H16 + (size_t)row * D) + F.lane;
#pragma unroll
                for (int j = 0; j < 8; ++j) { v2u w; w.x = pk2(v[k][j].x, v[k][j].y); w.y = pk2(v[k][j].z, v[k][j].w); hw[64 * j] = w;
                    v[k][j] = (f32x4){bflo(w.x), bfhi(w.x), bflo(w.y), bfhi(w.y)}; }
            }
            float s = 0.f;
#pragma unroll
            for (int j = 0; j < 8; ++j) s += (v[k][j].x * v[k][j].x + v[k][j].y * v[k][j].y) + (v[k][j].z * v[k][j].z + v[k][j].w * v[k][j].w);
            const float rstd = __builtin_amdgcn_rsqf(wave_sum(s) * (1.f / D) + EPS);
            GAS v2u* o8 = (GAS v2u*)(W_XN + (size_t)row * D) + F.lane;
#pragma unroll
            for (int j = 0; j < 8; ++j) { const int c = 4 * (F.lane + 64 * j);
                const f32x4 wv = *(const f32x4*)(nw + c), sc = *(const f32x4*)(scale + c), sh = *(const f32x4*)(shift + c);
                const f32x4 y = (v[k][j] * rstd) * wv * (sc + 1.0f) + sh;
                v2u w; w.x = pk2(y.x, y.y); w.y = pk2(y.z, y.w); o8[64 * j] = w; }
        }
    }
}
__device__ __forceinline__ void p_final(Frame& F) {
    const int gw = F.vcu * NWAVES + F.wave, NGW = F.G * NWAVES; const float* fnw = IP_FNW;
    for (int row = gw; row < NLAT; row += NGW) {
        f32x4 v[8]; float s = 0.f; load_row(v, nullptr, W_H16 + (size_t)row * D, F.lane);
#pragma unroll
        for (int j = 0; j < 8; ++j) s += (v[j].x * v[j].x + v[j].y * v[j].y) + (v[j].z * v[j].z + v[j].w * v[j].w);
        const float rstd = __builtin_amdgcn_rsqf(wave_sum(s) * (1.f / D) + EPS);
        GAS f32x4* xr = (GAS f32x4*)(F.out + (size_t)row * D) + F.lane;
#pragma unroll
        for (int j = 0; j < 8; ++j) { const int c = 4 * (F.lane + 64 * j); const f32x4 wv = *(const f32x4*)(fnw + c); xr[64 * j] = (v[j] * rstd) * wv; }
    }
}

constexpr float QSCALE = 0.125f * 1.4426950408889634f;
__device__ __forceinline__ void p_rope(Frame& F, int layer) {
    const int gw = F.vcu * NWAVES + F.wave, NGW = F.G * NWAVES;
    const int nrows = layer == 0 ? MTOT : NLAT;
    for (int row = gw; row < nrows; row += NGW) {
        const int t = row & (SEQ - 1), prow = t >> 6, pcol = t & 63;
        bf16* base = W_PROJ + (size_t)row * WIN + C_AQ;
        if (row >= NLAT) {
#pragma unroll
            for (int s = 0; s < 2; ++s) { bf16* pa = base + 8 * (F.lane + 64 * s); const v4u xa = *(const v4u*)pa; v4u wa;
                wa.x = pk2(bflo(xa.x) * QSCALE, bfhi(xa.x) * QSCALE); wa.y = pk2(bflo(xa.y) * QSCALE, bfhi(xa.y) * QSCALE); wa.z = pk2(bflo(xa.z) * QSCALE, bfhi(xa.z) * QSCALE); wa.w = pk2(bflo(xa.w) * QSCALE, bfhi(xa.w) * QSCALE);
                *(v4u*)pa = wa; }
            continue;
        }
#pragma unroll
        for (int s = 0; s < 2; ++s) {
            const int item = F.lane + 64 * s, grp = item >> 1, half = item & 1;
            bf16* pa = base + grp * 32 + 8 * half; bf16* pb = pa + 16;
            const v4u xa = *(const v4u*)pa, xb = *(const v4u*)pb;
            const float pos = (float)((grp & 1) ? pcol : prow);
            const float osc = grp < 32 ? QSCALE : 1.0f;
            float a[8], b[8];
            a[0] = bflo(xa.x); a[1] = bfhi(xa.x); a[2] = bflo(xa.y); a[3] = bfhi(xa.y); a[4] = bflo(xa.z); a[5] = bfhi(xa.z); a[6] = bflo(xa.w); a[7] = bfhi(xa.w);
            b[0] = bflo(xb.x); b[1] = bfhi(xb.x); b[2] = bflo(xb.y); b[3] = bfhi(xb.y); b[4] = bflo(xb.z); b[5] = bfhi(xb.z); b[6] = bflo(xb.w); b[7] = bfhi(xb.w);
            float oa[8], ob[8];
#pragma unroll
            for (int e = 0; e < 8; ++e) { const int d = 8 * half + e;
                const float invf = exp2f(-(float)d * (13.287712379549449f / 16.0f));
                const float rev = pos * invf * 0.15915494309189535f;
                const float fr = rev - floorf(rev);
                const float sn = __builtin_amdgcn_sinf(fr) * osc, cs = __builtin_amdgcn_cosf(fr) * osc;
                oa[e] = a[e] * cs - b[e] * sn; ob[e] = b[e] * cs + a[e] * sn; }
            v4u wa, wb;
            wa.x = pk2(oa[0], oa[1]); wa.y = pk2(oa[2], oa[3]); wa.z = pk2(oa[4], oa[5]); wa.w = pk2(oa[6], oa[7]);
            wb.x = pk2(ob[0], ob[1]); wb.y = pk2(ob[2], ob[3]); wb.z = pk2(ob[4], ob[5]); wb.w = pk2(ob[6], ob[7]);
            *(v4u*)pa = wa; *(v4u*)pb = wb;
        }
    }
}

constexpr float LOG2E_F = 1.4426950408889634f, HG_CLAMP2 = 80.f * 1.4426950408889634f;
__device__ __forceinline__ void hg_gate(float z, float lb, float& l2f, float& kv) {
    const float e = __builtin_amdgcn_exp2f(-fabsf(z) * LOG2E_F), r = __builtin_amdgcn_rcpf(1.0f + e), er = e * r;
    const bool pos = z >= 0.f, haslb = lb > 0.f;
    const float sig = pos ? r : er, nsig = pos ? er : r, omlb = 1.0f - lb;
    kv = omlb * nsig;
    const float lg = __builtin_amdgcn_logf(haslb ? lb + omlb * sig : 1.0f + e);
    l2f = haslb ? lg : fminf(z, 0.f) * LOG2E_F - lg;
}
__device__ __forceinline__ int chunk_row(int b, int c) { return c < 4 ? NLAT + CTXL * b + 64 * c : SEQ * b + 64 * (c - 4); }
__device__ __forceinline__ void unpack16(const v4u a, const v4u b, float* o) {
    o[0] = bflo(a.x); o[1] = bfhi(a.x); o[2] = bflo(a.y); o[3] = bfhi(a.y); o[4] = bflo(a.z); o[5] = bfhi(a.z); o[6] = bflo(a.w); o[7] = bfhi(a.w);
    o[8] = bflo(b.x); o[9] = bfhi(b.x); o[10] = bflo(b.y); o[11] = bfhi(b.y); o[12] = bflo(b.z); o[13] = bfhi(b.z); o[14] = bflo(b.w); o[15] = bfhi(b.w);
}
__device__ __forceinline__ float scan_dpp(float x) {
    x += __builtin_bit_cast(float, __builtin_amdgcn_update_dpp(0, __builtin_bit_cast(int, x), 0x111, 0xf, 0xf, true));
    x += __builtin_bit_cast(float, __builtin_amdgcn_update_dpp(0, __builtin_bit_cast(int, x), 0x112, 0xf, 0xf, true));
    x += __builtin_bit_cast(float, __builtin_amdgcn_update_dpp(0, __builtin_bit_cast(int, x), 0x114, 0xf, 0xf, true));
    x += __builtin_bit_cast(float, __builtin_amdgcn_update_dpp(0, __builtin_bit_cast(int, x), 0x118, 0xf, 0xf, true));
    x += __builtin_bit_cast(float, __builtin_amdgcn_update_dpp(0, __builtin_bit_cast(int, x), 0x142, 0xa, 0xf, true));
    x += __builtin_bit_cast(float, __builtin_amdgcn_update_dpp(0, __builtin_bit_cast(int, x), 0x143, 0xc, 0xf, true));
    return x;
}
__device__ __forceinline__ void scan16(float* cum, int lane) {
    (void)lane;
#pragma unroll
    for (int e = 0; e < 16; ++e) cum[e] = scan_dpp(cum[e]);
}
__device__ __forceinline__ bf16x8 ldfrag(const LAS unsigned char* base, int row, int stride, int kbyte) { return *(const LAS bf16x8*)(base + row * stride + kbyte); }

__device__ __forceinline__ void fill_lb(Frame& F, LAS float* lbs, int layer) {
    const float* hlb = IP_HLB;
    for (int i = F.tid; i < 2048; i += NWAVES * 64) { const int dir = i >> 10, ch = i & 1023; float lb = 0.f;
        if (layer) lb = sigm_f(hlb[(dir * 2 + 1) * 1024 + ch] - hlb[(dir * 2 + 0) * 1024 + ch]);
        lbs[i] = lb; }
    __syncthreads();
}
constexpr int H_KT = 0, H_VT = 18432, H_ESC = 36864, H_SET = 37888, H_LB = 2 * H_SET;
__device__ __forceinline__ void p_h1(Frame& F, int layer, int nrep = 1) {
    LAS unsigned char* L = F.lds + RING_OFF;
    const int lane = F.lane, w = F.wave, fr = lane & 15, fq = lane >> 4;
    LAS float* lbs = (LAS float*)(L + H_LB); fill_lb(F, lbs, layer);
    int pbuf = 0;
    v4u nz0, nz1, nv0, nv1, nq0, nq1;
    auto unit_rowp = [&](int uu_) -> const bf16* { const int u_ = uu_ % (NSEQ * NCHUNK); const int s_ = u_ / NCHUNK, c_ = u_ - s_ * NCHUNK, b_ = s_ >> 4, dir_ = (s_ >> 3) & 1, h_ = s_ & 7;
        return W_PROJ + (size_t)(chunk_row(b_, c_) + (dir_ ? 63 - lane : lane)) * WIN + 128 * h_ + 16 * w; };
#define H1_REQ(uu_) do { const bf16* rp = unit_rowp(uu_); const int s_ = ((uu_) % (NSEQ * NCHUNK)) / NCHUNK, dir_ = (s_ >> 3) & 1; const int zc = dir_ ? C_HB : C_HF; \
        nz0 = *(const v4u*)(rp + zc); nz1 = *(const v4u*)(rp + zc + 8); nv0 = *(const v4u*)(rp + C_HI); nv1 = *(const v4u*)(rp + C_HI + 8); nq0 = *(const v4u*)(rp + C_HQ); nq1 = *(const v4u*)(rp + C_HQ + 8); } while (0)
    if (F.bx < NSEQ * NCHUNK * nrep) H1_REQ(F.bx);
    for (int uu = F.bx; uu < NSEQ * NCHUNK * nrep; uu += F.G) {
        const int u = uu % (NSEQ * NCHUNK);
        const int s = u / NCHUNK, dir = (s >> 3) & 1;
        const int tok = dir ? 63 - lane : lane;
        LAS unsigned char* Ls = L + pbuf * H_SET; pbuf ^= 1;
        LAS bf16* KT = (LAS bf16*)(Ls + H_KT); LAS bf16* VT = (LAS bf16*)(Ls + H_VT); LAS float* esc = (LAS float*)(Ls + H_ESC);
        const v4u z0 = nz0, z1 = nz1, v0 = nv0, v1 = nv1, q0 = nq0, q1 = nq1;
        if (uu + F.G < NSEQ * NCHUNK * nrep) H1_REQ(uu + F.G);
        float z[16], cum[16], kv[16], q[16]; unpack16(z0, z1, z); unpack16(q0, q1, q);
#pragma unroll
        for (int e = 0; e < 16; ++e) hg_gate(z[e], lbs[dir * 1024 + 128 * (s & 7) + 16 * w + e], cum[e], kv[e]);
        scan16(cum, lane);
        const unsigned vw[8] = {v0.x, v0.y, v0.z, v0.w, v1.x, v1.y, v1.z, v1.w};
        unsigned kp[8], qp[8];
        float mcm = 0.f, mce = 0.f;
#pragma unroll
        for (int i = 0; i < 8; ++i) { float ksv[2], qsv[2];
#pragma unroll
            for (int t = 0; t < 2; ++t) { const int e = 2 * i + t;
                const float cmid = __builtin_bit_cast(float, __builtin_amdgcn_readlane(__builtin_bit_cast(int, cum[e]), 31)), cend = __builtin_bit_cast(float, __builtin_amdgcn_readlane(__builtin_bit_cast(int, cum[e]), 63));
                const float dlt = cmid - cum[e];
                ksv[t] = kv[e] * __builtin_amdgcn_exp2f(fminf(dlt, HG_CLAMP2)); qsv[t] = q[e] * __builtin_amdgcn_exp2f(fminf(-dlt, HG_CLAMP2));
                mcm = lane == e ? cmid : mcm; mce = lane == e ? cend : mce; }
            kp[i] = pk2(ksv[0], ksv[1]); qp[i] = pk2(qsv[0], qsv[1]);
            KT[(16 * w + 2 * i) * 72 + tok] = (bf16)(kp[i] & 0xffffu); KT[(16 * w + 2 * i + 1) * 72 + tok] = (bf16)(kp[i] >> 16);
            VT[(16 * w + 2 * i) * 72 + tok] = (bf16)(vw[i] & 0xffffu); VT[(16 * w + 2 * i + 1) * 72 + tok] = (bf16)(vw[i] >> 16); }
        if (lane < 16) { esc[16 * w + lane] = __builtin_amdgcn_exp2f(mce - mcm); W_DEC[(size_t)u * 128 + 16 * w + lane] = __builtin_amdgcn_exp2f(mce); W_EMID[(size_t)u * 128 + 16 * w + lane] = __builtin_amdgcn_exp2f(mcm); }
        { bf16* kd = W_KS + ((size_t)u * 64 + tok) * 128 + 16 * w; bf16* qd = W_QS + ((size_t)u * 64 + tok) * 128 + 16 * w;
          *(v4u*)kd = (v4u){kp[0], kp[1], kp[2], kp[3]}; *(v4u*)(kd + 8) = (v4u){kp[4], kp[5], kp[6], kp[7]};
          *(v4u*)qd = (v4u){qp[0], qp[1], qp[2], qp[3]}; *(v4u*)(qd + 8) = (v4u){qp[4], qp[5], qp[6], qp[7]};
#if defined(PROBE_XW)
          { bf16* xd = W_XN + ((size_t)u * 64 + tok) * 128 + 16 * w; *(v4u*)xd = (v4u){kp[0], kp[1], kp[2], kp[3]}; *(v4u*)(xd + 8) = (v4u){kp[4], kp[5], kp[6], kp[7]}; }
#endif
        }
        __syncthreads();
        f32x4 acc[8];
#pragma unroll
        for (int nb = 0; nb < 8; ++nb) acc[nb] = (f32x4){0.f, 0.f, 0.f, 0.f};
#pragma unroll
        for (int ks = 0; ks < 2; ++ks) { const bf16x8 a = ldfrag((const LAS unsigned char*)KT, 16 * w + fr, 144, (32 * ks + 8 * fq) * 2);
#pragma unroll
            for (int nb = 0; nb < 8; ++nb) { const bf16x8 bb = ldfrag((const LAS unsigned char*)VT, 16 * nb + fr, 144, (32 * ks + 8 * fq) * 2);
                acc[nb] = __builtin_amdgcn_mfma_f32_16x16x32_bf16(a, bb, acc[nb], 0, 0, 0); } }
        const f32x4 e4 = *(const LAS f32x4*)(esc + 16 * w + 4 * fq);
        bf16* dst = W_ST + (size_t)u * 16384 + 16 * w + 4 * fq;
#pragma unroll
        for (int nb = 0; nb < 8; ++nb) { const f32x4 val = acc[nb] * e4; v2u o; o.x = pk2(val[0], val[1]); o.y = pk2(val[2], val[3]); *(v2u*)(dst + (size_t)(16 * nb + fr) * 128) = o; }
    }
#undef H1_REQ
    __syncthreads();
}

__device__ __forceinline__ void p_h2(Frame& F) {
    for (int unit = F.bx; unit < NSEQ * 8; unit += F.G) {
        const int s = unit >> 3, slice = unit & 7, dir = (s >> 3) & 1;
        const int e0 = slice * 2048 + 4 * F.tid, dk0 = e0 & 127;
        float S[4] = {0.f, 0.f, 0.f, 0.f};
        for (int st = 0; st < NCHUNK; st += 4) {
            v2u uu[4]; f32x4 dd[4], em[4]; bf16* pp[4];
#pragma unroll
            for (int i = 0; i < 4; ++i) { const int step = st + i; const int c = dir == 0 ? step : (step < 4 ? 3 - step : 135 - step); const size_t u = (size_t)s * NCHUNK + c;
                pp[i] = W_ST + u * 16384 + e0; uu[i] = *(const v2u*)pp[i]; dd[i] = *(const f32x4*)(W_DEC + u * 128 + dk0); em[i] = *(const f32x4*)(W_EMID + u * 128 + dk0); }
#pragma unroll
            for (int i = 0; i < 4; ++i) { v2u o; o.x = pk2(S[0] * em[i][0], S[1] * em[i][1]); o.y = pk2(S[2] * em[i][2], S[3] * em[i][3]); *(v2u*)pp[i] = o;
                S[0] = dd[i][0] * S[0] + bflo(uu[i].x); S[1] = dd[i][1] * S[1] + bfhi(uu[i].x); S[2] = dd[i][2] * S[2] + bflo(uu[i].y); S[3] = dd[i][3] * S[3] + bfhi(uu[i].y); }
        }
    }
}

constexpr int H3_QK = 0, H3_QKSET = 34816, H3_VT = 69632, H3_P = 88064, H3_SS = 97280;
__device__ __forceinline__ void p_h3(Frame& F, int layer) {
    LAS unsigned char* L = F.lds + RING_OFF;
    LAS bf16* VT = (LAS bf16*)(L + H3_VT); LAS bf16* Ps = (LAS bf16*)(L + H3_P); LAS float* ssq = (LAS float*)(L + H3_SS);
    const int lane = F.lane, w = F.wave, fr = lane & 15, fq = lane >> 4;
    const float* hnw = IP_HNW;
    const int c_lo = layer ? 4 : 0, ncpb = NCHUNK - c_lo;
    const int nunits = 16 * ncpb;
    v4u nq[2], nk[2], ns[4], nv0, nv1;
    auto h1unit = [&](int u_, int dir_) -> size_t { const int bh_ = u_ / ncpb, c_ = c_lo + (u_ - bh_ * ncpb), b_ = bh_ >> 3, h_ = bh_ & 7; return ((size_t)((b_ * 2 + dir_) * 8 + h_)) * NCHUNK + c_; };
#define H3_REQ(u_, dir_) do { const size_t us_ = h1unit(u_, dir_); const bf16* qp_ = W_QS + us_ * 8192 + 8 * F.tid; const bf16* kp_ = W_KS + us_ * 8192 + 8 * F.tid; \
        nq[0] = *(const v4u*)qp_; nq[1] = *(const v4u*)(qp_ + 4096); nk[0] = *(const v4u*)kp_; nk[1] = *(const v4u*)(kp_ + 4096); \
        const bf16* sp_ = W_ST + us_ * 16384 + (16 * w + fr) * 128 + 8 * fq; \
        ns[0] = *(const v4u*)sp_; ns[1] = *(const v4u*)(sp_ + 32); ns[2] = *(const v4u*)(sp_ + 64); ns[3] = *(const v4u*)(sp_ + 96); } while (0)
#define H3_REQV(u_) do { const int bh_ = (u_) / ncpb, c_ = c_lo + ((u_) - bh_ * ncpb), b_ = bh_ >> 3, h_ = bh_ & 7; \
        const bf16* vp_ = W_PROJ + (size_t)(chunk_row(b_, c_) + lane) * WIN + C_HI + 128 * h_ + 16 * w; nv0 = *(const v4u*)vp_; nv1 = *(const v4u*)(vp_ + 8); } while (0)
    if (F.bx < nunits) { H3_REQ(F.bx, 0); H3_REQV(F.bx); }
    int pbuf = 0;
    for (int u = F.bx; u < nunits; u += F.G) {
        const int bh = u / ncpb, c = c_lo + (u - bh * ncpb), b = bh >> 3, h = bh & 7;
        const int rb = chunk_row(b, c), ch0 = 128 * h + 16 * w;
        f32x4 acc[4];
#pragma unroll
        for (int tb = 0; tb < 4; ++tb) acc[tb] = (f32x4){0.f, 0.f, 0.f, 0.f};
        v2u gv[4];
#pragma unroll 1
        for (int dir = 0; dir < 2; ++dir) {
            LAS bf16* Qs = (LAS bf16*)(L + H3_QK + pbuf * H3_QKSET); LAS bf16* Ks = Qs + 64 * 136; pbuf ^= 1;
            const v4u sv0 = ns[0], sv1 = ns[1], sv2 = ns[2], sv3 = ns[3];
#pragma unroll
            for (int j = 0; j < 2; ++j) { const int pc = F.tid + 512 * j; *(LAS v4u*)(Qs + (pc >> 4) * 136 + 8 * (pc & 15)) = nq[j]; *(LAS v4u*)(Ks + (pc >> 4) * 136 + 8 * (pc & 15)) = nk[j]; }
            if (dir == 0) {
                const unsigned ww[8] = {nv0.x, nv0.y, nv0.z, nv0.w, nv1.x, nv1.y, nv1.z, nv1.w};
#pragma unroll
                for (int e = 0; e < 8; ++e) { VT[(16 * w + 2 * e) * 72 + lane] = (bf16)(ww[e] & 0xffffu); VT[(16 * w + 2 * e + 1) * 72 + lane] = (bf16)(ww[e] >> 16); }
            } else {
#pragma unroll
                for (int tb = 0; tb < 4; ++tb) gv[tb] = *(const v2u*)(W_PROJ + (size_t)(rb + 16 * tb + fr) * WIN + C_HG + ch0 + 4 * fq);
            }
            __syncthreads();
            { const int nu = dir ? u + F.G : u, nd = dir ^ 1;
              if (nu < nunits) { H3_REQ(nu, nd); if (dir) H3_REQV(nu); } }
#pragma unroll
            for (int bi = 0; bi < 2; ++bi) { const int blk = 2 * w + bi, I = blk >> 2, J = blk & 3;
                f32x4 pacc = (f32x4){0.f, 0.f, 0.f, 0.f};
                const bool need = dir == 0 ? (J <= I) : (J >= I);
                if (need) {
#pragma unroll
                    for (int ks4 = 0; ks4 < 4; ++ks4) { const bf16x8 a = ldfrag((const LAS unsigned char*)Ks, 16 * J + fr, 272, (32 * ks4 + 8 * fq) * 2), bb = ldfrag((const LAS unsigned char*)Qs, 16 * I + fr, 272, (32 * ks4 + 8 * fq) * 2);
                        pacc = __builtin_amdgcn_mfma_f32_16x16x32_bf16(a, bb, pacc, 0, 0, 0); }
                    if (I == J) {
#pragma unroll
                        for (int r = 0; r < 4; ++r) { const int jj = 4 * fq + r; const bool keep = dir == 0 ? (jj <= fr) : (jj >= fr); if (!keep) pacc[r] = 0.f; } }
                }
                v2u o; o.x = pk2(pacc[0], pacc[1]); o.y = pk2(pacc[2], pacc[3]);
                *(LAS v2u*)(Ps + (16 * I + fr) * 72 + 16 * J + 4 * fq) = o; }
            __syncthreads();
#pragma unroll
            for (int ks2 = 0; ks2 < 2; ++ks2) { const bf16x8 a = ldfrag((const LAS unsigned char*)VT, 16 * w + fr, 144, (32 * ks2 + 8 * fq) * 2);
#pragma unroll
                for (int tb = 0; tb < 4; ++tb) { const bf16x8 bb = ldfrag((const LAS unsigned char*)Ps, 16 * tb + fr, 144, (32 * ks2 + 8 * fq) * 2);
                    acc[tb] = __builtin_amdgcn_mfma_f32_16x16x32_bf16(a, bb, acc[tb], 0, 0, 0); } }
#pragma unroll
            for (int ks4 = 0; ks4 < 4; ++ks4) { const v4u sraw = ks4 == 0 ? sv0 : ks4 == 1 ? sv1 : ks4 == 2 ? sv2 : sv3; const bf16x8 a = __builtin_bit_cast(bf16x8, sraw);
#pragma unroll
                for (int tb = 0; tb < 4; ++tb) { const bf16x8 bb = ldfrag((const LAS unsigned char*)Qs, 16 * tb + fr, 272, (32 * ks4 + 8 * fq) * 2);
                    acc[tb] = __builtin_amdgcn_mfma_f32_16x16x32_bf16(a, bb, acc[tb], 0, 0, 0); } }
        }
#pragma unroll
        for (int tb = 0; tb < 4; ++tb) { float p = (acc[tb][0] * acc[tb][0] + acc[tb][1] * acc[tb][1]) + (acc[tb][2] * acc[tb][2] + acc[tb][3] * acc[tb][3]);
            p += __shfl_xor(p, 16); p += __shfl_xor(p, 32);
            if (fq == 0) ssq[w * 64 + 16 * tb + fr] = p; }
        __syncthreads();
        const f32x4 nwv = *(const f32x4*)(hnw + layer * 128 + 16 * w + 4 * fq);
#pragma unroll
        for (int tb = 0; tb < 4; ++tb) { const int tk = 16 * tb + fr; float tot = 0.f;
#pragma unroll
            for (int ww = 0; ww < 8; ++ww) tot += ssq[ww * 64 + tk];
            const float rstd = __builtin_amdgcn_rsqf(tot * (1.f / 128.f) + EPS);
            const size_t row = (size_t)(rb + tk);
            const float y0 = acc[tb][0] * rstd * nwv[0] * silu_f(bflo(gv[tb].x)), y1 = acc[tb][1] * rstd * nwv[1] * silu_f(bfhi(gv[tb].x));
            const float y2 = acc[tb][2] * rstd * nwv[2] * silu_f(bflo(gv[tb].y)), y3 = acc[tb][3] * rstd * nwv[3] * silu_f(bfhi(gv[tb].y));
            v2u o; o.x = pk2(y0, y1); o.y = pk2(y2, y3);
            *(v2u*)(W_BR + row * MIXW + ch0 + 4 * fq) = o; }
    }
#undef H3_REQ
#undef H3_REQV
    __syncthreads();
}

__device__ __forceinline__ void p_pm(Frame& F, int layer, int nrows) {
    const int gw = F.vcu * NWAVES + F.wave, NGW = F.G * NWAVES, lane = F.lane;
    const float* cw = IP_CONVW + (size_t)layer * 3 * MIXW;
    bf16* B1 = W_BR + (size_t)MTOT * MIXW;
    for (int row = gw; row < nrows; row += NGW) {
        int pos, len; if (row < NLAT) { pos = row & (SEQ - 1); len = SEQ; } else { pos = (row - NLAT) & (CTXL - 1); len = CTXL; }
        const bool hasp = pos > 0, hasn = pos < len - 1;
        const bf16* pr = W_PROJ + (size_t)row * WIN;
#pragma unroll
        for (int s = 0; s < 2; ++s) {
            const int c0 = 512 * s + 8 * lane;
            float cbv[8], pm[8], pc[8], pn[8];
            { const v4u a = *(const v4u*)(pr + C_CB + c0); cbv[0] = bflo(a.x); cbv[1] = bfhi(a.x); cbv[2] = bflo(a.y); cbv[3] = bfhi(a.y); cbv[4] = bflo(a.z); cbv[5] = bfhi(a.z); cbv[6] = bflo(a.w); cbv[7] = bfhi(a.w); }
#define LDPROD(dst, rp) do { const v4u a_ = *(const v4u*)((rp) + C_CC + c0), b_ = *(const v4u*)((rp) + C_CU + c0); \
            dst[0] = bflo(a_.x) * bflo(b_.x); dst[1] = bfhi(a_.x) * bfhi(b_.x); dst[2] = bflo(a_.y) * bflo(b_.y); dst[3] = bfhi(a_.y) * bfhi(b_.y); \
            dst[4] = bflo(a_.z) * bflo(b_.z); dst[5] = bfhi(a_.z) * bfhi(b_.z); dst[6] = bflo(a_.w) * bflo(b_.w); dst[7] = bfhi(a_.w) * bfhi(b_.w); } while (0)
            LDPROD(pc, pr);
            if (hasp) { LDPROD(pm, pr - WIN); } else {
#pragma unroll
                for (int e = 0; e < 8; ++e) pm[e] = 0.f; }
            if (hasn) { LDPROD(pn, pr + WIN); } else {
#pragma unroll
                for (int e = 0; e < 8; ++e) pn[e] = 0.f; }
#undef LDPROD
            float yb[8];
#pragma unroll
            for (int e = 0; e < 8; ++e) yb[e] = cbv[e] * (cw[c0 + e] * pm[e] + cw[MIXW + c0 + e] * pc[e] + cw[2 * MIXW + c0 + e] * pn[e]);
            { v4u o; o.x = pk2(yb[0], yb[1]); o.y = pk2(yb[2], yb[3]); o.z = pk2(yb[4], yb[5]); o.w = pk2(yb[6], yb[7]); *(v4u*)(B1 + (size_t)row * MIXW + c0) = o; }
        }
    }
}

__device__ __forceinline__ void p_attn(Frame& F, int layer, char* ldsg) {
    const float lam_init = 0.8f - 0.6f * expf(-0.3f * (float)layer);
    float lam;
    { const float* lp = IP_LAM + layer * 256; const float s1 = wave_sum(lp[F.lane] * lp[64 + F.lane]), s2 = wave_sum(lp[128 + F.lane] * lp[192 + F.lane]); lam = expf(s1) - expf(s2) + lam_init; }
    const float* danw = IP_DANW + layer * 128; bf16* B2 = W_BR + (size_t)2 * MTOT * MIXW;
    const int nunits = 512 + (layer == 0 ? 16 : 0);
    for (int id = F.vcu; id < nunits; id += F.G) {
        unsigned* held = (unsigned*)W_OP + ((size_t)(((id - F.vcu) / F.G) * F.G + F.bx) * 512 + F.tid) * 32;
        if (id < 512) { const int qb = id & 31, h = (id >> 5) & 7, b = id >> 8;
#pragma unroll 1
            for (int p = 0; p < 2; ++p) att::attn_unit(W_PROJ, SEQ * b + 256 * qb, NLAT + CTXL * b, SEQ * b, NCHUNK, h, p, held, lam, 1.0f - lam_init, danw, B2, ldsg); }
        else { const int j = id - 512, h = j & 7, b = j >> 3;
#pragma unroll 1
            for (int p = 0; p < 2; ++p) att::attn_unit(W_PROJ, NLAT + CTXL * b, NLAT + CTXL * b, SEQ * b, 4, h, p, held, lam, 1.0f - lam_init, danw, B2, ldsg); }
    }
}
struct Args { const float* in[18]; float* out; unsigned char* ws; int ph_lo, ph_hi, li, pad; };
__global__ void __launch_bounds__(NWAVES * 64, 2) mk_fwd(Args args) {
    extern __shared__ __attribute__((aligned(16))) unsigned char lds[];
    Frame F;
    F.lds = (LAS unsigned char*)lds;
    F.MISC = (volatile LAS unsigned*)(F.lds + MISC_OFF);
    F.tid = threadIdx.x; F.lane = F.tid & 63; F.wave = __builtin_amdgcn_readfirstlane(F.tid >> 6);
    F.G = gridDim.x; F.bx = blockIdx.x; { const int bx = blockIdx.x; F.vcu = (F.G % 8 == 0) ? (bx % 8) * (F.G / 8) + bx / 8 : bx; }
    F.ws = args.ws; F.out = args.out;
    F.ctl = (gu32*)(F.ws + WS_CTL);
    for (int u = F.tid; u < (LDS_BYTES - LDSCTL_OFF) / 4; u += NWAVES * 64) ((LAS unsigned*)(F.lds + LDSCTL_OFF))[u] = 0u;
    __syncthreads();
    XcdBarrier bar; bar.bar = (unsigned*)(F.ctl + CW_BAR) + args.li * XCD_BAR_WORDS; bar.x = 0; bar.st = nullptr;
    if (MK_N_LAUNCHES == 1) bar = xcd_barrier_post((unsigned*)(F.ctl + CW_BAR), F.MISC + 8);
    const int lo = args.ph_lo, hi = args.ph_hi;
#ifndef PHMASK
#define PHMASK 0x7fff
#endif
#define PON(b) (((PHMASK) >> (b)) & 1)
#define IN(k) (lo <= (k) && (k) < hi)
#ifndef PROBE_PH
#define PROBE_PH -1
#define PROBE_REP 0
#endif
#define PHASE(cond, id) if (cond) _Pragma("unroll 1") for (int rep_ = 0, nrep_ = ((id) == PROBE_PH ? 1 + PROBE_REP : 1); rep_ < nrep_; ++rep_) { Frame P_ = F; launder(P_); { Frame& F = P_; (void)F;
#define POUT(p, scr) ((rep_ < nrep_ - 1) ? (scr) : (p))
#define PHASE_END } }
#if defined(PROBE_TMASK)
    unsigned long long t_prev = __builtin_amdgcn_s_memrealtime(), t_acc = 0ull;
#define TSTAMP(id) do { const unsigned long long now_ = __builtin_amdgcn_s_memrealtime(); if (((PROBE_TMASK) >> (id)) & 1) t_acc += now_ - t_prev; t_prev = now_; } while (0)
#else
#define TSTAMP(id) do { } while (0)
#endif
#define SEAM(k) do { if (IN(k) && IN((k) + 1)) xcd_barrier(bar); } while (0)

    PHASE(PON(13) && IN(0), 13) p_ada(F); p_convert(F, 0); PHASE_END
    SEAM(0); TSTAMP(13);
    if (PROBE_PH == 200) { for (int q_ = 0; q_ < PROBE_REP; ++q_) xcd_barrier(bar); }

#pragma unroll 1
    for (int l = 0; l < 2; ++l) {
        const int pb = 1 + l * NPL;
        const float* modl = W_MOD + (size_t)l * 3 * MODW;
        const int Mm = (l == 1) ? NLAT : MTOT;
        const float* hl = (l == 0) ? IP_X : (const float*)nullptr; const float* hc = (l == 0) ? IP_CTX : (const float*)nullptr;
        PHASE(PON(0) && IN(pb + 0), 0) if (l == 1) p_convert(F, 1); p_norm(F, hl, hc, IP_NORMW + (size_t)(l * 3 + 0) * D, modl, 0, MTOT, l == 1 ? 11 : 0);  PHASE_END
        SEAM(pb + 0); TSTAMP(0);
        PHASE(PON(1) && IN(pb + 1), 1) pg8::Gemm g{W_XN, W_W13T, MTOT, 2 * FF, D}; pg8::StaticOrder S; S.init(MTOT, 2 * FF, F.G, F.bx);
            pg8::EpiSwiglu E{W_HID, FF}; pg8::gemm_phase<pg8::EpiSwiglu, pg8::StaticOrder, true, true>(F.lds + RING_OFF, g, S, E);  PHASE_END
        SEAM(pb + 1); TSTAMP(1);
        PHASE(PON(2) && IN(pb + 2), 2)
            { pg8::Gemm g{W_HID, W_W2T, NLAT, D, FF}; pg8::StaticOrder S; S.init(NLAT, D, F.G, F.bx, WGM_N8);
              pg8::EpiResid E{hl, W_H16, POUT(W_H16, (bf16*)W_Y32), modl + 2 * D, 0.5f, 0.f}; pg8::gemm_phase<pg8::EpiResid, pg8::StaticOrder, true, true>(F.lds + RING_OFF, g, S, E); }
            { pg8::Gemm g{W_HID + (size_t)NLAT * FF, W_W2T, NCTX, D, 512, FF}; pg8::SplitKOrder S; S.init(NCTX, D, 11, F.G, F.bx);
              pg8::EpiPartial E{W_PART, modl + 2 * MODW + 2 * D, 0.5f}; pg8::gemm_phase<pg8::EpiPartial, pg8::SplitKOrder, true, true>(F.lds + RING_OFF, g, S, E); }
         PHASE_END
        SEAM(pb + 2); TSTAMP(2);
        PHASE(PON(3) && IN(pb + 3), 3) p_norm(F, nullptr, hc, IP_NORMW + (size_t)(l * 3 + 1) * D, modl, 1, MTOT, 11); PHASE_END
        SEAM(pb + 3); TSTAMP(3);
        PHASE(PON(4) && IN(pb + 4), 4) pg8::Gemm g{W_XN, W_WINT, MTOT, WIN, D}; pg8::StaticOrder S; S.init(MTOT, WIN, F.G, F.bx);
            pg8::EpiStoreBf16 E{W_PROJ, WIN, C_AQ / 256, C_AV / 256, QSCALE, C_GA / 256}; pg8::gemm_phase<pg8::EpiStoreBf16, pg8::StaticOrder, true, true>(F.lds + RING_OFF, g, S, E); if (PROBE_PH == 104) { for (int q_ = 0; q_ < PROBE_REP; ++q_) p_h2(F); } PHASE_END
        SEAM(pb + 4); TSTAMP(4);
        PHASE(PON(5) && IN(pb + 5), 5) p_h1(F, l, (PROBE_PH == 105) ? 1 + PROBE_REP : 1);  PHASE_END
        SEAM(pb + 5); TSTAMP(5);
        PHASE(PON(6) && IN(pb + 6), 6) p_attn(F, l, (char*)lds + RING_OFF); if (rep_ == 0) p_h2(F);  PHASE_END
        SEAM(pb + 6); TSTAMP(6);
        PHASE(PON(7) && IN(pb + 7), 7) p_h3(F, l); p_pm(F, l, Mm);  PHASE_END
        SEAM(pb + 7); TSTAMP(7);
#if defined(PROBE_IDLE)
        { const unsigned long long t0_ = __builtin_amdgcn_s_memrealtime(); while (__builtin_amdgcn_s_memrealtime() - t0_ < (unsigned long long)(PROBE_IDLE)) __builtin_amdgcn_s_sleep(64); }
#endif
        PHASE(PON(8) && IN(pb + 8), 8)
            { pg8::Gemm g{W_BR, W_WBT, Mm, D, MIXW}; pg8::MergeOrder S; S.init(Mm, F.G, F.bx);
              pg8::EpiMergeChain E{W_PROJ + C_GA, WIN, W_XN}; pg8::gemm_phase<pg8::EpiMergeChain, pg8::MergeOrder, true, true>(F.lds + RING_OFF, g, S, E); }
         PHASE_END
        SEAM(pb + 8); TSTAMP(8);
        PHASE(PON(9) && IN(pb + 9), 9)
            { pg8::Gemm g{W_XN, W_WOT, NLAT, D, D}; pg8::StaticOrder S; S.init(NLAT, D, F.G, F.bx, WGM_N8);
              pg8::EpiResid E{nullptr, W_H16, POUT(W_H16, (bf16*)W_Y32), modl + 5 * D, 1.0f, 0.f}; pg8::gemm_phase<pg8::EpiResid, pg8::StaticOrder, true, true>(F.lds + RING_OFF, g, S, E); }
            if (l == 0) { pg8::Gemm g{W_XN + (size_t)NLAT * D, W_WOT, NCTX, D, 512, D}; pg8::SplitKOrder S; S.init(NCTX, D, 4, F.G, F.bx);
              pg8::EpiPartial E{W_PART, modl + 2 * MODW + 5 * D, 1.0f}; pg8::gemm_phase<pg8::EpiPartial, pg8::SplitKOrder, true, true>(F.lds + RING_OFF, g, S, E); }
         PHASE_END
        SEAM(pb + 9); TSTAMP(9);
        PHASE(PON(10) && IN(pb + 10), 10) p_norm(F, nullptr, nullptr, IP_NORMW + (size_t)(l * 3 + 2) * D, modl, 2, Mm, 4); PHASE_END
        SEAM(pb + 10); TSTAMP(10);
        PHASE(PON(11) && IN(pb + 11), 11) pg8::Gemm g{W_XN, W_W13T + (size_t)2 * FF * D, Mm, 2 * FF, D}; pg8::StaticOrder S; S.init(Mm, 2 * FF, F.G, F.bx);
            pg8::EpiSwiglu E{W_HID, FF}; pg8::gemm_phase<pg8::EpiSwiglu, pg8::StaticOrder, true, true>(F.lds + RING_OFF, g, S, E);  PHASE_END
        SEAM(pb + 11); TSTAMP(11);
        PHASE(PON(12) && IN(pb + 12), 12)
            { pg8::Gemm g{W_HID, W_W2T + (size_t)D * FF, NLAT, D, FF}; pg8::StaticOrder S; S.init(NLAT, D, F.G, F.bx, WGM_N8);
              pg8::EpiResid E{nullptr, W_H16, POUT(W_H16, (bf16*)W_Y32), modl + 8 * D, 0.5f, 0.f}; pg8::gemm_phase<pg8::EpiResid, pg8::StaticOrder, true, true>(F.lds + RING_OFF, g, S, E); }
            if (l == 0) { pg8::Gemm g{W_HID + (size_t)NLAT * FF, W_W2T + (size_t)D * FF, NCTX, D, 512, FF}; pg8::SplitKOrder S; S.init(NCTX, D, 11, F.G, F.bx);
              pg8::EpiPartial E{W_PART, modl + 2 * MODW + 8 * D, 0.5f}; pg8::gemm_phase<pg8::EpiPartial, pg8::SplitKOrder, true, true>(F.lds + RING_OFF, g, S, E); }
         PHASE_END
        SEAM(pb + 12); TSTAMP(12);
    }
    PHASE(PON(14) && IN(NPHASE - 1), 14) p_final(F); PHASE_END
#if defined(PROBE_TMASK)
    TSTAMP(14);
    if (blockIdx.x == 0) { const unsigned long long t0_ = __builtin_amdgcn_s_memrealtime(); while (__builtin_amdgcn_s_memrealtime() - t0_ < (unsigned long long)(PROBE_TMUL) * t_acc) __builtin_amdgcn_s_sleep(32); }
#endif

#undef IN
#undef SEAM
}

extern "C" void kernel_launch(void* const* d_in, const int* in_sizes, int n_in, void* d_out, int out_size, void* d_ws, size_t ws_size, hipStream_t stream) {
    static int grid = 0;
    if (grid == 0) {
        if (n_in != 18 || in_sizes[0] != NLAT * D || out_size != NLAT * D || ws_size < WS_END) { fprintf(stderr, "kernel_launch: shape/workspace mismatch (n_in %d, in0 %d, out %d, ws %zu, need %zu)\n", n_in, n_in > 0 ? in_sizes[0] : -1, out_size, ws_size, (size_t)WS_END); grid = -1; return; }
        int dev = 0, cus = 0, per_cu = 0;
        if (hipGetDevice(&dev) != hipSuccess || hipDeviceGetAttribute(&cus, hipDeviceAttributeMultiprocessorCount, dev) != hipSuccess) { grid = -1; return; }
        if (hipFuncSetAttribute((const void*)mk_fwd, hipFuncAttributeMaxDynamicSharedMemorySize, LDS_BYTES) != hipSuccess) { fprintf(stderr, "kernel_launch: hipFuncSetAttribute failed\n"); grid = -1; return; }
        if (hipOccupancyMaxActiveBlocksPerMultiprocessor(&per_cu, (const void*)mk_fwd, NWAVES * 64, LDS_BYTES) != hipSuccess || per_cu < 1) fprintf(stderr, "kernel_launch: occupancy query reports %d\n", per_cu);
        (void)hipGetLastError();
        grid = cus;
    }
    if (grid < 0) return;
    if (hipMemsetAsync((char*)d_ws + WS_CTL, 0, CTL_ZERO_BYTES, stream) != hipSuccess) return;
    Args a{};
    for (int i = 0; i < 18; ++i) a.in[i] = (const float*)d_in[i];
    a.out = (float*)d_out; a.ws = (unsigned char*)d_ws;
#if MK_N_LAUNCHES == 1
    a.ph_lo = 0; a.ph_hi = NPHASE; a.li = 0;
    hipLaunchKernelGGL(mk_fwd, dim3(grid), dim3(NWAVES * 64), LDS_BYTES, stream, a);
#else
    for (int ph = 0; ph < NPHASE; ++ph) { a.ph_lo = ph; a.ph_hi = ph + 1; a.li = 0; hipLaunchKernelGGL(mk_fwd, dim3(grid), dim3(NWAVES * 64), LDS_BYTES, stream, a); }
#endif
    const hipError_t le = hipPeekAtLastError();
    if (le != hipSuccess) fprintf(stderr, "kernel_launch: launch failed: %s\n", hipGetErrorName(le));
}
```

```cpp
#include <hip/hip_runtime.h>
#include <cstdio>
#include <cstdint>
#ifndef WGM_N8
#define WGM_N8 4
#endif
namespace pg8 {
#define PG8_LAS __attribute__((address_space(3)))
typedef unsigned short bf16_t;
typedef short bf16x8 __attribute__((ext_vector_type(8)));
typedef float f32x4 __attribute__((ext_vector_type(4)));
typedef unsigned u32x4 __attribute__((ext_vector_type(4)));
constexpr int BM = 256, BK = 64, HALF = 128, HTB = HALF * BK * 2  , STAGE_BYTES = 8 * HTB, NXCD = 8, WGM = 4;

__host__ __device__ __forceinline__ int lds_byte(int r, int c) { const int st = (r >> 4) * 2 + (c >> 5), rr = r & 15, cc = c & 31, ob = rr * 64 + cc * 2; return st * 1024 + (ob ^ (((ob >> 9) & 1) << 5)); }
__host__ __device__ __forceinline__ void stage_rc(int b, int& R, int& C) { const int st = b / 1024, sb = b % 1024, swz = sb ^ (((sb >> 9) & 1) << 5); R = (st >> 1) * 16 + swz / 64; C = (st & 1) * 32 + (swz % 64) / 2; }
__host__ __device__ __forceinline__ int perm32(int rho) { const int n = rho >> 4, i = rho & 15; return 8 * (i >> 2) + 4 * n + (i & 3); }

struct Unit { int pm, pn, pk; };
struct Gemm { const bf16_t* A; const bf16_t* Bt; int M, N, K; int ld; };

struct StaticOrder {
    int nM, nN, nwg, G, c, wgm;
    __host__ __device__ void init(int M, int N, int G_, int c_, int wgm_ = WGM) { nM = M / BM; nN = N / BM; nwg = nM * nN; G = G_; c = c_; wgm = wgm_; }
    __host__ __device__ bool next(int i, Unit& u) const {
        const long L = (long)i * G + c; if (L >= nwg) return false;
        int wgid = (int)L; { const int q = nwg / NXCD, r = nwg % NXCD, xcd = wgid % NXCD, off = wgid / NXCD; wgid = (xcd < r ? xcd * (q + 1) : r * (q + 1) + (xcd - r) * q) + off; }
        const int nig = wgm * nN, gid = wgid / nig, fm = gid * wgm, gsz = (nM - fm) < wgm ? (nM - fm) : wgm;
        u.pm = fm + ((wgid % nig) % gsz); u.pn = (wgid % nig) / gsz; u.pk = 0; return true;
    }
    __device__ __forceinline__ void a_ready(const Unit&) const {}
    __device__ __forceinline__ void done(const Unit&) const {}
};

typedef __bf16 cvbf2 __attribute__((ext_vector_type(2)));
typedef float cvf2 __attribute__((ext_vector_type(2)));
__device__ __forceinline__ unsigned cvt_pk_bf16(float lo, float hi) { const cvf2 v = {lo, hi}; return __builtin_bit_cast(unsigned, __builtin_convertvector(v, cvbf2)); }
__device__ __forceinline__ float silu_f(float x) { return x * __builtin_amdgcn_rcpf(1.0f + __builtin_amdgcn_exp2f(-1.4426950408889634f * x)); }
__device__ __forceinline__ float sigm_f(float x) { return __builtin_amdgcn_rcpf(1.0f + __builtin_amdgcn_exp2f(-1.4426950408889634f * x)); }
__device__ __forceinline__ float bfbits2f(unsigned short b) { return __uint_as_float(((unsigned)b) << 16); }
typedef unsigned u32x2 __attribute__((ext_vector_type(2)));
constexpr int MODW = 18432;
constexpr int NLAT = 16384;
constexpr int DM = 2048;

struct EpiStoreBf16 {
    static constexpr bool PERM = true, AFTER_DRAIN = false, CHAIN = false;
    bf16_t* O; int ldc; int rope_lo, rope_hi; float qscale; int gate_lo;
    __device__ __forceinline__ void operator()(const f32x4 (&acc)[2][2][4][2], const Unit& u, int wr, int wc, int fr, int fq) const {
        const int row0 = u.pm * BM + wr * 64 + fr; const int col0 = u.pn * BM + wc * 32 + 8 * fq;
        if (u.pn >= rope_lo && u.pn < rope_hi) {
            const bool isq = u.pn < (rope_lo + rope_hi) / 2, lat = u.pm < 64;
            const float osc = isq ? qscale : 1.0f, sgn = fq < 2 ? -1.0f : 1.0f;
            float invf[8];
#pragma unroll
            for (int e = 0; e < 8; ++e) invf[e] = exp2f(-(float)(8 * (fq & 1) + e) * (13.287712379549449f / 16.0f)) * 0.15915494309189535f;
#pragma unroll
            for (int ai = 0; ai < 2; ++ai)
#pragma unroll
                for (int m = 0; m < 4; ++m) { const int r = row0 + ai * HALF + m * 16; bf16_t* rowp = O + (size_t)r * ldc + col0;
                    const int t = r & 8191; const float pos = (float)((wc & 1) ? (t & 63) : (t >> 6));
                    float cs[8], sn[8];
#pragma unroll
                    for (int e = 0; e < 8; ++e) { const float rev = pos * invf[e], frc = rev - floorf(rev); cs[e] = lat ? __builtin_amdgcn_cosf(frc) * osc : osc; sn[e] = lat ? __builtin_amdgcn_sinf(frc) * osc * sgn : 0.f; }
#pragma unroll
                    for (int bj = 0; bj < 2; ++bj) { const f32x4 v0 = acc[ai][bj][m][0], v1 = acc[ai][bj][m][1];
                        float mine[8] = {v0[0], v0[1], v0[2], v0[3], v1[0], v1[1], v1[2], v1[3]}, outv[8];
#pragma unroll
                        for (int e = 0; e < 8; ++e) { const float other = __shfl_xor(mine[e], 32); outv[e] = mine[e] * cs[e] + other * sn[e]; }
                        u32x4 w; w.x = cvt_pk_bf16(outv[0], outv[1]); w.y = cvt_pk_bf16(outv[2], outv[3]); w.z = cvt_pk_bf16(outv[4], outv[5]); w.w = cvt_pk_bf16(outv[6], outv[7]);
                        *(u32x4*)(rowp + bj * HALF) = w; } }
            return;
        }
        const bool isg = u.pn >= gate_lo;
#pragma unroll
        for (int ai = 0; ai < 2; ++ai)
#pragma unroll
            for (int m = 0; m < 4; ++m) { bf16_t* rowp = O + (size_t)(row0 + ai * HALF + m * 16) * ldc + col0;
#pragma unroll
                for (int bj = 0; bj < 2; ++bj) { f32x4 v0 = acc[ai][bj][m][0], v1 = acc[ai][bj][m][1];
                    if (isg) {
#pragma unroll
                        for (int i = 0; i < 4; ++i) { v0[i] = sigm_f(v0[i]); v1[i] = sigm_f(v1[i]); } }
                    u32x4 w; w.x = cvt_pk_bf16(v0[0], v0[1]); w.y = cvt_pk_bf16(v0[2], v0[3]); w.z = cvt_pk_bf16(v1[0], v1[1]); w.w = cvt_pk_bf16(v1[2], v1[3]);
                    *(u32x4*)(rowp + bj * HALF) = w; } }
    }
};
struct EpiSwiglu {
    static constexpr bool PERM = true, AFTER_DRAIN = false, CHAIN = false;
    bf16_t* O; int ldc;
    __device__ __forceinline__ void operator()(const f32x4 (&acc)[2][2][4][2], const Unit& u, int wr, int wc, int fr, int fq) const {
        const int row0 = u.pm * BM + wr * 64 + fr; const int col0 = u.pn * HALF + wc * 32 + 8 * fq;
#pragma unroll
        for (int ai = 0; ai < 2; ++ai)
#pragma unroll
            for (int m = 0; m < 4; ++m) { bf16_t* rowp = O + (size_t)(row0 + ai * HALF + m * 16) * ldc + col0;
                const f32x4 g0 = acc[ai][0][m][0], g1 = acc[ai][0][m][1], u0 = acc[ai][1][m][0], u1 = acc[ai][1][m][1];
                float r[8];
#pragma unroll
                for (int i = 0; i < 4; ++i) { r[i] = silu_f(g0[i]) * u0[i]; r[4 + i] = silu_f(g1[i]) * u1[i]; }
                u32x4 w; w.x = cvt_pk_bf16(r[0], r[1]); w.y = cvt_pk_bf16(r[2], r[3]); w.z = cvt_pk_bf16(r[4], r[5]); w.w = cvt_pk_bf16(r[6], r[7]);
                *(u32x4*)rowp = w; }
    }
};
struct EpiResid {
    static constexpr bool PERM = true, AFTER_DRAIN = false, CHAIN = false;
    const float* base32; const bf16_t* base16; bf16_t* out; const float* coef; float mul, pad_;
    __device__ __forceinline__ void operator()(const f32x4 (&acc)[2][2][4][2], const Unit& u, int wr, int wc, int fr, int fq) const {
        const int g = u.pm < 32 ? 0 : 1;
        const int col0 = u.pn * BM + wc * 32 + 8 * fq;
        f32x4 cf[2][2];
#pragma unroll
        for (int bj = 0; bj < 2; ++bj)
#pragma unroll
            for (int n = 0; n < 2; ++n) cf[bj][n] = *(const f32x4*)(coef + (size_t)g * MODW + col0 + bj * HALF + 4 * n) * mul;
#pragma unroll
        for (int ai = 0; ai < 2; ++ai)
#pragma unroll
            for (int mp = 0; mp < 2; ++mp) {
                f32x4 pre[2][2][2];
                if (base32) {
#pragma unroll
                    for (int mm = 0; mm < 2; ++mm) { const int m = 2 * mp + mm; const size_t off = (size_t)(u.pm * BM + ai * HALF + wr * 64 + m * 16 + fr) * DM + col0;
#pragma unroll
                        for (int bj = 0; bj < 2; ++bj)
#pragma unroll
                            for (int n = 0; n < 2; ++n) pre[mm][bj][n] = *(const f32x4*)(base32 + off + bj * HALF + 4 * n); }
                } else {
                    u32x4 raw[2][2];
#pragma unroll
                    for (int mm = 0; mm < 2; ++mm) { const int m = 2 * mp + mm; const size_t off = (size_t)(u.pm * BM + ai * HALF + wr * 64 + m * 16 + fr) * DM + col0;
#pragma unroll
                        for (int bj = 0; bj < 2; ++bj) raw[mm][bj] = *(const u32x4*)(base16 + off + bj * HALF); }
#pragma unroll
                    for (int mm = 0; mm < 2; ++mm)
#pragma unroll
                        for (int bj = 0; bj < 2; ++bj) { const u32x4 w = raw[mm][bj];
                            pre[mm][bj][0] = (f32x4){__uint_as_float(w.x << 16), __uint_as_float(w.x & 0xffff0000u), __uint_as_float(w.y << 16), __uint_as_float(w.y & 0xffff0000u)};
                            pre[mm][bj][1] = (f32x4){__uint_as_float(w.z << 16), __uint_as_float(w.z & 0xffff0000u), __uint_as_float(w.w << 16), __uint_as_float(w.w & 0xffff0000u)}; }
                }
                asm volatile("" ::: "memory");
#pragma unroll
                for (int mm = 0; mm < 2; ++mm) { const int m = 2 * mp + mm; const size_t off = (size_t)(u.pm * BM + ai * HALF + wr * 64 + m * 16 + fr) * DM + col0;
#pragma unroll
                    for (int bj = 0; bj < 2; ++bj) { const f32x4 v0 = pre[mm][bj][0] + cf[bj][0] * acc[ai][bj][m][0], v1 = pre[mm][bj][1] + cf[bj][1] * acc[ai][bj][m][1];
                        u32x4 w; w.x = cvt_pk_bf16(v0[0], v0[1]); w.y = cvt_pk_bf16(v0[2], v0[3]); w.z = cvt_pk_bf16(v1[0], v1[1]); w.w = cvt_pk_bf16(v1[2], v1[3]);
                        *(u32x4*)(out + off + bj * HALF) = w; } }
                asm volatile("" ::: "memory");
            }
    }
};
struct EpiMergeChain {
    static constexpr bool PERM = true, AFTER_DRAIN = false, CHAIN = true;
    const bf16_t* gate; int ldg; bf16_t* ybf;
    __device__ __forceinline__ bool chain(f32x4 (&acc)[2][2][4][2], const Unit& u, int wr, int wc, int fr, int fq) const {
        const int br = u.pn >> 3, pn = u.pn & 7, pm = u.pm - 66 * br;
        const int row0 = pm * BM + wr * 64 + fr, col0 = pn * BM + wc * 32 + 8 * fq;
        const bf16_t* g0 = gate + (size_t)br * 2048 + col0;
#pragma unroll
        for (int ai = 0; ai < 2; ++ai)
#pragma unroll
            for (int m = 0; m < 4; ++m) { const size_t r = (size_t)(row0 + ai * HALF + m * 16);
#pragma unroll
                for (int bj = 0; bj < 2; ++bj) {
                    const u32x4 ga = *(const u32x4*)(g0 + r * ldg + bj * HALF);
                    float sa[8] = {__uint_as_float(ga.x << 16), __uint_as_float(ga.x & 0xffff0000u), __uint_as_float(ga.y << 16), __uint_as_float(ga.y & 0xffff0000u),
                                   __uint_as_float(ga.z << 16), __uint_as_float(ga.z & 0xffff0000u), __uint_as_float(ga.w << 16), __uint_as_float(ga.w & 0xffff0000u)};
                    if (br < 2) {
                        const u32x4 gb = *(const u32x4*)(g0 + 2048 + r * ldg + bj * HALF);
                        const float sb[8] = {__uint_as_float(gb.x << 16), __uint_as_float(gb.x & 0xffff0000u), __uint_as_float(gb.y << 16), __uint_as_float(gb.y & 0xffff0000u),
                                             __uint_as_float(gb.z << 16), __uint_as_float(gb.z & 0xffff0000u), __uint_as_float(gb.w << 16), __uint_as_float(gb.w & 0xffff0000u)};
#pragma unroll
                        for (int i = 0; i < 8; ++i) sa[i] *= __builtin_amdgcn_rcpf(sb[i]);
                        acc[ai][bj][m][0] = acc[ai][bj][m][0] * (f32x4){sa[0], sa[1], sa[2], sa[3]}; acc[ai][bj][m][1] = acc[ai][bj][m][1] * (f32x4){sa[4], sa[5], sa[6], sa[7]};
                    } else {
                        const f32x4 v0 = acc[ai][bj][m][0] * (f32x4){sa[0], sa[1], sa[2], sa[3]}, v1 = acc[ai][bj][m][1] * (f32x4){sa[4], sa[5], sa[6], sa[7]};
                        u32x4 w; w.x = cvt_pk_bf16(v0[0], v0[1]); w.y = cvt_pk_bf16(v0[2], v0[3]); w.z = cvt_pk_bf16(v1[0], v1[1]); w.w = cvt_pk_bf16(v1[2], v1[3]);
                        *(u32x4*)(ybf + r * DM + col0 + bj * HALF) = w; } }
                if (m & 1) asm volatile("" ::: "memory"); }
        return br == 2;
    }
};
struct MergeOrder {
    StaticOrder base;
    __host__ __device__ void init(int M, int G_, int c_) { base.init(M, 8 * BM, G_, c_, WGM_N8); }
    __host__ __device__ bool next(int i, Unit& u) const { const int t = i / 3, br = i - 3 * t; if (!base.next(t, u)) return false; u.pm += 66 * br; u.pn += 8 * br; return true; }
    __device__ __forceinline__ void a_ready(const Unit&) const {}
    __device__ __forceinline__ void done(const Unit&) const {}
};
struct SplitKOrder {
    int nM, nN, nK, G, c;
    __host__ __device__ void init(int M, int N, int nK_, int G_, int c_) { nM = M / BM; nN = N / BM; nK = nK_; G = G_; c = c_; }
    __host__ __device__ bool next(int i, Unit& u) const { const int L = i * G + c; if (L >= nM * nN * nK) return false; u.pk = L % nK; const int t = L / nK; u.pm = t % nM; u.pn = t / nM; return true; }
    __device__ __forceinline__ void a_ready(const Unit&) const {}
    __device__ __forceinline__ void done(const Unit&) const {}
};
struct EpiPartial {
    static constexpr bool PERM = false, AFTER_DRAIN = false, CHAIN = false;
    float* part; const float* coef; float mul;
    __device__ __forceinline__ void operator()(const f32x4 (&acc)[2][2][4][2], const Unit& u, int wr, int wc, int fr, int fq) const {
        const int col0 = u.pn * BM + wc * 32 + 4 * fq;
        f32x4 cf[2][2];
#pragma unroll
        for (int bj = 0; bj < 2; ++bj)
#pragma unroll
            for (int n = 0; n < 2; ++n) cf[bj][n] = *(const f32x4*)(coef + col0 + bj * HALF + n * 16) * mul;
#pragma unroll
        for (int ai = 0; ai < 2; ++ai)
#pragma unroll
            for (int m = 0; m < 4; ++m) { const int r = u.pm * BM + ai * HALF + wr * 64 + m * 16 + fr; const size_t off = ((size_t)u.pk * 512 + r) * DM + col0;
#pragma unroll
                for (int bj = 0; bj < 2; ++bj)
#pragma unroll
                    for (int n = 0; n < 2; ++n) *(f32x4*)(part + off + bj * HALF + n * 16) = cf[bj][n] * acc[ai][bj][m][n]; }
    }
};

template <class Epi, class Sched, bool ALIGN_EPI = false, bool SP2 = false>
__device__ __forceinline__ void gemm_phase(PG8_LAS unsigned char* lds, const Gemm g, const Sched& S, const Epi& E) {
    int tid_ = threadIdx.x; asm volatile("" : "+v"(tid_)); const int tid = tid_, wid = __builtin_amdgcn_readfirstlane(tid >> 6), lane = tid & 63, wr = wid >> 2, wc = wid & 3, fr = lane & 15, fq = lane >> 4;
    const int K = g.K, nt = K / BK, LD = g.ld ? g.ld : g.K;
    unsigned voffA[2], voffB[2];
#pragma unroll
    for (int i = 0; i < 2; ++i) { int R, C; stage_rc(tid * 16 + i * 8192, R, C); const int Rb = Epi::PERM ? ((R & ~31) + perm32(R & 31)) : R;
        voffA[i] = (unsigned)(R * LD + C) * 2u; voffB[i] = (unsigned)(Rb * LD + C) * 2u; }
    const size_t kstep = (size_t)(BK * 2);
    const size_t hstep = (size_t)HALF * LD * 2;
    const size_t tstep = 2 * hstep;
    const unsigned ldsw = (unsigned)wid * 1024u;
    const int aoff = lds_byte(wr * 64 + fr, fq * 8), boff = lds_byte(wc * 32 + fr, fq * 8);
#define PG8_SA(b, h) (((b) * 2 + (h)) * HTB)
#define PG8_SB(b, h) ((4 + (b) * 2 + (h)) * HTB)
#define PG8_STAGE(bufoff, gbase, voff) do { _Pragma("unroll") for (int _i = 0; _i < 2; ++_i) \
        __builtin_amdgcn_global_load_lds((const unsigned*)((const char*)(gbase) + (voff)[_i]), (PG8_LAS unsigned*)(lds + (bufoff) + ldsw + _i * 8192), 16, 0, 0); } while (0)
#define PG8_LDA(dst, b, h) do { _Pragma("unroll") for (int m = 0; m < 4; ++m) _Pragma("unroll") for (int k = 0; k < 2; ++k) dst[m][k] = *(const PG8_LAS bf16x8*)(lds + PG8_SA(b, h) + aoff + m * 2048 + k * 1024); } while (0)
#define PG8_LDB(dst, b, h) do { _Pragma("unroll") for (int n = 0; n < 2; ++n) _Pragma("unroll") for (int k = 0; k < 2; ++k) dst[n][k] = *(const PG8_LAS bf16x8*)(lds + PG8_SB(b, h) + boff + n * 2048 + k * 1024); } while (0)
#define PG8_MMA(ai, bj, At, Bt) do { __builtin_amdgcn_s_setprio(1); _Pragma("unroll") for (int m = 0; m < 4; ++m) _Pragma("unroll") for (int n = 0; n < 2; ++n) _Pragma("unroll") for (int k = 0; k < 2; ++k) \
        acc[ai][bj][m][n] = __builtin_amdgcn_mfma_f32_16x16x32_bf16(Bt[n][k], At[m][k], acc[ai][bj][m][n], 0, 0, 0); __builtin_amdgcn_s_setprio(0); } while (0)
#define PG8_WAIT_V(n) asm volatile("s_waitcnt vmcnt(" #n ")" ::: "memory")
#define PG8_WAIT_L(n) asm volatile("s_waitcnt lgkmcnt(" #n ")" ::: "memory")
#define PG8_BAR __builtin_amdgcn_s_barrier()
#define PG8_SCHED __builtin_amdgcn_sched_barrier(0)
    Unit cur, nxt; int ui = 0;
    if (!S.next(0, cur)) return;
    f32x4 acc[2][2][4][2];
#pragma unroll
    for (int a = 0; a < 2; ++a)
#pragma unroll
        for (int b = 0; b < 2; ++b)
#pragma unroll
            for (int m = 0; m < 4; ++m)
#pragma unroll
                for (int n = 0; n < 2; ++n) acc[a][b][m][n] = (f32x4){0.f, 0.f, 0.f, 0.f};
    bf16x8 At[4][2], B0[2][2], B1[2][2];
    const size_t kslice = (size_t)K * 2;
    const char* cA = (const char*)g.A + (size_t)cur.pm * tstep + (size_t)cur.pk * kslice; const char* cB = (const char*)g.Bt + (size_t)cur.pn * tstep + (size_t)cur.pk * kslice;
    S.a_ready(cur);
    if constexpr (SP2) {
        PG8_STAGE(PG8_SB(0, 0), cB, voffB); PG8_STAGE(PG8_SB(0, 1), cB + hstep, voffB); PG8_STAGE(PG8_SA(0, 0), cA, voffA); PG8_STAGE(PG8_SA(0, 1), cA + hstep, voffA);
        if (wr == 1) PG8_BAR;
        PG8_WAIT_V(2); PG8_BAR;
        PG8_STAGE(PG8_SB(1, 0), cB + kstep, voffB); PG8_STAGE(PG8_SA(1, 0), cA + kstep, voffA); PG8_STAGE(PG8_SB(1, 1), cB + hstep + kstep, voffB);
        PG8_WAIT_V(6); PG8_BAR;
    } else {
        PG8_STAGE(PG8_SB(0, 0), cB, voffB); PG8_STAGE(PG8_SA(0, 0), cA, voffA); PG8_STAGE(PG8_SB(0, 1), cB + hstep, voffB); PG8_STAGE(PG8_SA(0, 1), cA + hstep, voffA);
        if (wr == 1) PG8_BAR;
        PG8_WAIT_V(4); PG8_BAR;
        PG8_STAGE(PG8_SB(1, 0), cB + kstep, voffB); PG8_STAGE(PG8_SA(1, 0), cA + kstep, voffA); PG8_STAGE(PG8_SB(1, 1), cB + hstep + kstep, voffB);
        PG8_WAIT_V(6); PG8_BAR;
    }
    for (;;) {
        const bool has_next = S.next(ui + 1, nxt);
        const char* nA = has_next ? (const char*)g.A + (size_t)nxt.pm * tstep + (size_t)nxt.pk * kslice : cA; const char* nB = has_next ? (const char*)g.Bt + (size_t)nxt.pn * tstep + (size_t)nxt.pk * kslice : cB;
        for (int t = 0; t < nt; t += 2) {
            const bool last = (t == nt - 2);
            const char* a1 = cA + (size_t)(t + 1) * kstep;
            const char* a2 = last ? nA : cA + (size_t)(t + 2) * kstep; const char* b2 = last ? nB : cB + (size_t)(t + 2) * kstep;
            const char* a3 = a2 + kstep; const char* b3 = b2 + kstep;
            if (last && has_next) S.a_ready(nxt);
            if constexpr (SP2) {
            PG8_LDB(B0, 0, 0); PG8_LDB(B1, 0, 1); PG8_SCHED; PG8_LDA(At, 0, 0); PG8_STAGE(PG8_SA(1, 1), a1 + hstep, voffA);
            PG8_WAIT_V(8); PG8_WAIT_L(0); PG8_BAR; PG8_MMA(0, 0, At, B0); PG8_MMA(0, 1, At, B1); PG8_BAR; PG8_SCHED;
            PG8_LDA(At, 0, 1); PG8_STAGE(PG8_SB(0, 0), b2, voffB); PG8_STAGE(PG8_SB(0, 1), b2 + hstep, voffB); PG8_STAGE(PG8_SA(0, 0), a2, voffA);
            PG8_WAIT_V(8); PG8_WAIT_L(0); PG8_BAR; PG8_MMA(1, 0, At, B0); PG8_MMA(1, 1, At, B1); PG8_BAR; PG8_SCHED;
            PG8_LDB(B0, 1, 0); PG8_LDB(B1, 1, 1); PG8_SCHED; PG8_LDA(At, 1, 0); PG8_STAGE(PG8_SA(0, 1), a2 + hstep, voffA);
            PG8_WAIT_V(8); PG8_WAIT_L(0); PG8_BAR; PG8_MMA(0, 0, At, B0); PG8_MMA(0, 1, At, B1); PG8_BAR; PG8_SCHED;
            PG8_LDA(At, 1, 1); PG8_STAGE(PG8_SB(1, 0), b3, voffB); PG8_STAGE(PG8_SB(1, 1), b3 + hstep, voffB); PG8_STAGE(PG8_SA(1, 0), a3, voffA);
            PG8_WAIT_V(8); PG8_WAIT_L(0); PG8_BAR; PG8_MMA(1, 0, At, B0); PG8_MMA(1, 1, At, B1); PG8_BAR; PG8_SCHED;
            } else {
            PG8_LDB(B0, 0, 0); PG8_SCHED; PG8_LDA(At, 0, 0); PG8_STAGE(PG8_SA(1, 1), a1 + hstep, voffA);
            PG8_WAIT_L(8); PG8_BAR; PG8_WAIT_L(0); PG8_MMA(0, 0, At, B0); PG8_BAR; PG8_SCHED;
            PG8_LDB(B1, 0, 1); PG8_STAGE(PG8_SB(0, 0), b2, voffB);
            PG8_BAR; PG8_WAIT_L(0); PG8_MMA(0, 1, At, B1); PG8_BAR;
            PG8_LDA(At, 0, 1); PG8_STAGE(PG8_SA(0, 0), a2, voffA);
            PG8_BAR; PG8_WAIT_L(0); PG8_MMA(1, 0, At, B0); PG8_BAR; PG8_SCHED;
            PG8_STAGE(PG8_SB(0, 1), b2 + hstep, voffB);
            PG8_WAIT_V(6); PG8_BAR; PG8_MMA(1, 1, At, B1); PG8_BAR;
            PG8_LDB(B0, 1, 0); PG8_SCHED; PG8_LDA(At, 1, 0); PG8_STAGE(PG8_SA(0, 1), a2 + hstep, voffA);
            PG8_WAIT_L(8); PG8_BAR; PG8_WAIT_L(0); PG8_MMA(0, 0, At, B0); PG8_BAR; PG8_SCHED;
            PG8_LDB(B1, 1, 1); PG8_STAGE(PG8_SB(1, 0), b3, voffB);
            PG8_BAR; PG8_WAIT_L(0); PG8_MMA(0, 1, At, B1); PG8_BAR;
            PG8_LDA(At, 1, 1); PG8_STAGE(PG8_SA(1, 0), a3, voffA);
            PG8_BAR; PG8_WAIT_L(0); PG8_MMA(1, 0, At, B0); PG8_BAR; PG8_SCHED;
            PG8_STAGE(PG8_SB(1, 1), b3 + hstep, voffB);
            PG8_WAIT_V(6); PG8_BAR; PG8_MMA(1, 1, At, B1); PG8_BAR;
            }
        }
        if constexpr (ALIGN_EPI) { if (wr == 0) PG8_BAR; }
        bool zero_acc = true;
        if constexpr (Epi::CHAIN) { zero_acc = E.chain(acc, cur, wr, wc, fr, fq); S.done(cur); }
        else if constexpr (!Epi::AFTER_DRAIN) { E(acc, cur, wr, wc, fr, fq); S.done(cur); }
        if (!has_next) break;
        if (zero_acc)
#pragma unroll
        for (int a = 0; a < 2; ++a)
#pragma unroll
            for (int b = 0; b < 2; ++b)
#pragma unroll
                for (int m = 0; m < 4; ++m)
#pragma unroll
                    for (int n = 0; n < 2; ++n) acc[a][b][m][n] = (f32x4){0.f, 0.f, 0.f, 0.f};
        cur = nxt; cA = nA; cB = nB; ++ui;
        if constexpr (ALIGN_EPI) { if (wr == 1) PG8_BAR; }
    }
    PG8_WAIT_V(0);
    if constexpr (!ALIGN_EPI) { if (wr == 0) PG8_BAR; }
    PG8_BAR;
    if constexpr (Epi::AFTER_DRAIN) { E.fused(acc, cur, wr, wc, fr, fq, lds, wid, lane); S.done(cur); }
#undef PG8_SA
#undef PG8_SB
#undef PG8_STAGE
#undef PG8_LDA
#undef PG8_LDB
#undef PG8_MMA
#undef PG8_WAIT_V
#undef PG8_WAIT_L
#undef PG8_BAR
#undef PG8_SCHED
}
}
namespace att {
typedef unsigned short bf16;
using bf16x8 = __attribute__((ext_vector_type(8))) short;
using s16x4  = __attribute__((ext_vector_type(4))) short;
using f32x16 = __attribute__((ext_vector_type(16))) float;
using u32x4  = __attribute__((ext_vector_type(4))) unsigned;
constexpr int NW = 8, QBLK = 32, KVBLK = 64;
constexpr float SCALE = 0.125f;
constexpr float THR = 8.f;
constexpr int LDP = 17408;
constexpr int LDO = 1024;
constexpr size_t SHM_V = KVBLK * 128 * 2, SHM_K = KVBLK * 64 * 2, SHM_ATTN = 2 * SHM_V + 2 * SHM_K + NW * 64 * 4;
#define KSWZ64(row, colB) ((row) * 128 + ((colB) ^ ((((row) >> 1) & 7) << 4)))
#define SBAR() __builtin_amdgcn_sched_barrier(0)
__device__ __forceinline__ int crow(int r, int hi) { return (r & 3) + 8 * (r >> 2) + 4 * hi; }
__device__ __forceinline__ unsigned cvtpk(float lo, float hi) { unsigned r; asm volatile("v_cvt_pk_bf16_f32 %0, %1, %2" : "=v"(r) : "v"(lo), "v"(hi)); return r; }
typedef __bf16 atbf2 __attribute__((ext_vector_type(2)));
typedef float atf2 __attribute__((ext_vector_type(2)));
__device__ __forceinline__ unsigned pk2bf(float lo, float hi) { const atf2 v = {lo, hi}; return __builtin_bit_cast(unsigned, __builtin_convertvector(v, atbf2)); }
__device__ __forceinline__ bf16x8 ld8(const bf16* p) { return *reinterpret_cast<const bf16x8*>(p); }

typedef float f32x2a __attribute__((ext_vector_type(2)));
#define MX3(a, b, c) __builtin_fmaxf(__builtin_fmaxf((a), (b)), (c))
constexpr float THR2 = THR * 1.4426950408889634f;
__device__ __forceinline__ void partialSM(f32x16& p0, f32x16& p1, float& mref, f32x16& negm, float& alpha, bool first) {
  float a = MX3(p0[0], p0[1], p1[0]), b = MX3(p0[2], p0[3], p1[1]); a = MX3(a, p1[2], p1[3]);
#pragma unroll
  for (int r = 4; r < 16; r += 4) { a = MX3(a, p0[r], p0[r + 1]); b = MX3(b, p0[r + 2], p0[r + 3]); a = MX3(a, p1[r], p1[r + 1]); b = MX3(b, p1[r + 2], p1[r + 3]); }
  float pmax = __builtin_fmaxf(a, b);
  { auto rr = __builtin_amdgcn_permlane32_swap(__float_as_uint(pmax), __float_as_uint(pmax), false, false);
    pmax = __builtin_fmaxf(__uint_as_float(rr[0]), __uint_as_float(rr[1])); }
  alpha = 1.f;
  if (__builtin_expect(first || !__all(pmax <= THR2), 0)) {
    const float d = first ? pmax : __builtin_fmaxf(pmax, 0.f);
    mref += d; alpha = first ? 0.f : __builtin_amdgcn_exp2f(-d);
#pragma unroll
    for (int r = 0; r < 16; ++r) { p0[r] -= d; p1[r] -= d; }
#pragma unroll
    for (int r = 0; r < 16; ++r) negm[r] = -mref;
    asm volatile("" : "+v"(negm));
  }
#pragma unroll
  for (int r = 0; r < 16; ++r) { p0[r] = __builtin_amdgcn_exp2f(p0[r]); p1[r] = __builtin_amdgcn_exp2f(p1[r]); }
}
__device__ __forceinline__ void finishSM(f32x16& p0, f32x16& p1, float alpha, float& l_reg, bf16x8& pa0, bf16x8& pa1, bf16x8& pa2, bf16x8& pa3) {
  f32x2a s2 = (f32x2a){p0[0], p0[1]} + (f32x2a){p1[0], p1[1]};
#pragma unroll
  for (int r = 2; r < 16; r += 2) { s2 += (f32x2a){p0[r], p0[r + 1]}; s2 += (f32x2a){p1[r], p1[r + 1]}; }
  float ps = s2.x + s2.y;
  { auto rr = __builtin_amdgcn_permlane32_swap(__float_as_uint(ps), __float_as_uint(ps), false, false);
    ps = __uint_as_float(rr[0]) + __uint_as_float(rr[1]); }
  l_reg = l_reg * alpha + ps;
#define PK4(P, BASE, OUT) do { unsigned a0 = cvtpk(P[BASE + 0], P[BASE + 1]), a1 = cvtpk(P[BASE + 2], P[BASE + 3]);   \
    unsigned b0 = cvtpk(P[BASE + 4], P[BASE + 5]), b1 = cvtpk(P[BASE + 6], P[BASE + 7]);                              \
    auto r0 = __builtin_amdgcn_permlane32_swap(a0, b0, false, false); auto r1 = __builtin_amdgcn_permlane32_swap(a1, b1, false, false); \
    u32x4 w = {r0[0], r1[0], r0[1], r1[1]}; OUT = *reinterpret_cast<bf16x8*>(&w); } while (0)
  PK4(p0, 0, pa0); PK4(p0, 8, pa1); PK4(p1, 0, pa2); PK4(p1, 8, pa3);
#undef PK4
}
__device__ __forceinline__ void qkt(f32x16& p0, f32x16& p1, const bf16* Ks, const bf16x8* qr, const f32x16& negm, int r32, int hi) {
#pragma unroll
  for (int d0 = 0; d0 < 4; ++d0) { int cb = (d0 * 16 + hi * 8) * 2;
    bf16x8 b0 = *reinterpret_cast<const bf16x8*>((const char*)Ks + KSWZ64(r32, cb));
    bf16x8 b1 = *reinterpret_cast<const bf16x8*>((const char*)Ks + KSWZ64(32 + r32, cb));
    if (d0 == 0) { p0 = __builtin_amdgcn_mfma_f32_32x32x16_bf16(b0, qr[0], negm, 0, 0, 0); p1 = __builtin_amdgcn_mfma_f32_32x32x16_bf16(b1, qr[0], negm, 0, 0, 0); }
    else { p0 = __builtin_amdgcn_mfma_f32_32x32x16_bf16(b0, qr[d0], p0, 0, 0, 0); p1 = __builtin_amdgcn_mfma_f32_32x32x16_bf16(b1, qr[d0], p1, 0, 0, 0); } }
}
__device__ __forceinline__ int v_st(int k, int c) { const int kk = (k & ~0xC) | ((k & 4) << 1) | ((k & 8) >> 1); return ((kk >> 3) * 4 + (c >> 5)) * 512 + ((kk & 7) * 32 + (c & 31)) * 2; }
__device__ __forceinline__ int v_rd_base(int lane) { return ((lane & 3) << 3) | (((lane >> 2) & 3) << 6) | (((lane >> 4) & 1) << 5) | (((lane >> 5) & 1) << 8); }
constexpr int v_rd_off(int d0, int ks, int half) { return d0 * 512 + ks * 4096 + half * 2048; }
template <int OFF> __device__ __forceinline__ s16x4 tr_read(int vb) {
  s16x4 r; asm volatile("ds_read_b64_tr_b16 %0, %1 offset:%2" : "=&v"(r) : "v"(vb), "i"(OFF) : "memory"); return r;
}
template <int D0> __device__ __forceinline__ void pv_one(f32x16& od, int vb, bf16x8 pa0, bf16x8 pa1, bf16x8 pa2, bf16x8 pa3) {
  const s16x4 l0 = tr_read<v_rd_off(D0, 0, 0)>(vb), h0 = tr_read<v_rd_off(D0, 0, 1)>(vb), l1 = tr_read<v_rd_off(D0, 1, 0)>(vb), h1 = tr_read<v_rd_off(D0, 1, 1)>(vb);
  const s16x4 l2 = tr_read<v_rd_off(D0, 2, 0)>(vb), h2 = tr_read<v_rd_off(D0, 2, 1)>(vb), l3 = tr_read<v_rd_off(D0, 3, 0)>(vb), h3 = tr_read<v_rd_off(D0, 3, 1)>(vb);
  asm volatile("s_waitcnt lgkmcnt(0)" ::: "memory"); SBAR();
#define PK(L, H) (bf16x8){L[0], L[1], L[2], L[3], H[0], H[1], H[2], H[3]}
  od = __builtin_amdgcn_mfma_f32_32x32x16_bf16(pa0, PK(l0, h0), od, 0, 0, 0);
  od = __builtin_amdgcn_mfma_f32_32x32x16_bf16(pa1, PK(l1, h1), od, 0, 0, 0);
  od = __builtin_amdgcn_mfma_f32_32x32x16_bf16(pa2, PK(l2, h2), od, 0, 0, 0);
  od = __builtin_amdgcn_mfma_f32_32x32x16_bf16(pa3, PK(l3, h3), od, 0, 0, 0);
#undef PK
}
__device__ __forceinline__ void pv_d0(f32x16* o, int vb, bf16x8 pa0, bf16x8 pa1, bf16x8 pa2, bf16x8 pa3) {
  pv_one<0>(o[0], vb, pa0, pa1, pa2, pa3); pv_one<1>(o[1], vb, pa0, pa1, pa2, pa3); pv_one<2>(o[2], vb, pa0, pa1, pa2, pa3); pv_one<3>(o[3], vb, pa0, pa1, pa2, pa3);
}
__device__ __forceinline__ unsigned short f2bf_rne(float f) { unsigned u = __float_as_uint(f); return (unsigned short)((u + 0x7fffu + ((u >> 16) & 1u)) >> 16); }

__device__ __forceinline__ void glds16(const void* gsrc, unsigned lds_dst) { unsigned keep;
  asm volatile("s_mov_b32 %0, m0\n\ts_mov_b32 m0, %2\n\ts_nop 0\n\tglobal_load_lds_dwordx4 %1, off\n\ts_mov_b32 m0, %0" : "=&s"(keep) : "v"(gsrc), "s"(lds_dst) : "memory"); }
__device__ __forceinline__ void glds16s(const void* sbase, unsigned voff, unsigned lds_dst) { unsigned keep;
  asm volatile("s_mov_b32 %0, m0\n\ts_mov_b32 m0, %3\n\ts_nop 0\n\tglobal_load_lds_dwordx4 %1, %2\n\ts_mov_b32 m0, %0" : "=&s"(keep) : "v"(voff), "s"(sbase), "s"(lds_dst) : "memory"); }
constexpr int LDS_K = 0, NKS = 3, LDS_V = NKS * (int)SHM_K, NVS = 4, LDS_WS = LDS_V + NVS * (int)SHM_V, ATT_LDS_BYTES = LDS_WS + NW * 64 * 4;
__device__ __forceinline__ void attn_unit(const bf16* __restrict__ proj, int qrow0, int crow0, int lrow0, int NT, int h, int p, unsigned* __restrict__ hold, float lam, float onemli, const float* __restrict__ nw128, bf16* __restrict__ Bout, char* lds) {
  int tid_ = threadIdx.x; asm volatile("" : "+v"(tid_)); const int tid = tid_, lane = tid & 63, r32 = lane & 31, hi = lane >> 5;
  const int wid = __builtin_amdgcn_readfirstlane(tid >> 6);
  const int CQ = 8192 + 128 * h + 64 * p, CK = 9216 + 128 * h + 64 * p, CV = 10240 + 128 * h;
  const unsigned lds0 = (unsigned)(uintptr_t)lds;
  asm volatile("s_waitcnt vmcnt(0)" ::: "memory");
  float* ws = (float*)(lds + LDS_WS) + wid * 64; float* li_l = ws; float* al_l = ws + 32;
  float mref = 0.f, l_reg = 0; f32x16 o[4] = {}; bf16x8 qr[4]; f32x16 negm = f32x16{}; asm volatile("" : "+v"(negm));
  const bf16* Qw = proj + (size_t)(qrow0 + wid * QBLK + r32) * LDP + CQ + hi * 8;
#pragma unroll
  for (int d0 = 0; d0 < 4; ++d0) qr[d0] = ld8(Qw + d0 * 16);
  unsigned kofs, vofs[2];
  { const int row = 8 * wid + (lane >> 3), cpos = lane & 7, cc = cpos ^ ((row >> 1) & 7); kofs = (unsigned)((row * LDP + CK + cc * 8) * 2); }
#pragma unroll
  for (int i = 0; i < 2; ++i) { const int gidx = (2 * wid + i) * 64 + lane, st = gidx >> 5, within = gidx & 31, kk = (st >> 2) * 8 + (within >> 2), cc = (st & 3) * 32 + (within & 3) * 8;
    const int k = (kk & ~0xC) | ((kk & 4) << 1) | ((kk & 8) >> 1); vofs[i] = (unsigned)((k * LDP + CV + cc) * 2); }
#define TROW(jt) ((jt) < 4 ? crow0 + 64 * (jt) : lrow0 + 64 * ((jt) - 4))
#define DMA(jt, ks, vs) do { const bf16* tb_ = proj + (size_t)TROW(jt) * LDP; glds16s(tb_, kofs, lds0 + LDS_K + (ks) * (unsigned)SHM_K + wid * 1024u); \
    glds16s(tb_, vofs[0], lds0 + LDS_V + (vs) * (unsigned)SHM_V + (2 * wid) * 1024u); glds16s(tb_, vofs[1], lds0 + LDS_V + (vs) * (unsigned)SHM_V + (2 * wid + 1) * 1024u); } while (0)
#if defined(PROBE_ATT_XDMA)
#define PROBE_XDMA_K() glds16s(tb_, kofs, lds0 + 98304u + wid * 1024u)
#define PROBE_XDMA_V(i) glds16s(tb_, vofs[i], lds0 + 106496u + (2 * wid + (i)) * 1024u)
#else
#define PROBE_XDMA_K() do { } while (0)
#define PROBE_XDMA_V(i) do { } while (0)
#endif
#if defined(PROBE_ATT_XDMA)
#define WAITBAR_STEP WAITBAR(6)
#else
#define WAITBAR_STEP WAITBAR(3)
#endif
#if defined(PROBE_ATT_XBAR)
#define PROBE_XBAR asm volatile("s_barrier" ::: "memory")
#else
#define PROBE_XBAR do { } while (0)
#endif
#if defined(PROBE_ATT_LGKM0)
#define LGKM(n) asm volatile("s_waitcnt lgkmcnt(0)" ::: "memory")
#endif
#define DMA_K(jt, ks) do { const bf16* tb_ = proj + (size_t)TROW(jt) * LDP; glds16s(tb_, kofs, lds0 + LDS_K + (ks) * (unsigned)SHM_K + wid * 1024u); PROBE_XDMA_K(); } while (0)
#define DMA_V(jt, vs, i) do { const bf16* tb_ = proj + (size_t)TROW(jt) * LDP; glds16s(tb_, vofs[i], lds0 + LDS_V + (vs) * (unsigned)SHM_V + (2 * wid + (i)) * 1024u); PROBE_XDMA_V(i); } while (0)
#define WAITBAR(n) asm volatile("s_waitcnt vmcnt(" #n ") lgkmcnt(0)\n\ts_barrier" ::: "memory")
#define RESC(a) do { if (__any((a) < 1.f)) { if (hi == 0) al_l[r32] = (a); asm volatile("s_waitcnt lgkmcnt(0)" ::: "memory"); \
    _Pragma("unroll") for (int d = 0; d < 4; ++d) _Pragma("unroll") for (int r = 0; r < 16; ++r) o[d][r] *= al_l[crow(r, hi)]; } } while (0)
  const int vbase = (int)(lds0 + LDS_V) + v_rd_base(lane);
  f32x16 pA0, pA1, pB0, pB1; float alA, alB; bf16x8 pa0, pa1, pa2, pa3;
  int ks_cur = 0, vs_prev = 0;
  DMA(0, 0, 0); DMA(1, 1, 1);
  WAITBAR(3);
  qkt(pA0, pA1, (const bf16*)(lds + LDS_K), qr, negm, r32, hi); partialSM(pA0, pA1, mref, negm, alA, true);
  DMA(2, 2, 2);
  WAITBAR(3);
  ks_cur = 1; vs_prev = 0;
#define EX4(P, B) do { P[B] = __builtin_amdgcn_exp2f(P[B]); P[B + 1] = __builtin_amdgcn_exp2f(P[B + 1]); P[B + 2] = __builtin_amdgcn_exp2f(P[B + 2]); P[B + 3] = __builtin_amdgcn_exp2f(P[B + 3]); } while (0)
#define EX2(P, B) do { P[B] = __builtin_amdgcn_exp2f(P[B]); P[B + 1] = __builtin_amdgcn_exp2f(P[B + 1]); } while (0)
#define PK4(P, BASE, OUT) do { unsigned a0 = cvtpk(P[BASE + 0], P[BASE + 1]), a1 = cvtpk(P[BASE + 2], P[BASE + 3]);   \
    unsigned b0 = cvtpk(P[BASE + 4], P[BASE + 5]), b1 = cvtpk(P[BASE + 6], P[BASE + 7]);                              \
    auto r0 = __builtin_amdgcn_permlane32_swap(a0, b0, false, false); auto r1 = __builtin_amdgcn_permlane32_swap(a1, b1, false, false); \
    u32x4 w = {r0[0], r1[0], r0[1], r1[1]}; OUT = *reinterpret_cast<bf16x8*>(&w); } while (0)
#define KFR(row, d0) (*reinterpret_cast<const bf16x8*>(kb_ + KSWZ64((row), ((d0) * 16 + hi * 8) * 2)))
#define TRR(D0, ks, half) tr_read<v_rd_off(D0, ks, half)>(vb_)
#define PKV(L, H) (bf16x8){L[0], L[1], L[2], L[3], H[0], H[1], H[2], H[3]}
#if !defined(PROBE_ATT_LGKM0)
#define LGKM(n) asm volatile("s_waitcnt lgkmcnt(" #n ")" ::: "memory")
#endif
#define PVMMA(D0, PA, NEXT, WAITN, G) do { WAITN; SBAR(); o[D0] = __builtin_amdgcn_mfma_f32_32x32x16_bf16(PA, PKV(l##D0, h##D0), o[D0], 0, 0, 0); NEXT; G; SBAR(); } while (0)
#define PVALL(G0, G1, G2, G3, G4, G5, G6, G7, G8, G9, G10, G11, G12, G13, G14, G15) do { \
    PVMMA(0, pa0, { l0 = TRR(0, 1, 0); h0 = TRR(0, 1, 1); }, LGKM(6), G0); \
    PVMMA(1, pa0, { l1 = TRR(1, 1, 0); h1 = TRR(1, 1, 1); }, LGKM(6), G1); \
    PVMMA(2, pa0, { l2 = TRR(2, 1, 0); h2 = TRR(2, 1, 1); }, LGKM(6), G2); \
    PVMMA(3, pa0, { l3 = TRR(3, 1, 0); h3 = TRR(3, 1, 1); }, LGKM(6), G3); \
    PVMMA(0, pa1, { l0 = TRR(0, 2, 0); h0 = TRR(0, 2, 1); }, LGKM(6), G4); \
    PVMMA(1, pa1, { l1 = TRR(1, 2, 0); h1 = TRR(1, 2, 1); }, LGKM(6), G5); \
    PVMMA(2, pa1, { l2 = TRR(2, 2, 0); h2 = TRR(2, 2, 1); }, LGKM(6), G6); \
    PVMMA(3, pa1, { l3 = TRR(3, 2, 0); h3 = TRR(3, 2, 1); }, LGKM(6), G7); \
    PVMMA(0, pa2, { l0 = TRR(0, 3, 0); h0 = TRR(0, 3, 1); }, LGKM(6), G8); \
    PVMMA(1, pa2, { l1 = TRR(1, 3, 0); h1 = TRR(1, 3, 1); }, LGKM(6), G9); \
    PVMMA(2, pa2, { l2 = TRR(2, 3, 0); h2 = TRR(2, 3, 1); }, LGKM(6), G10); \
    PVMMA(3, pa2, { l3 = TRR(3, 3, 0); h3 = TRR(3, 3, 1); }, LGKM(6), G11); \
    PVMMA(0, pa3, { }, LGKM(6), G12); \
    PVMMA(1, pa3, { }, LGKM(4), G13); \
    PVMMA(2, pa3, { }, LGKM(2), G14); \
    PVMMA(3, pa3, { }, LGKM(0), G15); } while (0)
#define FADD(a, b) ((a) + (b))
#define PIN(x) asm volatile("" : "+v"(x))
#define EX3(P, a, b, c_) do { P[a] = __builtin_amdgcn_exp2f(P[a]); P[b] = __builtin_amdgcn_exp2f(P[b]); P[c_] = __builtin_amdgcn_exp2f(P[c_]); PIN(P); } while (0)
#define PKH(P, B, RA, RB) do { const unsigned a_ = cvtpk(P[B], P[B + 1]), b_ = cvtpk(P[B + 4], P[B + 5]); auto r_ = __builtin_amdgcn_permlane32_swap(a_, b_, false, false); RA = r_[0]; RB = r_[1]; } while (0)
#define MKPA(OUT, x0, x1, y0, y1) do { u32x4 w_ = {x0, y0, x1, y1}; OUT = *reinterpret_cast<bf16x8*>(&w_); } while (0)
#define STEP(PX0, PX1, ALX, PY0, PY1, ALY, j) do { \
    const int jn_ = (j) + 2; const bool more_ = jn_ < NT; const int ksn_ = (ks_cur + 2) % 3, vsn_ = (vs_prev + 3) & 3; \
    const char* kb_ = lds + LDS_K + ks_cur * (int)SHM_K; const int vb_ = vbase + vs_prev * (int)SHM_V; \
    float sa_, sb_; \
    s16x4 l0, h0, l1, h1, l2, h2, l3, h3; \
    { bf16x8 kA = KFR(r32, 0), kB = KFR(32 + r32, 0), kC = KFR(r32, 1), kD = KFR(32 + r32, 1); unsigned x0_, x1_, y0_, y1_; SBAR(); \
      PX0 = __builtin_amdgcn_mfma_f32_32x32x16_bf16(kA, qr[0], negm, 0, 0, 0); if (more_) DMA_K(jn_, ksn_); PKH(PY0, 0, x0_, x1_); sa_ = PY0[0] + PY0[1]; sa_ += PY0[2]; SBAR(); \
      PX1 = __builtin_amdgcn_mfma_f32_32x32x16_bf16(kB, qr[0], negm, 0, 0, 0); kA = KFR(r32, 2); kB = KFR(32 + r32, 2); if (more_) DMA_V(jn_, vsn_, 0); PKH(PY0, 2, y0_, y1_); MKPA(pa0, x0_, x1_, y0_, y1_); sa_ += PY0[3]; sa_ += PY0[4]; SBAR(); \
      PX0 = __builtin_amdgcn_mfma_f32_32x32x16_bf16(kC, qr[1], PX0, 0, 0, 0); if (more_) DMA_V(jn_, vsn_, 1); PKH(PY0, 8, x0_, x1_); sa_ += PY0[5]; sa_ += PY0[6]; SBAR(); \
      PX1 = __builtin_amdgcn_mfma_f32_32x32x16_bf16(kD, qr[1], PX1, 0, 0, 0); kC = KFR(r32, 3); kD = KFR(32 + r32, 3); PKH(PY0, 10, y0_, y1_); MKPA(pa1, x0_, x1_, y0_, y1_); sa_ += PY0[7]; sa_ += PY0[8]; SBAR(); \
      PX0 = __builtin_amdgcn_mfma_f32_32x32x16_bf16(kA, qr[2], PX0, 0, 0, 0); l0 = TRR(0, 0, 0); h0 = TRR(0, 0, 1); PKH(PY1, 0, x0_, x1_); sa_ += PY0[9]; sa_ += PY0[10]; SBAR(); \
      PX1 = __builtin_amdgcn_mfma_f32_32x32x16_bf16(kB, qr[2], PX1, 0, 0, 0); l1 = TRR(1, 0, 0); h1 = TRR(1, 0, 1); PKH(PY1, 2, y0_, y1_); MKPA(pa2, x0_, x1_, y0_, y1_); sa_ += PY0[11]; sa_ += PY0[12]; SBAR(); \
      PX0 = __builtin_amdgcn_mfma_f32_32x32x16_bf16(kC, qr[3], PX0, 0, 0, 0); l2 = TRR(2, 0, 0); h2 = TRR(2, 0, 1); PKH(PY1, 8, x0_, x1_); sa_ += PY0[13]; sa_ += PY0[14]; SBAR(); \
      PX1 = __builtin_amdgcn_mfma_f32_32x32x16_bf16(kD, qr[3], PX1, 0, 0, 0); l3 = TRR(3, 0, 0); h3 = TRR(3, 0, 1); PKH(PY1, 10, y0_, y1_); MKPA(pa3, x0_, x1_, y0_, y1_); sa_ += PY0[15]; sb_ = PY1[0] + PY1[1]; SBAR(); } \
    float mxa_, mxb_, pmax_; \
    PVALL({ mxa_ = MX3(PX0[0], PX0[1], PX1[0]); mxb_ = MX3(PX0[2], PX0[3], PX1[1]); mxa_ = MX3(mxa_, PX1[2], PX1[3]); sb_ += PY1[2]; sb_ += PY1[3]; }, \
          { mxa_ = MX3(mxa_, PX0[4], PX0[5]); mxb_ = MX3(mxb_, PX0[6], PX0[7]); mxa_ = MX3(mxa_, PX1[4], PX1[5]); mxb_ = MX3(mxb_, PX1[6], PX1[7]); sb_ += PY1[4]; sb_ += PY1[5]; }, \
          { mxa_ = MX3(mxa_, PX0[8], PX0[9]); mxb_ = MX3(mxb_, PX0[10], PX0[11]); mxa_ = MX3(mxa_, PX1[8], PX1[9]); mxb_ = MX3(mxb_, PX1[10], PX1[11]); sb_ += PY1[6]; sb_ += PY1[7]; }, \
          { mxa_ = MX3(mxa_, PX0[12], PX0[13]); mxb_ = MX3(mxb_, PX0[14], PX0[15]); mxa_ = MX3(mxa_, PX1[12], PX1[13]); mxb_ = MX3(mxb_, PX1[14], PX1[15]); sb_ += PY1[8]; sb_ += PY1[9]; }, \
          { pmax_ = __builtin_fmaxf(mxa_, mxb_); auto rr_ = __builtin_amdgcn_permlane32_swap(__float_as_uint(pmax_), __float_as_uint(pmax_), false, false); pmax_ = __builtin_fmaxf(__uint_as_float(rr_[0]), __uint_as_float(rr_[1])); \
            sb_ += PY1[10]; sb_ += PY1[11]; sb_ += PY1[12]; }, \
          { sb_ += PY1[13]; sb_ += PY1[14]; sb_ += PY1[15]; { float ps_ = sa_ + sb_; auto rq_ = __builtin_amdgcn_permlane32_swap(__float_as_uint(ps_), __float_as_uint(ps_), false, false); ps_ = __uint_as_float(rq_[0]) + __uint_as_float(rq_[1]); l_reg = l_reg * ALY + ps_; } \
            ALX = 1.f; if (__builtin_expect(!__all(pmax_ <= THR2), 0)) { const float d_ = __builtin_fmaxf(pmax_, 0.f); mref += d_; ALX = __builtin_amdgcn_exp2f(-d_); \
              _Pragma("unroll") for (int r = 0; r < 16; ++r) { PX0[r] -= d_; PX1[r] -= d_; } _Pragma("unroll") for (int r = 0; r < 16; ++r) negm[r] = -mref; asm volatile("" : "+v"(negm)); } }, \
          { EX3(PX0, 0, 1, 2); }, { EX3(PX0, 3, 4, 5); }, { EX3(PX0, 6, 7, 8); }, { EX3(PX0, 9, 10, 11); }, { EX3(PX0, 12, 13, 14); }, \
          { PX0[15] = __builtin_amdgcn_exp2f(PX0[15]); PX1[0] = __builtin_amdgcn_exp2f(PX1[0]); PX1[1] = __builtin_amdgcn_exp2f(PX1[1]); PIN(PX0); PIN(PX1); }, \
          { EX3(PX1, 2, 3, 4); }, { EX3(PX1, 5, 6, 7); }, { EX3(PX1, 8, 9, 10); PX1[11] = __builtin_amdgcn_exp2f(PX1[11]); PIN(PX1); }, { EX2(PX1, 12); EX2(PX1, 14); PIN(PX1); }); \
    if (more_) WAITBAR_STEP; else WAITBAR(0); PROBE_XBAR; \
    RESC(ALX); ks_cur = (ks_cur + 1) % 3; vs_prev = (vs_prev + 1) & 3; } while (0)
  for (int j = 1; j + 1 < NT; j += 2) {
    STEP(pB0, pB1, alB, pA0, pA1, alA, j);
    STEP(pA0, pA1, alA, pB0, pB1, alB, j + 1);
  }
  STEP(pB0, pB1, alB, pA0, pA1, alA, NT - 1);
  finishSM(pB0, pB1, alB, l_reg, pa0, pa1, pa2, pa3); SBAR();
  pv_d0(o, vbase + vs_prev * (int)SHM_V, pa0, pa1, pa2, pa3);
  if (hi == 0) li_l[r32] = l_reg; asm volatile("s_waitcnt lgkmcnt(0)" ::: "memory");
  float rli[16];
#pragma unroll
  for (int r = 0; r < 16; ++r) rli[r] = __builtin_amdgcn_rcpf(li_l[crow(r, hi)]);
  if (p == 0) {
#pragma unroll
    for (int d0 = 0; d0 < 4; ++d0) { u32x4 a, b;
#pragma unroll
      for (int q = 0; q < 4; ++q) { a[q] = pk2bf(o[d0][2 * q] * rli[2 * q], o[d0][2 * q + 1] * rli[2 * q + 1]); b[q] = pk2bf(o[d0][8 + 2 * q] * rli[8 + 2 * q], o[d0][9 + 2 * q] * rli[9 + 2 * q]); }
      *reinterpret_cast<u32x4*>(hold + d0 * 8) = a; *reinterpret_cast<u32x4*>(hold + d0 * 8 + 4) = b; }
  } else {
    unsigned held[32];
#pragma unroll
    for (int q = 0; q < 8; ++q) { const u32x4 t = *reinterpret_cast<const u32x4*>(hold + 4 * q); held[4 * q] = t[0]; held[4 * q + 1] = t[1]; held[4 * q + 2] = t[2]; held[4 * q + 3] = t[3]; }
    float ss[16];
#pragma unroll
    for (int r = 0; r < 16; ++r) { ss[r] = 0.f;
#pragma unroll
      for (int d0 = 0; d0 < 4; ++d0) { const unsigned hw = held[d0 * 8 + (r >> 1)]; const float o0 = __uint_as_float((r & 1) ? (hw & 0xffff0000u) : (hw << 16));
        const float x = o0 - lam * (o[d0][r] * rli[r]); o[d0][r] = x; ss[r] += x * x; } }
#pragma unroll
    for (int r = 0; r < 16; ++r) {
#pragma unroll
      for (int m = 1; m < 32; m <<= 1) ss[r] += __shfl_xor(ss[r], m); }
    float dn[4];
#pragma unroll
    for (int d0 = 0; d0 < 4; ++d0) dn[d0] = nw128[d0 * 32 + r32] * onemli;
    bf16* Ow = Bout + (size_t)(qrow0 + wid * QBLK) * LDO + 128 * h;
#pragma unroll
    for (int r = 0; r < 16; ++r) { const int orow = crow(r, hi); const float rstd = __builtin_amdgcn_rsqf(ss[r] * (1.f / 128.f) + 1e-6f);
#pragma unroll
      for (int d0 = 0; d0 < 4; ++d0) Ow[(size_t)orow * LDO + d0 * 32 + r32] = (bf16)(pk2bf(o[d0][r] * rstd * dn[d0], 0.f) & 0xffffu); }
  }
  asm volatile("s_waitcnt vmcnt(0) lgkmcnt(0)\n\ts_barrier" ::: "memory");
#undef TROW
#undef DMA
#undef DMA_K
#undef DMA_V
#undef WAITBAR
#undef STEP
#undef PKH
#undef MKPA
#undef FADD
#undef EX3
#undef PIN
#undef PVALL
#undef PVMMA
#undef LGKM
#undef PKV
#undef TRR
#undef KFR
#undef PK4
#undef EX2
#undef EX4
#undef RESC
}
#undef SBAR
}

constexpr int NWAVES = 8;
#ifndef MK_N_LAUNCHES
#define MK_N_LAUNCHES 1
#endif
constexpr int D = 2048, NLAT = 16384, NCTX = 512, MTOT = NLAT + NCTX, SEQ = 8192, CTXL = 256, FF = 5632, WIN = 17408, MODW = 18432, MIXW = 1024;
constexpr int C_HQ = 0, C_HF = 1024, C_HB = 2048, C_HI = 3072, C_HG = 4096, C_CB = 5120, C_CC = 6144, C_CU = 7168, C_AQ = 8192, C_AK = 9216, C_AV = 10240, C_GA = 11264, C_GB = 13312, C_GC = 15360;
constexpr int NCHUNK = 132;
constexpr int NSEQ = 32;
constexpr float EPS = 1e-6f;
constexpr int NPL = 13;
constexpr int NPHASE = 1 + 2 * NPL + 1;

constexpr size_t MiB = 1u << 20;
constexpr size_t WS_CTL = 0, CTL_ZERO_BYTES = 65536;
constexpr size_t WS_MOD = 1 * MiB;
constexpr size_t WS_HCTX = 2 * MiB;
constexpr size_t WS_W13T = 6 * MiB;
constexpr size_t WS_W2T = WS_W13T + 88 * MiB;
constexpr size_t WS_WINT = WS_W2T + 44 * MiB;
constexpr size_t WS_WBT = WS_WINT + 68 * MiB;
constexpr size_t WS_WOT = WS_WBT + 12 * MiB;
constexpr size_t WS_XN = WS_WOT + 8 * MiB;
constexpr size_t WS_PROJ = WS_XN + 66 * MiB;
constexpr size_t WS_ST = WS_PROJ + 561 * MiB;
constexpr size_t WS_DEC = WS_ST + 132 * MiB;
constexpr size_t WS_BR = WS_DEC + 3 * MiB;
constexpr size_t WS_OP = WS_BR + 99 * MiB;
constexpr size_t WS_PART = WS_OP + 66 * MiB;
constexpr size_t WS_H16 = WS_PART + 44 * MiB;
constexpr size_t WS_QS = WS_H16 + 66 * MiB;
constexpr size_t WS_KS = WS_QS + 66 * MiB;
constexpr size_t WS_END = WS_KS + 66 * MiB;
constexpr size_t WS_EMID = WS_HCTX;
static_assert((size_t)MTOT * WIN * 2 <= 561 * MiB && (size_t)4224 * 16384 * 2 <= 132 * MiB && (size_t)MTOT * D * 4 <= 132 * MiB && (size_t)3 * MTOT * MIXW * 2 <= 99 * MiB, "d_ws map");
constexpr int CW_BAR = 4096;

constexpr int RING_OFF = 0, RING_BYTES = 131072;
constexpr int LDSCTL_OFF = RING_BYTES, MISC_OFF = LDSCTL_OFF + 320;
constexpr int LDS_BYTES = 147456;

#define GAS __attribute__((address_space(1)))
#define LAS __attribute__((address_space(3)))
typedef unsigned short bf16;
typedef unsigned v4u __attribute__((ext_vector_type(4)));
typedef unsigned v2u __attribute__((ext_vector_type(2)));
typedef float f32x4 __attribute__((ext_vector_type(4)));
typedef short bf16x8 __attribute__((ext_vector_type(8)));
typedef GAS unsigned gu32;
#define RLX_AGENT __ATOMIC_RELAXED, __HIP_MEMORY_SCOPE_AGENT
#define LDS_WAIT() asm volatile("s_waitcnt lgkmcnt(0)" ::: "memory")
#define VM_WAIT() asm volatile("s_waitcnt vmcnt(0)" ::: "memory")
typedef __bf16 hwbf2 __attribute__((ext_vector_type(2)));
typedef float hwf2 __attribute__((ext_vector_type(2)));
__device__ __forceinline__ unsigned pk2(float lo, float hi) { const hwf2 v = {lo, hi}; return __builtin_bit_cast(unsigned, __builtin_convertvector(v, hwbf2)); }
__device__ __forceinline__ unsigned f2bf(float f) { return pk2(f, f) & 0xffffu; }
__device__ __forceinline__ float bflo(unsigned w) { return __uint_as_float(w << 16); }
__device__ __forceinline__ float bfhi(unsigned w) { return __uint_as_float(w & 0xffff0000u); }
__device__ __forceinline__ float silu_f(float x) { return x * __builtin_amdgcn_rcpf(1.0f + __builtin_amdgcn_exp2f(-1.4426950408889634f * x)); }
__device__ __forceinline__ float sigm_f(float x) { return __builtin_amdgcn_rcpf(1.0f + __builtin_amdgcn_exp2f(-1.4426950408889634f * x)); }

#define XB_TMO      128
#define XB_XCNT(j)  (256  + 64 * (j))
#define XB_XSUB(j)  (1280 + 64 * (j))
#define XB_XGEN(j)  (2304 + 64 * (j))
#define XB_TOP      3328
#define XB_TOPGEN   3392
#define XCD_BAR_WORDS 3456
#define XB_SPIN_CAP (1u << 18)

__device__ __forceinline__ unsigned xb_ld(unsigned* p)              { return __hip_atomic_load(p, __ATOMIC_RELAXED, __HIP_MEMORY_SCOPE_AGENT); }
__device__ __forceinline__ unsigned xb_add(unsigned* p, unsigned v) { return __hip_atomic_fetch_add(p, v, __ATOMIC_RELAXED, __HIP_MEMORY_SCOPE_AGENT); }
__device__ __forceinline__ unsigned xb_xcc_id() { return (unsigned)__builtin_amdgcn_s_getreg((3 << 11) | 20) & 0xFu; }
#define XB_SPIN(cond, bar) do { unsigned _sp = 0; while (cond) { __builtin_amdgcn_s_sleep(1); \
    if ((++_sp & 255u) == 0u) { if (xb_ld(&(bar)[XB_TMO])) break; if (_sp > XB_SPIN_CAP) { atomicAdd(&(bar)[XB_TMO], 1u); break; } } } } while (0)

struct XcdBarrier {
    unsigned* bar; unsigned x;
    volatile LAS unsigned* st;
};

__device__ __forceinline__ XcdBarrier xcd_barrier_post(unsigned* bar, volatile LAS unsigned* st) {
    XcdBarrier b; b.bar = bar; b.x = xb_xcc_id(); b.st = st;
    if (threadIdx.x == 0) (void)xb_add(&bar[XB_XCNT(b.x)], 1u);
    return b;
}
__device__ __forceinline__ void xcd_barrier_complete(unsigned* bar, unsigned x, unsigned& nloc, unsigned& nx) {
    const unsigned G = gridDim.x * gridDim.y * gridDim.z;
    unsigned sum, cnt, mine, sp = 0u;
    for (;;) {
        sum = 0u; cnt = 0u; mine = 0u;
#pragma unroll
        for (unsigned j = 0; j < 16; ++j) { const unsigned c = xb_ld(&bar[XB_XCNT(j)]); sum += c; cnt += (c > 0u) ? 1u : 0u; mine = (j == x) ? c : mine; }
        if (sum == G) break;
        __builtin_amdgcn_s_sleep(1);
        if ((++sp & 255u) == 0u) { if (xb_ld(&bar[XB_TMO])) break; if (sp > XB_SPIN_CAP) { atomicAdd(&bar[XB_TMO], 1u); break; } }
    }
    nloc = mine > 0u ? mine : 1u; nx = cnt > 0u ? cnt : 1u;
}

__device__ __forceinline__ void xcd_barrier(const XcdBarrier& b) {
    asm volatile("s_waitcnt vmcnt(0)" ::: "memory");
    __syncthreads();
    if (threadIdx.x == 0) {
        unsigned* bar = b.bar;
        __builtin_amdgcn_s_waitcnt(0);
        unsigned nloc = b.st[0], nx = b.st[1];
        if (nloc == 0u) { xcd_barrier_complete(bar, b.x, nloc, nx); b.st[0] = nloc; b.st[1] = nx; }
        const unsigned old = xb_add(&bar[XB_XSUB(b.x)], 1u);
        const unsigned gen = old / nloc;
        if (old + 1u == (gen + 1u) * nloc) {
            __builtin_amdgcn_fence(__ATOMIC_RELEASE, "agent");
            asm volatile("s_waitcnt vmcnt(0)" ::: "memory");
            const unsigned og = xb_add(&bar[XB_TOP], 1u);
            const unsigned tg = og / nx;
            if (og + 1u == (tg + 1u) * nx) xb_add(&bar[XB_TOPGEN], 1u);
            else XB_SPIN(xb_ld(&bar[XB_TOPGEN]) == tg, bar);
            __builtin_amdgcn_fence(__ATOMIC_ACQUIRE, "agent");
            xb_add(&bar[XB_XGEN(b.x)], 1u);
            asm volatile("s_waitcnt vmcnt(0)" ::: "memory");
        } else {
            XB_SPIN(xb_ld(&bar[XB_XGEN(b.x)]) == gen, bar);
            __builtin_amdgcn_fence(__ATOMIC_ACQUIRE, "agent");
            asm volatile("s_waitcnt vmcnt(0)" ::: "memory");
        }
    }
    __syncthreads();
}

struct Frame {
    LAS unsigned char* lds;
    volatile LAS unsigned* MISC;
    gu32* ctl;
    unsigned char* ws;
    float* out;
    int tid, lane, wave;
    int vcu, G, bx;
};
__device__ __forceinline__ void launder(Frame& P) {
    int t = P.tid; asm volatile("" : "+v"(t)); P.tid = t; P.lane = t & 63; P.wave = __builtin_amdgcn_readfirstlane(t >> 6);
    unsigned long long w = (unsigned long long)P.ws, o = (unsigned long long)P.out; int g = P.G, v = P.vcu, x = P.bx;
    asm volatile("" : "+s"(w), "+s"(o), "+s"(g), "+s"(v), "+s"(x));
    P.ws = (unsigned char*)w; P.out = (float*)o; P.G = g; P.vcu = v; P.bx = x;
}
__device__ __forceinline__ const float* in_ptr(int k) {
    auto kp = (const float* const __attribute__((address_space(4)))*)__builtin_amdgcn_kernarg_segment_ptr();
    int kk = k; asm volatile("" : "+s"(kk));
    return kp[kk];
}
#define IP_X in_ptr(0)
#define IP_C in_ptr(1)
#define IP_CTX in_ptr(2)
#define IP_CCTX in_ptr(3)
#define IP_WADA in_ptr(4)
#define IP_BADA in_ptr(5)
#define IP_NORMW in_ptr(6)
#define IP_W13 in_ptr(7)
#define IP_W2 in_ptr(8)
#define IP_WIN in_ptr(9)
#define IP_HLB in_ptr(10)
#define IP_HNW in_ptr(11)
#define IP_CONVW in_ptr(12)
#define IP_LAM in_ptr(13)
#define IP_DANW in_ptr(14)
#define IP_WBR in_ptr(15)
#define IP_WOUT in_ptr(16)
#define IP_FNW in_ptr(17)
#define W_HCTX ((float*)(F.ws + WS_HCTX))
#define W_MOD ((float*)(F.ws + WS_MOD))
#define W_W13T ((bf16*)(F.ws + WS_W13T))
#define W_W2T ((bf16*)(F.ws + WS_W2T))
#define W_WINT ((bf16*)(F.ws + WS_WINT))
#define W_WBT ((bf16*)(F.ws + WS_WBT))
#define W_WOT ((bf16*)(F.ws + WS_WOT))
#define W_XN ((bf16*)(F.ws + WS_XN))
#define W_PROJ ((bf16*)(F.ws + WS_PROJ))
#define W_HID ((bf16*)(F.ws + WS_PROJ))
#define W_ST ((bf16*)(F.ws + WS_ST))
#define W_BR ((bf16*)(F.ws + WS_BR))
#define W_OP ((bf16*)(F.ws + WS_OP))
#define W_Y32 ((float*)(F.ws + WS_ST))
#define W_DEC ((float*)(F.ws + WS_DEC))
#define W_PART ((float*)(F.ws + WS_PART))
#define W_H16 ((bf16*)(F.ws + WS_H16))
#define W_QS ((bf16*)(F.ws + WS_QS))
#define W_KS ((bf16*)(F.ws + WS_KS))
#define W_EMID ((float*)(F.ws + WS_EMID))

__device__ __forceinline__ float wave_sum(float v) {
#pragma unroll
    for (int o = 1; o < 64; o <<= 1) v += __shfl_xor(v, o);
    return v;
}

__device__ __forceinline__ void p_ada(Frame& F) {
    LAS float* sc = (LAS float*)(F.lds + RING_OFF);
    LAS float* red = sc + 3 * D;
    const float* cvec = IP_C; const float* ccv = IP_CCTX; const float* wada = IP_WADA; const float* bada = IP_BADA; float* modp = W_MOD;
    for (int i = F.tid; i < 3 * D; i += NWAVES * 64) { const int g = i / D, k = i - g * D; const float v = (g < 2) ? cvec[g * D + k] : ccv[k]; sc[i] = silu_f(v); }
    __syncthreads();
    const int rr = F.lane >> 3, cg = F.lane & 7;
    for (int unit = F.bx; unit < 2 * (MODW / 32); unit += F.G) {
        const int layer = unit / (MODW / 32), cb = unit - layer * (MODW / 32), col = cb * 32 + 4 * cg;
        const float* W = wada + (size_t)layer * D * MODW + col;
        const int k0 = F.wave * 256 + rr; f32x4 a0 = {0.f, 0.f, 0.f, 0.f}, a1 = a0, a2 = a0;
#pragma unroll 1
        for (int kb = 0; kb < 256; kb += 128) {
            f32x4 wv[16];
#pragma unroll
            for (int i = 0; i < 16; ++i) wv[i] = *(const GAS f32x4*)(W + (size_t)(k0 + kb + 8 * i) * MODW);
#pragma unroll
            for (int i = 0; i < 16; ++i) { const int k = k0 + kb + 8 * i; a0 = a0 + wv[i] * sc[k]; a1 = a1 + wv[i] * sc[D + k]; a2 = a2 + wv[i] * sc[2 * D + k]; }
        }
#pragma unroll
        for (int j = 0; j < 4; ++j) {
#pragma unroll
            for (int o = 8; o < 64; o <<= 1) { a0[j] += __shfl_xor(a0[j], o); a1[j] += __shfl_xor(a1[j], o); a2[j] += __shfl_xor(a2[j], o); } }
        if (rr == 0) { *(LAS f32x4*)(red + (F.wave * 3 + 0) * 32 + 4 * cg) = a0; *(LAS f32x4*)(red + (F.wave * 3 + 1) * 32 + 4 * cg) = a1; *(LAS f32x4*)(red + (F.wave * 3 + 2) * 32 + 4 * cg) = a2; }
        __syncthreads();
        if (F.tid < 96) { const int g = F.tid >> 5, c = F.tid & 31; float t = 0.f;
#pragma unroll
            for (int w = 0; w < 8; ++w) t += red[(w * 3 + g) * 32 + c];
            modp[(size_t)(layer * 3 + g) * MODW + cb * 32 + c] = t + bada[(size_t)layer * MODW + cb * 32 + c]; }
        __syncthreads();
    }
}

struct CvtItem { const float* W; bf16* WT; int K, N, k0, n0, drow0; };
__device__ __forceinline__ void cvt_issue(const CvtItem& I, f32x4 (&t)[8], int lane) {
    const int rr = lane >> 3, cg = lane & 7;
#pragma unroll
    for (int i = 0; i < 8; ++i) t[i] = *(const GAS f32x4*)(I.W + (size_t)(I.k0 + 8 * i + rr) * I.N + I.n0 + 4 * cg);
}
__device__ __forceinline__ void cvt_finish(const CvtItem& I, const f32x4 (&t)[8], LAS float* scr, int lane) {
    { const int rr = lane >> 3, cg = lane & 7;
#pragma unroll
      for (int i = 0; i < 8; ++i) { LAS float* d = scr + (8 * i + rr) * 33 + 4 * cg; d[0] = t[i][0]; d[1] = t[i][1]; d[2] = t[i][2]; d[3] = t[i][3]; } }
    LDS_WAIT(); asm volatile("" ::: "memory");
    const int c = lane & 7;
#pragma unroll
    for (int j = 0; j < 4; ++j) { const int n = (lane >> 3) + 8 * j; const LAS float* s = scr + (8 * c) * 33 + n;
        v4u o; o.x = pk2(s[0 * 33], s[1 * 33]); o.y = pk2(s[2 * 33], s[3 * 33]); o.z = pk2(s[4 * 33], s[5 * 33]); o.w = pk2(s[6 * 33], s[7 * 33]);
        *(GAS v4u*)(I.WT + (size_t)(I.drow0 + n) * I.K + I.k0 + 8 * c) = o; }
    LDS_WAIT(); asm volatile("" ::: "memory");
}
__device__ __forceinline__ void p_convert(Frame& F, int layer) {
    LAS float* scr = (LAS float*)(F.lds + RING_OFF + F.wave * 16384);
    const int gw = F.vcu * NWAVES + F.wave, NGW = F.G * NWAVES;
    constexpr int I13 = (D / 64) * (2 * FF / 32), I2 = (FF / 64) * (D / 32), IIN = (D / 64) * (WIN / 32), IBR = (MIXW / 64) * (D / 32), IOUT = (D / 64) * (D / 32);
    constexpr int NITEMS = 2 * I13 + 2 * I2 + IIN + 3 * IBR + IOUT;
    const float* pw13 = IP_W13; const float* pw2 = IP_W2; const float* pwin = IP_WIN; const float* pwbr = IP_WBR; const float* pwout = IP_WOUT;
    auto decode = [&](int it) -> CvtItem {
        int r = it;
        if (r < 2 * I13) { const int f = r / I13; r -= f * I13; const int nblk = 2 * FF / 32, kb = r / nblk, nb = r - kb * nblk; const int n0 = 32 * nb;
            const int half = n0 >= FF ? 1 : 0, nn = n0 - half * FF; const int drow0 = 256 * (nn >> 7) + 128 * half + (nn & 127);
            return CvtItem{pw13 + (size_t)(layer * 2 + f) * D * 2 * FF, W_W13T + (size_t)f * 2 * FF * D, D, 2 * FF, 64 * kb, n0, drow0}; }
        r -= 2 * I13;
        if (r < 2 * I2) { const int f = r / I2; r -= f * I2; const int nblk = D / 32, kb = r / nblk, nb = r - kb * nblk;
            return CvtItem{pw2 + (size_t)(layer * 2 + f) * FF * D, W_W2T + (size_t)f * D * FF, FF, D, 64 * kb, 32 * nb, 32 * nb}; }
        r -= 2 * I2;
        if (r < IIN) { const int nblk = WIN / 32, kb = r / nblk, nb = r - kb * nblk;
            return CvtItem{pwin + (size_t)layer * D * WIN, W_WINT, D, WIN, 64 * kb, 32 * nb, 32 * nb}; }
        r -= IIN;
        if (r < 3 * IBR) { const int f = r / IBR; r -= f * IBR; const int nblk = D / 32, kb = r / nblk, nb = r - kb * nblk;
            return CvtItem{pwbr + (size_t)(layer * 3 + f) * MIXW * D, W_WBT + (size_t)f * D * MIXW, MIXW, D, 64 * kb, 32 * nb, 32 * nb}; }
        r -= 3 * IBR;
        { const int nblk = D / 32, kb = r / nblk, nb = r - kb * nblk;
            return CvtItem{pwout + (size_t)layer * D * D, W_WOT, D, D, 64 * kb, 32 * nb, 32 * nb}; }
    };
    int it = gw;
    if (it < NITEMS) {
        CvtItem cur = decode(it); f32x4 t[8]; cvt_issue(cur, t, F.lane);
#pragma unroll 1
        for (;;) {
            const int nit = it + NGW; const bool has = nit < NITEMS;
            CvtItem nxt = cur; f32x4 u[8];
            if (has) { nxt = decode(nit); cvt_issue(nxt, u, F.lane); }
            cvt_finish(cur, t, scr, F.lane);
            if (!has) break;
            cur = nxt; it = nit;
#pragma unroll
            for (int i = 0; i < 8; ++i) t[i] = u[i];
        }
    }
    __syncthreads();
}

__device__ __forceinline__ void load_row(f32x4* v, const float* src32, const bf16* src16, int lane) {
    if (src32) { const GAS f32x4* xr = (const GAS f32x4*)src32 + lane;
#pragma unroll
        for (int j = 0; j < 8; ++j) v[j] = xr[64 * j]; }
    else { const GAS v2u* xr = (const GAS v2u*)src16 + lane;
#pragma unroll
        for (int j = 0; j < 8; ++j) { const v2u w = xr[64 * j]; v[j] = (f32x4){bflo(w.x), bfhi(w.x), bflo(w.y), bfhi(w.y)}; } }
}
__device__ __forceinline__ void p_norm(Frame& F, const float* lat32, const float* ctx32, const float* nw, const float* modl, int which, int nrows, int npart) {
    const int gw = F.vcu * NWAVES + F.wave, NGW = F.G * NWAVES;
    for (int row0 = gw; row0 < nrows; row0 += 2 * NGW) {
        const int row1 = row0 + NGW; const bool has1 = row1 < nrows;
        f32x4 v[2][8];
#pragma unroll
        for (int k = 0; k < 2; ++k) { const int row = k ? row1 : row0;
            if (k == 0 || has1) { const float* s32 = row < NLAT ? lat32 : ctx32; if (s32) s32 += (size_t)(row < NLAT ? row : row - NLAT) * D;
                load_row(v[k], s32, W_H16 + (size_t)row * D, F.lane); } }
#pragma unroll
        for (int k = 0; k < 2; ++k) { const int row = k ? row1 : row0;
            if (k == 1 && !has1) break;
            const int g = row < SEQ ? 0 : (row < NLAT ? 1 : 2);
            const float* shift = modl + (size_t)g * MODW + (3 * which) * D; const float* scale = shift + D;
            if (row >= NLAT && npart > 0) {
                for (int p = 0; p < npart; ++p) { const GAS f32x4* pr = (const GAS f32x4*)(W_PART + ((size_t)p * 512 + (row - NLAT)) * D) + F.lane;
#pragma unroll
                    for (int j = 0; j < 8; ++j) v[k][j] = v[k][j] + pr[64 * j]; }
                GAS v2u* hw = (GAS v2u*)(W_H16 + (size_t)row * D) + F.lane;
#pragma unroll
                for (int j = 0; j < 8; ++j) { v2u w; w.x = pk2(v[k][j].x, v[k][j].y); w.y = pk2(v[k][j].z, v[k][j].w); hw[64 * j] = w;
                    v[k][j] = (f32x4){bflo(w.x), bfhi(w.x), bflo(w.y), bfhi(w.y)}; }
            }
            float s = 0.f;
#pragma unroll
            for (int j = 0; j < 8; ++j) s += (v[k][j].x * v[k][j].x + v[k][j].y * v[k][j].y) + (v[k][j].z * v[k][j].z + v[k][j].w * v[k][j].w);
            const float rstd = __builtin_amdgcn_rsqf(wave_sum(s) * (1.f / D) + EPS);
            GAS v2u* o8 = (GAS v2u*)(W_XN + (size_t)row * D) + F.lane;
#pragma unroll
            for (int j = 0; j < 8; ++j) { const int c = 4 * (F.lane + 64 * j);
                const f32x4 wv = *(const f32x4*)(nw + c), sc = *(const f32x4*)(scale + c), sh = *(const f32x4*)(shift + c);
                const f32x4 y = (v[k][j] * rstd) * wv * (sc + 1.0f) + sh;
                v2u w; w.x = pk2(y.x, y.y); w.y = pk2(y.z, y.w); o8[64 * j] = w; }
        }
    }
}
__device__ __forceinline__ void p_final(Frame& F) {
    const int gw = F.vcu * NWAVES + F.wave, NGW = F.G * NWAVES; const float* fnw = IP_FNW;
    for (int row = gw; row < NLAT; row += NGW) {
        f32x4 v[8]; float s = 0.f; load_row(v, nullptr, W_H16 + (size_t)row * D, F.lane);
#pragma unroll
        for (int j = 0; j < 8; ++j) s += (v[j].x * v[j].x + v[j].y * v[j].y) + (v[j].z * v[j].z + v[j].w * v[j].w);
        const float rstd = __builtin_amdgcn_rsqf(wave_sum(s) * (1.f / D) + EPS);
        GAS f32x4* xr = (GAS f32x4*)(F.out + (size_t)row * D) + F.lane;
#pragma unroll
        for (int j = 0; j < 8; ++j) { const int c = 4 * (F.lane + 64 * j); const f32x4 wv = *(const f32x4*)(fnw + c); xr[64 * j] = (v[j] * rstd) * wv; }
    }
}

constexpr float QSCALE = 0.125f * 1.4426950408889634f;
__device__ __forceinline__ void p_rope(Frame& F, int layer) {
    const int gw = F.vcu * NWAVES + F.wave, NGW = F.G * NWAVES;
    const int nrows = layer == 0 ? MTOT : NLAT;
    for (int row = gw; row < nrows; row += NGW) {
        const int t = row & (SEQ - 1), prow = t >> 6, pcol = t & 63;
        bf16* base = W_PROJ + (size_t)row * WIN + C_AQ;
        if (row >= NLAT) {
#pragma unroll
            for (int s = 0; s < 2; ++s) { bf16* pa = base + 8 * (F.lane + 64 * s); const v4u xa = *(const v4u*)pa; v4u wa;
                wa.x = pk2(bflo(xa.x) * QSCALE, bfhi(xa.x) * QSCALE); wa.y = pk2(bflo(xa.y) * QSCALE, bfhi(xa.y) * QSCALE); wa.z = pk2(bflo(xa.z) * QSCALE, bfhi(xa.z) * QSCALE); wa.w = pk2(bflo(xa.w) * QSCALE, bfhi(xa.w) * QSCALE);
                *(v4u*)pa = wa; }
            continue;
        }
#pragma unroll
        for (int s = 0; s < 2; ++s) {
            const int item = F.lane + 64 * s, grp = item >> 1, half = item & 1;
            bf16* pa = base + grp * 32 + 8 * half; bf16* pb = pa + 16;
            const v4u xa = *(const v4u*)pa, xb = *(const v4u*)pb;
            const float pos = (float)((grp & 1) ? pcol : prow);
            const float osc = grp < 32 ? QSCALE : 1.0f;
            float a[8], b[8];
            a[0] = bflo(xa.x); a[1] = bfhi(xa.x); a[2] = bflo(xa.y); a[3] = bfhi(xa.y); a[4] = bflo(xa.z); a[5] = bfhi(xa.z); a[6] = bflo(xa.w); a[7] = bfhi(xa.w);
            b[0] = bflo(xb.x); b[1] = bfhi(xb.x); b[2] = bflo(xb.y); b[3] = bfhi(xb.y); b[4] = bflo(xb.z); b[5] = bfhi(xb.z); b[6] = bflo(xb.w); b[7] = bfhi(xb.w);
            float oa[8], ob[8];
#pragma unroll
            for (int e = 0; e < 8; ++e) { const int d = 8 * half + e;
                const float invf = exp2f(-(float)d * (13.287712379549449f / 16.0f));
                const float rev = pos * invf * 0.15915494309189535f;
                const float fr = rev - floorf(rev);
                const float sn = __builtin_amdgcn_sinf(fr) * osc, cs = __builtin_amdgcn_cosf(fr) * osc;
                oa[e] = a[e] * cs - b[e] * sn; ob[e] = b[e] * cs + a[e] * sn; }
            v4u wa, wb;
            wa.x = pk2(oa[0], oa[1]); wa.y = pk2(oa[2], oa[3]); wa.z = pk2(oa[4], oa[5]); wa.w = pk2(oa[6], oa[7]);
            wb.x = pk2(ob[0], ob[1]); wb.y = pk2(ob[2], ob[3]); wb.z = pk2(ob[4], ob[5]); wb.w = pk2(ob[6], ob[7]);
            *(v4u*)pa = wa; *(v4u*)pb = wb;
        }
    }
}

constexpr float LOG2E_F = 1.4426950408889634f, HG_CLAMP2 = 80.f * 1.4426950408889634f;
__device__ __forceinline__ void hg_gate(float z, float lb, float& l2f, float& kv) {
    const float e = __builtin_amdgcn_exp2f(-fabsf(z) * LOG2E_F), r = __builtin_amdgcn_rcpf(1.0f + e), er = e * r;
    const bool pos = z >= 0.f, haslb = lb > 0.f;
    const float sig = pos ? r : er, nsig = pos ? er : r, omlb = 1.0f - lb;
    kv = omlb * nsig;
    const float lg = __builtin_amdgcn_logf(haslb ? lb + omlb * sig : 1.0f + e);
    l2f = haslb ? lg : fminf(z, 0.f) * LOG2E_F - lg;
}
__device__ __forceinline__ int chunk_row(int b, int c) { return c < 4 ? NLAT + CTXL * b + 64 * c : SEQ * b + 64 * (c - 4); }
__device__ __forceinline__ void unpack16(const v4u a, const v4u b, float* o) {
    o[0] = bflo(a.x); o[1] = bfhi(a.x); o[2] = bflo(a.y); o[3] = bfhi(a.y); o[4] = bflo(a.z); o[5] = bfhi(a.z); o[6] = bflo(a.w); o[7] = bfhi(a.w);
    o[8] = bflo(b.x); o[9] = bfhi(b.x); o[10] = bflo(b.y); o[11] = bfhi(b.y); o[12] = bflo(b.z); o[13] = bfhi(b.z); o[14] = bflo(b.w); o[15] = bfhi(b.w);
}
__device__ __forceinline__ float scan_dpp(float x) {
    x += __builtin_bit_cast(float, __builtin_amdgcn_update_dpp(0, __builtin_bit_cast(int, x), 0x111, 0xf, 0xf, true));
    x += __builtin_bit_cast(float, __builtin_amdgcn_update_dpp(0, __builtin_bit_cast(int, x), 0x112, 0xf, 0xf, true));
    x += __builtin_bit_cast(float, __builtin_amdgcn_update_dpp(0, __builtin_bit_cast(int, x), 0x114, 0xf, 0xf, true));
    x += __builtin_bit_cast(float, __builtin_amdgcn_update_dpp(0, __builtin_bit_cast(int, x), 0x118, 0xf, 0xf, true));
    x += __builtin_bit_cast(float, __builtin_amdgcn_update_dpp(0, __builtin_bit_cast(int, x), 0x142, 0xa, 0xf, true));
    x += __builtin_bit_cast(float, __builtin_amdgcn_update_dpp(0, __builtin_bit_cast(int, x), 0x143, 0xc, 0xf, true));
    return x;
}
__device__ __forceinline__ void scan16(float* cum, int lane) {
    (void)lane;
#pragma unroll
    for (int e = 0; e < 16; ++e) cum[e] = scan_dpp(cum[e]);
}
__device__ __forceinline__ bf16x8 ldfrag(const LAS unsigned char* base, int row, int stride, int kbyte) { return *(const LAS bf16x8*)(base + row * stride + kbyte); }

__device__ __forceinline__ void fill_lb(Frame& F, LAS float* lbs, int layer) {
    const float* hlb = IP_HLB;
    for (int i = F.tid; i < 2048; i += NWAVES * 64) { const int dir = i >> 10, ch = i & 1023; float lb = 0.f;
        if (layer) lb = sigm_f(hlb[(dir * 2 + 1) * 1024 + ch] - hlb[(dir * 2 + 0) * 1024 + ch]);
        lbs[i] = lb; }
    __syncthreads();
}
constexpr int H_KT = 0, H_VT = 18432, H_ESC = 36864, H_SET = 37888, H_LB = 2 * H_SET;
__device__ __forceinline__ void p_h1(Frame& F, int layer, int nrep = 1) {
    LAS unsigned char* L = F.lds + RING_OFF;
    const int lane = F.lane, w = F.wave, fr = lane & 15, fq = lane >> 4;
    LAS float* lbs = (LAS float*)(L + H_LB); fill_lb(F, lbs, layer);
    int pbuf = 0;
    v4u nz0, nz1, nv0, nv1, nq0, nq1;
    auto unit_rowp = [&](int uu_) -> const bf16* { const int u_ = uu_ % (NSEQ * NCHUNK); const int s_ = u_ / NCHUNK, c_ = u_ - s_ * NCHUNK, b_ = s_ >> 4, dir_ = (s_ >> 3) & 1, h_ = s_ & 7;
        return W_PROJ + (size_t)(chunk_row(b_, c_) + (dir_ ? 63 - lane : lane)) * WIN + 128 * h_ + 16 * w; };
#define H1_REQ(uu_) do { const bf16* rp = unit_rowp(uu_); const int s_ = ((uu_) % (NSEQ * NCHUNK)) / NCHUNK, dir_ = (s_ >> 3) & 1; const int zc = dir_ ? C_HB : C_HF; \
        nz0 = *(const v4u*)(rp + zc); nz1 = *(const v4u*)(rp + zc + 8); nv0 = *(const v4u*)(rp + C_HI); nv1 = *(const v4u*)(rp + C_HI + 8); nq0 = *(const v4u*)(rp + C_HQ); nq1 = *(const v4u*)(rp + C_HQ + 8); } while (0)
    if (F.bx < NSEQ * NCHUNK * nrep) H1_REQ(F.bx);
    for (int uu = F.bx; uu < NSEQ * NCHUNK * nrep; uu += F.G) {
        const int u = uu % (NSEQ * NCHUNK);
        const int s = u / NCHUNK, dir = (s >> 3) & 1;
        const int tok = dir ? 63 - lane : lane;
        LAS unsigned char* Ls = L + pbuf * H_SET; pbuf ^= 1;
        LAS bf16* KT = (LAS bf16*)(Ls + H_KT); LAS bf16* VT = (LAS bf16*)(Ls + H_VT); LAS float* esc = (LAS float*)(Ls + H_ESC);
        const v4u z0 = nz0, z1 = nz1, v0 = nv0, v1 = nv1, q0 = nq0, q1 = nq1;
        if (uu + F.G < NSEQ * NCHUNK * nrep) H1_REQ(uu + F.G);
        float z[16], cum[16], kv[16], q[16]; unpack16(z0, z1, z); unpack16(q0, q1, q);
#pragma unroll
        for (int e = 0; e < 16; ++e) hg_gate(z[e], lbs[dir * 1024 + 128 * (s & 7) + 16 * w + e], cum[e], kv[e]);
        scan16(cum, lane);
        const unsigned vw[8] = {v0.x, v0.y, v0.z, v0.w, v1.x, v1.y, v1.z, v1.w};
        unsigned kp[8], qp[8];
        float mcm = 0.f, mce = 0.f;
#pragma unroll
        for (int i = 0; i < 8; ++i) { float ksv[2], qsv[2];
#pragma unroll
            for (int t = 0; t < 2; ++t) { const int e = 2 * i + t;
                const float cmid = __builtin_bit_cast(float, __builtin_amdgcn_readlane(__builtin_bit_cast(int, cum[e]), 31)), cend = __builtin_bit_cast(float, __builtin_amdgcn_readlane(__builtin_bit_cast(int, cum[e]), 63));
                const float dlt = cmid - cum[e];
                ksv[t] = kv[e] * __builtin_amdgcn_exp2f(fminf(dlt, HG_CLAMP2)); qsv[t] = q[e] * __builtin_amdgcn_exp2f(fminf(-dlt, HG_CLAMP2));
                mcm = lane == e ? cmid : mcm; mce = lane == e ? cend : mce; }
            kp[i] = pk2(ksv[0], ksv[1]); qp[i] = pk2(qsv[0], qsv[1]);
            KT[(16 * w + 2 * i) * 72 + tok] = (bf16)(kp[i] & 0xffffu); KT[(16 * w + 2 * i + 1) * 72 + tok] = (bf16)(kp[i] >> 16);
            VT[(16 * w + 2 * i) * 72 + tok] = (bf16)(vw[i] & 0xffffu); VT[(16 * w + 2 * i + 1) * 72 + tok] = (bf16)(vw[i] >> 16); }
        if (lane < 16) { esc[16 * w + lane] = __builtin_amdgcn_exp2f(mce - mcm); W_DEC[(size_t)u * 128 + 16 * w + lane] = __builtin_amdgcn_exp2f(mce); W_EMID[(size_t)u * 128 + 16 * w + lane] = __builtin_amdgcn_exp2f(mcm); }
        { bf16* kd = W_KS + ((size_t)u * 64 + tok) * 128 + 16 * w; bf16* qd = W_QS + ((size_t)u * 64 + tok) * 128 + 16 * w;
          *(v4u*)kd = (v4u){kp[0], kp[1], kp[2], kp[3]}; *(v4u*)(kd + 8) = (v4u){kp[4], kp[5], kp[6], kp[7]};
          *(v4u*)qd = (v4u){qp[0], qp[1], qp[2], qp[3]}; *(v4u*)(qd + 8) = (v4u){qp[4], qp[5], qp[6], qp[7]};
#if defined(PROBE_XW)
          { bf16* xd = W_XN + ((size_t)u * 64 + tok) * 128 + 16 * w; *(v4u*)xd = (v4u){kp[0], kp[1], kp[2], kp[3]}; *(v4u*)(xd + 8) = (v4u){kp[4], kp[5], kp[6], kp[7]}; }
#endif
        }
        __syncthreads();
        f32x4 acc[8];
#pragma unroll
        for (int nb = 0; nb < 8; ++nb) acc[nb] = (f32x4){0.f, 0.f, 0.f, 0.f};
#pragma unroll
        for (int ks = 0; ks < 2; ++ks) { const bf16x8 a = ldfrag((const LAS unsigned char*)KT, 16 * w + fr, 144, (32 * ks + 8 * fq) * 2);
#pragma unroll
            for (int nb = 0; nb < 8; ++nb) { const bf16x8 bb = ldfrag((const LAS unsigned char*)VT, 16 * nb + fr, 144, (32 * ks + 8 * fq) * 2);
                acc[nb] = __builtin_amdgcn_mfma_f32_16x16x32_bf16(a, bb, acc[nb], 0, 0, 0); } }
        const f32x4 e4 = *(const LAS f32x4*)(esc + 16 * w + 4 * fq);
        bf16* dst = W_ST + (size_t)u * 16384 + 16 * w + 4 * fq;
#pragma unroll
        for (int nb = 0; nb < 8; ++nb) { const f32x4 val = acc[nb] * e4; v2u o; o.x = pk2(val[0], val[1]); o.y = pk2(val[2], val[3]); *(v2u*)(dst + (size_t)(16 * nb + fr) * 128) = o; }
    }
#undef H1_REQ
    __syncthreads();
}

__device__ __forceinline__ void p_h2(Frame& F) {
    for (int unit = F.bx; unit < NSEQ * 8; unit += F.G) {
        const int s = unit >> 3, slice = unit & 7, dir = (s >> 3) & 1;
        const int e0 = slice * 2048 + 4 * F.tid, dk0 = e0 & 127;
        float S[4] = {0.f, 0.f, 0.f, 0.f};
        for (int st = 0; st < NCHUNK; st += 4) {
            v2u uu[4]; f32x4 dd[4], em[4]; bf16* pp[4];
#pragma unroll
            for (int i = 0; i < 4; ++i) { const int step = st + i; const int c = dir == 0 ? step : (step < 4 ? 3 - step : 135 - step); const size_t u = (size_t)s * NCHUNK + c;
                pp[i] = W_ST + u * 16384 + e0; uu[i] = *(const v2u*)pp[i]; dd[i] = *(const f32x4*)(W_DEC + u * 128 + dk0); em[i] = *(const f32x4*)(W_EMID + u * 128 + dk0); }
#pragma unroll
            for (int i = 0; i < 4; ++i) { v2u o; o.x = pk2(S[0] * em[i][0], S[1] * em[i][1]); o.y = pk2(S[2] * em[i][2], S[3] * em[i][3]); *(v2u*)pp[i] = o;
                S[0] = dd[i][0] * S[0] + bflo(uu[i].x); S[1] = dd[i][1] * S[1] + bfhi(uu[i].x); S[2] = dd[i][2] * S[2] + bflo(uu[i].y); S[3] = dd[i][3] * S[3] + bfhi(uu[i].y); }
        }
    }
}

constexpr int H3_QK = 0, H3_QKSET = 34816, H3_VT = 69632, H3_P = 88064, H3_SS = 97280;
__device__ __forceinline__ void p_h3(Frame& F, int layer) {
    LAS unsigned char* L = F.lds + RING_OFF;
    LAS bf16* VT = (LAS bf16*)(L + H3_VT); LAS bf16* Ps = (LAS bf16*)(L + H3_P); LAS float* ssq = (LAS float*)(L + H3_SS);
    const int lane = F.lane, w = F.wave, fr = lane & 15, fq = lane >> 4;
    const float* hnw = IP_HNW;
    const int c_lo = layer ? 4 : 0, ncpb = NCHUNK - c_lo;
    const int nunits = 16 * ncpb;
    v4u nq[2], nk[2], ns[4], nv0, nv1;
    auto h1unit = [&](int u_, int dir_) -> size_t { const int bh_ = u_ / ncpb, c_ = c_lo + (u_ - bh_ * ncpb), b_ = bh_ >> 3, h_ = bh_ & 7; return ((size_t)((b_ * 2 + dir_) * 8 + h_)) * NCHUNK + c_; };
#define H3_REQ(u_, dir_) do { const size_t us_ = h1unit(u_, dir_); const bf16* qp_ = W_QS + us_ * 8192 + 8 * F.tid; const bf16* kp_ = W_KS + us_ * 8192 + 8 * F.tid; \
        nq[0] = *(const v4u*)qp_; nq[1] = *(const v4u*)(qp_ + 4096); nk[0] = *(const v4u*)kp_; nk[1] = *(const v4u*)(kp_ + 4096); \
        const bf16* sp_ = W_ST + us_ * 16384 + (16 * w + fr) * 128 + 8 * fq; \
        ns[0] = *(const v4u*)sp_; ns[1] = *(const v4u*)(sp_ + 32); ns[2] = *(const v4u*)(sp_ + 64); ns[3] = *(const v4u*)(sp_ + 96); } while (0)
#define H3_REQV(u_) do { const int bh_ = (u_) / ncpb, c_ = c_lo + ((u_) - bh_ * ncpb), b_ = bh_ >> 3, h_ = bh_ & 7; \
        const bf16* vp_ = W_PROJ + (size_t)(chunk_row(b_, c_) + lane) * WIN + C_HI + 128 * h_ + 16 * w; nv0 = *(const v4u*)vp_; nv1 = *(const v4u*)(vp_ + 8); } while (0)
    if (F.bx < nunits) { H3_REQ(F.bx, 0); H3_REQV(F.bx); }
    int pbuf = 0;
    for (int u = F.bx; u < nunits; u += F.G) {
        const int bh = u / ncpb, c = c_lo + (u - bh * ncpb), b = bh >> 3, h = bh & 7;
        const int rb = chunk_row(b, c), ch0 = 128 * h + 16 * w;
        f32x4 acc[4];
#pragma unroll
        for (int tb = 0; tb < 4; ++tb) acc[tb] = (f32x4){0.f, 0.f, 0.f, 0.f};
        v2u gv[4];
#pragma unroll 1
        for (int dir = 0; dir < 2; ++dir) {
            LAS bf16* Qs = (LAS bf16*)(L + H3_QK + pbuf * H3_QKSET); LAS bf16* Ks = Qs + 64 * 136; pbuf ^= 1;
            const v4u sv0 = ns[0], sv1 = ns[1], sv2 = ns[2], sv3 = ns[3];
#pragma unroll
            for (int j = 0; j < 2; ++j) { const int pc = F.tid + 512 * j; *(LAS v4u*)(Qs + (pc >> 4) * 136 + 8 * (pc & 15)) = nq[j]; *(LAS v4u*)(Ks + (pc >> 4) * 136 + 8 * (pc & 15)) = nk[j]; }
            if (dir == 0) {
                const unsigned ww[8] = {nv0.x, nv0.y, nv0.z, nv0.w, nv1.x, nv1.y, nv1.z, nv1.w};
#pragma unroll
                for (int e = 0; e < 8; ++e) { VT[(16 * w + 2 * e) * 72 + lane] = (bf16)(ww[e] & 0xffffu); VT[(16 * w + 2 * e + 1) * 72 + lane] = (bf16)(ww[e] >> 16); }
            } else {
#pragma unroll
                for (int tb = 0; tb < 4; ++tb) gv[tb] = *(const v2u*)(W_PROJ + (size_t)(rb + 16 * tb + fr) * WIN + C_HG + ch0 + 4 * fq);
            }
            __syncthreads();
            { const int nu = dir ? u + F.G : u, nd = dir ^ 1;
              if (nu < nunits) { H3_REQ(nu, nd); if (dir) H3_REQV(nu); } }
#pragma unroll
            for (int bi = 0; bi < 2; ++bi) { const int blk = 2 * w + bi, I = blk >> 2, J = blk & 3;
                f32x4 pacc = (f32x4){0.f, 0.f, 0.f, 0.f};
                const bool need = dir == 0 ? (J <= I) : (J >= I);
                if (need) {
#pragma unroll
                    for (int ks4 = 0; ks4 < 4; ++ks4) { const bf16x8 a = ldfrag((const LAS unsigned char*)Ks, 16 * J + fr, 272, (32 * ks4 + 8 * fq) * 2), bb = ldfrag((const LAS unsigned char*)Qs, 16 * I + fr, 272, (32 * ks4 + 8 * fq) * 2);
                        pacc = __builtin_amdgcn_mfma_f32_16x16x32_bf16(a, bb, pacc, 0, 0, 0); }
                    if (I == J) {
#pragma unroll
                        for (int r = 0; r < 4; ++r) { const int jj = 4 * fq + r; const bool keep = dir == 0 ? (jj <= fr) : (jj >= fr); if (!keep) pacc[r] = 0.f; } }
                }
                v2u o; o.x = pk2(pacc[0], pacc[1]); o.y = pk2(pacc[2], pacc[3]);
                *(LAS v2u*)(Ps + (16 * I + fr) * 72 + 16 * J + 4 * fq) = o; }
            __syncthreads();
#pragma unroll
            for (int ks2 = 0; ks2 < 2; ++ks2) { const bf16x8 a = ldfrag((const LAS unsigned char*)VT, 16 * w + fr, 144, (32 * ks2 + 8 * fq) * 2);
#pragma unroll
                for (int tb = 0; tb < 4; ++tb) { const bf16x8 bb = ldfrag((const LAS unsigned char*)Ps, 16 * tb + fr, 144, (32 * ks2 + 8 * fq) * 2);
                    acc[tb] = __builtin_amdgcn_mfma_f32_16x16x32_bf16(a, bb, acc[tb], 0, 0, 0); } }
#pragma unroll
            for (int ks4 = 0; ks4 < 4; ++ks4) { const v4u sraw = ks4 == 0 ? sv0 : ks4 == 1 ? sv1 : ks4 == 2 ? sv2 : sv3; const bf16x8 a = __builtin_bit_cast(bf16x8, sraw);
#pragma unroll
                for (int tb = 0; tb < 4; ++tb) { const bf16x8 bb = ldfrag((const LAS unsigned char*)Qs, 16 * tb + fr, 272, (32 * ks4 + 8 * fq) * 2);
                    acc[tb] = __builtin_amdgcn_mfma_f32_16x16x32_bf16(a, bb, acc[tb], 0, 0, 0); } }
        }
#pragma unroll
        for (int tb = 0; tb < 4; ++tb) { float p = (acc[tb][0] * acc[tb][0] + acc[tb][1] * acc[tb][1]) + (acc[tb][2] * acc[tb][2] + acc[tb][3] * acc[tb][3]);
            p += __shfl_xor(p, 16); p += __shfl_xor(p, 32);
            if (fq == 0) ssq[w * 64 + 16 * tb + fr] = p; }
        __syncthreads();
        const f32x4 nwv = *(const f32x4*)(hnw + layer * 128 + 16 * w + 4 * fq);
#pragma unroll
        for (int tb = 0; tb < 4; ++tb) { const int tk = 16 * tb + fr; float tot = 0.f;
#pragma unroll
            for (int ww = 0; ww < 8; ++ww) tot += ssq[ww * 64 + tk];
            const float rstd = __builtin_amdgcn_rsqf(tot * (1.f / 128.f) + EPS);
            const size_t row = (size_t)(rb + tk);
            const float y0 = acc[tb][0] * rstd * nwv[0] * silu_f(bflo(gv[tb].x)), y1 = acc[tb][1] * rstd * nwv[1] * silu_f(bfhi(gv[tb].x));
            const float y2 = acc[tb][2] * rstd * nwv[2] * silu_f(bflo(gv[tb].y)), y3 = acc[tb][3] * rstd * nwv[3] * silu_f(bfhi(gv[tb].y));
            v2u o; o.x = pk2(y0, y1); o.y = pk2(y2, y3);
            *(v2u*)(W_BR + row * MIXW + ch0 + 4 * fq) = o; }
    }
#undef H3_REQ
#undef H3_REQV
    __syncthreads();
}

__device__ __forceinline__ void p_pm(Frame& F, int layer, int nrows) {
    const int gw = F.vcu * NWAVES + F.wave, NGW = F.G * NWAVES, lane = F.lane;
    const float* cw = IP_CONVW + (size_t)layer * 3 * MIXW;
    bf16* B1 = W_BR + (size_t)MTOT * MIXW;
    for (int row = gw; row < nrows; row += NGW) {
        int pos, len; if (row < NLAT) { pos = row & (SEQ - 1); len = SEQ; } else { pos = (row - NLAT) & (CTXL - 1); len = CTXL; }
        const bool hasp = pos > 0, hasn = pos < len - 1;
        const bf16* pr = W_PROJ + (size_t)row * WIN;
#pragma unroll
        for (int s = 0; s < 2; ++s) {
            const int c0 = 512 * s + 8 * lane;
            float cbv[8], pm[8], pc[8], pn[8];
            { const v4u a = *(const v4u*)(pr + C_CB + c0); cbv[0] = bflo(a.x); cbv[1] = bfhi(a.x); cbv[2] = bflo(a.y); cbv[3] = bfhi(a.y); cbv[4] = bflo(a.z); cbv[5] = bfhi(a.z); cbv[6] = bflo(a.w); cbv[7] = bfhi(a.w); }
#define LDPROD(dst, rp) do { const v4u a_ = *(const v4u*)((rp) + C_CC + c0), b_ = *(const v4u*)((rp) + C_CU + c0); \
            dst[0] = bflo(a_.x) * bflo(b_.x); dst[1] = bfhi(a_.x) * bfhi(b_.x); dst[2] = bflo(a_.y) * bflo(b_.y); dst[3] = bfhi(a_.y) * bfhi(b_.y); \
            dst[4] = bflo(a_.z) * bflo(b_.z); dst[5] = bfhi(a_.z) * bfhi(b_.z); dst[6] = bflo(a_.w) * bflo(b_.w); dst[7] = bfhi(a_.w) * bfhi(b_.w); } while (0)
            LDPROD(pc, pr);
            if (hasp) { LDPROD(pm, pr - WIN); } else {
#pragma unroll
                for (int e = 0; e < 8; ++e) pm[e] = 0.f; }
            if (hasn) { LDPROD(pn, pr + WIN); } else {
#pragma unroll
                for (int e = 0; e < 8; ++e) pn[e] = 0.f; }
#undef LDPROD
            float yb[8];
#pragma unroll
            for (int e = 0; e < 8; ++e) yb[e] = cbv[e] * (cw[c0 + e] * pm[e] + cw[MIXW + c0 + e] * pc[e] + cw[2 * MIXW + c0 + e] * pn[e]);
            { v4u o; o.x = pk2(yb[0], yb[1]); o.y = pk2(yb[2], yb[3]); o.z = pk2(yb[4], yb[5]); o.w = pk2(yb[6], yb[7]); *(v4u*)(B1 + (size_t)row * MIXW + c0) = o; }
        }
    }
}

__device__ __forceinline__ void p_attn(Frame& F, int layer, char* ldsg) {
    const float lam_init = 0.8f - 0.6f * expf(-0.3f * (float)layer);
    float lam;
    { const float* lp = IP_LAM + layer * 256; const float s1 = wave_sum(lp[F.lane] * lp[64 + F.lane]), s2 = wave_sum(lp[128 + F.lane] * lp[192 + F.lane]); lam = expf(s1) - expf(s2) + lam_init; }
    const float* danw = IP_DANW + layer * 128; bf16* B2 = W_BR + (size_t)2 * MTOT * MIXW;
    const int nunits = 512 + (layer == 0 ? 16 : 0);
    for (int id = F.vcu; id < nunits; id += F.G) {
        unsigned* held = (unsigned*)W_OP + ((size_t)(((id - F.vcu) / F.G) * F.G + F.bx) * 512 + F.tid) * 32;
        if (id < 512) { const int qb = id & 31, h = (id >> 5) & 7, b = id >> 8;
#pragma unroll 1
            for (int p = 0; p < 2; ++p) att::attn_unit(W_PROJ, SEQ * b + 256 * qb, NLAT + CTXL * b, SEQ * b, NCHUNK, h, p, held, lam, 1.0f - lam_init, danw, B2, ldsg); }
        else { const int j = id - 512, h = j & 7, b = j >> 3;
#pragma unroll 1
            for (int p = 0; p < 2; ++p) att::attn_unit(W_PROJ, NLAT + CTXL * b, NLAT + CTXL * b, SEQ * b, 4, h, p, held, lam, 1.0f - lam_init, danw, B2, ldsg); }
    }
}
struct Args { const float* in[18]; float* out; unsigned char* ws; int ph_lo, ph_hi, li, pad; };
__global__ void __launch_bounds__(NWAVES * 64, 2) mk_fwd(Args args) {
    extern __shared__ __attribute__((aligned(16))) unsigned char lds[];
    Frame F;
    F.lds = (LAS unsigned char*)lds;
    F.MISC = (volatile LAS unsigned*)(F.lds + MISC_OFF);
    F.tid = threadIdx.x; F.lane = F.tid & 63; F.wave = __builtin_amdgcn_readfirstlane(F.tid >> 6);
    F.G = gridDim.x; F.bx = blockIdx.x; { const int bx = blockIdx.x; F.vcu = (F.G % 8 == 0) ? (bx % 8) * (F.G / 8) + bx / 8 : bx; }
    F.ws = args.ws; F.out = args.out;
    F.ctl = (gu32*)(F.ws + WS_CTL);
    for (int u = F.tid; u < (LDS_BYTES - LDSCTL_OFF) / 4; u += NWAVES * 64) ((LAS unsigned*)(F.lds + LDSCTL_OFF))[u] = 0u;
    __syncthreads();
    XcdBarrier bar; bar.bar = (unsigned*)(F.ctl + CW_BAR) + args.li * XCD_BAR_WORDS; bar.x = 0; bar.st = nullptr;
    if (MK_N_LAUNCHES == 1) bar = xcd_barrier_post((unsigned*)(F.ctl + CW_BAR), F.MISC + 8);
    const int lo = args.ph_lo, hi = args.ph_hi;
#ifndef PHMASK
#define PHMASK 0x7fff
#endif
#define PON(b) (((PHMASK) >> (b)) & 1)
#define IN(k) (lo <= (k) && (k) < hi)
#ifndef PROBE_PH
#define PROBE_PH -1
#define PROBE_REP 0
#endif
#define PHASE(cond, id) if (cond) _Pragma("unroll 1") for (int rep_ = 0, nrep_ = ((id) == PROBE_PH ? 1 + PROBE_REP : 1); rep_ < nrep_; ++rep_) { Frame P_ = F; launder(P_); { Frame& F = P_; (void)F;
#define POUT(p, scr) ((rep_ < nrep_ - 1) ? (scr) : (p))
#define PHASE_END } }
#if defined(PROBE_TMASK)
    unsigned long long t_prev = __builtin_amdgcn_s_memrealtime(), t_acc = 0ull;
#define TSTAMP(id) do { const unsigned long long now_ = __builtin_amdgcn_s_memrealtime(); if (((PROBE_TMASK) >> (id)) & 1) t_acc += now_ - t_prev; t_prev = now_; } while (0)
#else
#define TSTAMP(id) do { } while (0)
#endif
#define SEAM(k) do { if (IN(k) && IN((k) + 1)) xcd_barrier(bar); } while (0)

    PHASE(PON(13) && IN(0), 13) p_ada(F); p_convert(F, 0); PHASE_END
    SEAM(0); TSTAMP(13);
    if (PROBE_PH == 200) { for (int q_ = 0; q_ < PROBE_REP; ++q_) xcd_barrier(bar); }

#pragma unroll 1
    for (int l = 0; l < 2; ++l) {
        const int pb = 1 + l * NPL;
        const float* modl = W_MOD + (size_t)l * 3 * MODW;
        const int Mm = (l == 1) ? NLAT : MTOT;
        const float* hl = (l == 0) ? IP_X : (const float*)nullptr; const float* hc = (l == 0) ? IP_CTX : (const float*)nullptr;
        PHASE(PON(0) && IN(pb + 0), 0) if (l == 1) p_convert(F, 1); p_norm(F, hl, hc, IP_NORMW + (size_t)(l * 3 + 0) * D, modl, 0, MTOT, l == 1 ? 11 : 0);  PHASE_END
        SEAM(pb + 0); TSTAMP(0);
        PHASE(PON(1) && IN(pb + 1), 1) pg8::Gemm g{W_XN, W_W13T, MTOT, 2 * FF, D}; pg8::StaticOrder S; S.init(MTOT, 2 * FF, F.G, F.bx);
            pg8::EpiSwiglu E{W_HID, FF}; pg8::gemm_phase<pg8::EpiSwiglu, pg8::StaticOrder, true, true>(F.lds + RING_OFF, g, S, E);  PHASE_END
        SEAM(pb + 1); TSTAMP(1);
        PHASE(PON(2) && IN(pb + 2), 2)
            { pg8::Gemm g{W_HID, W_W2T, NLAT, D, FF}; pg8::StaticOrder S; S.init(NLAT, D, F.G, F.bx, WGM_N8);
              pg8::EpiResid E{hl, W_H16, POUT(W_H16, (bf16*)W_Y32), modl + 2 * D, 0.5f, 0.f}; pg8::gemm_phase<pg8::EpiResid, pg8::StaticOrder, true, true>(F.lds + RING_OFF, g, S, E); }
            { pg8::Gemm g{W_HID + (size_t)NLAT * FF, W_W2T, NCTX, D, 512, FF}; pg8::SplitKOrder S; S.init(NCTX, D, 11, F.G, F.bx);
              pg8::EpiPartial E{W_PART, modl + 2 * MODW + 2 * D, 0.5f}; pg8::gemm_phase<pg8::EpiPartial, pg8::SplitKOrder, true, true>(F.lds + RING_OFF, g, S, E); }
         PHASE_END
        SEAM(pb + 2); TSTAMP(2);
        PHASE(PON(3) && IN(pb + 3), 3) p_norm(F, nullptr, hc, IP_NORMW + (size_t)(l * 3 + 1) * D, modl, 1, MTOT, 11); PHASE_END
        SEAM(pb + 3); TSTAMP(3);
        PHASE(PON(4) && IN(pb + 4), 4) pg8::Gemm g{W_XN, W_WINT, MTOT, WIN, D}; pg8::StaticOrder S; S.init(MTOT, WIN, F.G, F.bx);
            pg8::EpiStoreBf16 E{W_PROJ, WIN, C_AQ / 256, C_AV / 256, QSCALE, C_GA / 256}; pg8::gemm_phase<pg8::EpiStoreBf16, pg8::StaticOrder, true, true>(F.lds + RING_OFF, g, S, E); if (PROBE_PH == 104) { for (int q_ = 0; q_ < PROBE_REP; ++q_) p_h2(F); } PHASE_END
        SEAM(pb + 4); TSTAMP(4);
        PHASE(PON(5) && IN(pb + 5), 5) p_h1(F, l, (PROBE_PH == 105) ? 1 + PROBE_REP : 1);  PHASE_END
        SEAM(pb + 5); TSTAMP(5);
        PHASE(PON(6) && IN(pb + 6), 6) p_attn(F, l, (char*)lds + RING_OFF); if (rep_ == 0) p_h2(F);  PHASE_END
        SEAM(pb + 6); TSTAMP(6);
        PHASE(PON(7) && IN(pb + 7), 7) p_h3(F, l); p_pm(F, l, Mm);  PHASE_END
        SEAM(pb + 7); TSTAMP(7);
#if defined(PROBE_IDLE)
        { const unsigned long long t0_ = __builtin_amdgcn_s_memrealtime(); while (__builtin_amdgcn_s_memrealtime() - t0_ < (unsigned long long)(PROBE_IDLE)) __builtin_amdgcn_s_sleep(64); }
#endif
        PHASE(PON(8) && IN(pb + 8), 8)
            { pg8::Gemm g{W_BR, W_WBT, Mm, D, MIXW}; pg8::MergeOrder S; S.init(Mm, F.G, F.bx);
              pg8::EpiMergeChain E{W_PROJ + C_GA, WIN, W_XN}; pg8::gemm_phase<pg8::EpiMergeChain, pg8::MergeOrder, true, true>(F.lds + RING_OFF, g, S, E); }
         PHASE_END
        SEAM(pb + 8); TSTAMP(8);
        PHASE(PON(9) && IN(pb + 9), 9)
            { pg8::Gemm g{W_XN, W_WOT, NLAT, D, D}; pg8::StaticOrder S; S.init(NLAT, D, F.G, F.bx, WGM_N8);
              pg8::EpiResid E{nullptr, W_H16, POUT(W_H16, (bf16*)W_Y32), modl + 5 * D, 1.0f, 0.f}; pg8::gemm_phase<pg8::EpiResid, pg8::StaticOrder, true, true>(F.lds + RING_OFF, g, S, E); }
            if (l == 0) { pg8::Gemm g{W_XN + (size_t)NLAT * D, W_WOT, NCTX, D, 512, D}; pg8::SplitKOrder S; S.init(NCTX, D, 4, F.G, F.bx);
              pg8::EpiPartial E{W_PART, modl + 2 * MODW + 5 * D, 1.0f}; pg8::gemm_phase<pg8::EpiPartial, pg8::SplitKOrder, true, true>(F.lds + RING_OFF, g, S, E); }
         PHASE_END
        SEAM(pb + 9); TSTAMP(9);
        PHASE(PON(10) && IN(pb + 10), 10) p_norm(F, nullptr, nullptr, IP_NORMW + (size_t)(l * 3 + 2) * D, modl, 2, Mm, 4); PHASE_END
        SEAM(pb + 10); TSTAMP(10);
        PHASE(PON(11) && IN(pb + 11), 11) pg8::Gemm g{W_XN, W_W13T + (size_t)2 * FF * D, Mm, 2 * FF, D}; pg8::StaticOrder S; S.init(Mm, 2 * FF, F.G, F.bx);
            pg8::EpiSwiglu E{W_HID, FF}; pg8::gemm_phase<pg8::EpiSwiglu, pg8::StaticOrder, true, true>(F.lds + RING_OFF, g, S, E);  PHASE_END
        SEAM(pb + 11); TSTAMP(11);
        PHASE(PON(12) && IN(pb + 12), 12)
            { pg8::Gemm g{W_HID, W_W2T + (size_t)D * FF, NLAT, D, FF}; pg8::StaticOrder S; S.init(NLAT, D, F.G, F.bx, WGM_N8);
              pg8::EpiResid E{nullptr, W_H16, POUT(W_H16, (bf16*)W_Y32), modl + 8 * D, 0.5f, 0.f}; pg8::gemm_phase<pg8::EpiResid, pg8::StaticOrder, true, true>(F.lds + RING_OFF, g, S, E); }
            if (l == 0) { pg8::Gemm g{W_HID + (size_t)NLAT * FF, W_W2T + (size_t)D * FF, NCTX, D, 512, FF}; pg8::SplitKOrder S; S.init(NCTX, D, 11, F.G, F.bx);
              pg8::EpiPartial E{W_PART, modl + 2 * MODW + 8 * D, 0.5f}; pg8::gemm_phase<pg8::EpiPartial, pg8::SplitKOrder, true, true>(F.lds + RING_OFF, g, S, E); }
         PHASE_END
        SEAM(pb + 12); TSTAMP(12);
    }
    PHASE(PON(14) && IN(NPHASE - 1), 14) p_final(F); PHASE_END
#if defined(PROBE_TMASK)
    TSTAMP(14);
    if (blockIdx.x == 0) { const unsigned long long t0_ = __builtin_amdgcn_s_memrealtime(); while (__builtin_amdgcn_s_memrealtime() - t0_ < (unsigned long long)(PROBE_TMUL) * t_acc) __builtin_amdgcn_s_sleep(32); }
#endif

#undef IN
#undef SEAM
}

extern "C" void kernel_launch(void* const* d_in, const int* in_sizes, int n_in, void* d_out, int out_size, void* d_ws, size_t ws_size, hipStream_t stream) {
    static int grid = 0;
    if (grid == 0) {
        if (n_in != 18 || in_sizes[0] != NLAT * D || out_size != NLAT * D || ws_size < WS_END) { fprintf(stderr, "kernel_launch: shape/workspace mismatch (n_in %d, in0 %d, out %d, ws %zu, need %zu)\n", n_in, n_in > 0 ? in_sizes[0] : -1, out_size, ws_size, (size_t)WS_END); grid = -1; return; }
        int dev = 0, cus = 0, per_cu = 0;
        if (hipGetDevice(&dev) != hipSuccess || hipDeviceGetAttribute(&cus, hipDeviceAttributeMultiprocessorCount, dev) != hipSuccess) { grid = -1; return; }
        if (hipFuncSetAttribute((const void*)mk_fwd, hipFuncAttributeMaxDynamicSharedMemorySize, LDS_BYTES) != hipSuccess) { fprintf(stderr, "kernel_launch: hipFuncSetAttribute failed\n"); grid = -1; return; }
        if (hipOccupancyMaxActiveBlocksPerMultiprocessor(&per_cu, (const void*)mk_fwd, NWAVES * 64, LDS_BYTES) != hipSuccess || per_cu < 1) fprintf(stderr, "kernel_launch: occupancy query reports %d\n", per_cu);
        (void)hipGetLastError();
        grid = cus;
    }
    if (grid < 0) return;
    if (hipMemsetAsync((char*)d_ws + WS_CTL, 0, CTL_ZERO_BYTES, stream) != hipSuccess) return;
    Args a{};
    for (int i = 0; i < 18; ++i) a.in[i] = (const float*)d_in[i];
    a.out = (float*)d_out; a.ws = (unsigned char*)d_ws;
#if MK_N_LAUNCHES == 1
    a.ph_lo = 0; a.ph_hi = NPHASE; a.li = 0;
    hipLaunchKernelGGL(mk_fwd, dim3(grid), dim3(NWAVES * 64), LDS_BYTES, stream, a);
#else
    for (int ph = 0; ph < NPHASE; ++ph) { a.ph_lo = ph; a.ph_hi = ph + 1; a.li = 0; hipLaunchKernelGGL(mk_fwd, dim3(grid), dim3(NWAVES * 64), LDS_BYTES, stream, a); }
#endif
    const hipError_t le = hipPeekAtLastError();
    if (le != hipSuccess) fprintf(stderr, "kernel_launch: launch failed: %s\n", hipGetErrorName(le));
}
```
